# Optimizing an MI355X kernel written in HIP

```python
import math
import jax, jax.numpy as jnp
from jax import lax
import numpy as np

D_MODEL = 2048
BATCH = 4
SEQ = 2048
DEPTH = 4
DEC_BATCH = 128
DEC_SEQ = 4
PAST_LEN = 16384
PAGE_SIZE = 128

N_MIXERS = 3
N_HGRN = (DEPTH + 2) // 3
N_MLSTM = (DEPTH + 1) // 3
N_GMLP = DEPTH // 3

HG_DK = 128
HG_HEADS = D_MODEL // HG_DK
HG_DV = D_MODEL // HG_HEADS
HG_CHUNK = 64

ML_HEADS = 8
ML_DQK = D_MODEL // (2 * ML_HEADS)
ML_DV = D_MODEL // ML_HEADS
ML_CHUNK = 64
GATE_CAP = 15.0

GM_DIM = D_MODEL
GM_CHUNK = 128
GM_GROUPS = 16
GM_GDIM = GM_DIM // GM_GROUPS

FFN_DIM = 256 * ((8 * D_MODEL // 3 + 255) // 256)
CONV_W = 3
EPS = 1e-6

kernel_name = 'hybrid_hgrn2_mlstm_gmlp_convffn_step'


def _rmsnorm(x, g):
    xf = x.astype(jnp.float32)
    y = xf * lax.rsqrt(jnp.mean(xf * xf, axis=-1, keepdims=True) + EPS)
    return (y * g.astype(jnp.float32)).astype(x.dtype)


def _layernorm(x, g, b):
    xf = x.astype(jnp.float32)
    mu = jnp.mean(xf, axis=-1, keepdims=True)
    xc = xf - mu
    y = xc * lax.rsqrt(jnp.mean(xc * xc, axis=-1, keepdims=True) + EPS)
    return (y * g.astype(jnp.float32) + b.astype(jnp.float32)).astype(x.dtype)


def _chunk_len(T, c):
    return T if T <= c else c


def _to_chunks(a, L):
    B, T, H, d = a.shape
    return a.reshape(B, T // L, L, H, d).transpose(1, 0, 3, 2, 4)


def _gates_to_chunks(a, L):
    B, T, H = a.shape
    return a.reshape(B, T // L, L, H).transpose(1, 0, 3, 2)


def _from_chunks(a):
    n, B, H, L, d = a.shape
    return a.transpose(1, 0, 3, 2, 4).reshape(B, n * L, H, d)


def _hgrn_mixer(h, S0, w_q, w_f, w_i, w_g, lb, onorm, w_o):
    B, T, _ = h.shape
    f32 = jnp.float32
    q = jax.nn.silu(h @ w_q).astype(f32).reshape(B, T, HG_HEADS, HG_DK)
    fpre = (h @ w_f).astype(f32).reshape(B, T, HG_HEADS, HG_DK)
    v = (h @ w_i).astype(f32).reshape(B, T, HG_HEADS, HG_DV)
    lbh = jnp.maximum(lb.astype(f32), 0.0).reshape(HG_HEADS, HG_DK)
    logf = jnp.logaddexp(jnp.log(lbh), jnp.log1p(-lbh) + jax.nn.log_sigmoid(fpre))
    k = (1.0 - lbh) * jax.nn.sigmoid(-fpre)
    L = _chunk_len(T, HG_CHUNK)
    tri = jnp.tril(jnp.ones((L, L), dtype=bool))

    def step(S, xs):
        qc, kc, vc, lfc = xs
        b = jnp.cumsum(lfc, axis=2)
        o_inter = jnp.einsum('bhtk,bhkv->bhtv', qc * jnp.exp(b), S)
        diff = b[:, :, :, None, :] - b[:, :, None, :, :]
        decay = jnp.exp(jnp.where(tri[:, :, None], diff, -jnp.inf))
        A = jnp.einsum('bhtk,bhsk,bhtsk->bhts', qc, kc, decay)
        o = o_inter + jnp.einsum('bhts,bhsv->bhtv', A, vc)
        bL = b[:, :, -1:, :]
        S = jnp.exp(bL[:, :, 0])[..., None] * S + jnp.einsum('bhsk,bhsv->bhkv', kc * jnp.exp(bL - b), vc)
        return S, o

    S, o = lax.scan(step, S0.astype(f32), (_to_chunks(q, L), _to_chunks(k, L), _to_chunks(v, L), _to_chunks(logf, L)))
    o = _from_chunks(o).reshape(B, T, HG_HEADS * HG_DV)
    o = _rmsnorm(o, onorm).astype(h.dtype) * jax.nn.sigmoid(h @ w_g)
    return o @ w_o, S


def _mlstm_mixer(h, C0, n0, m0, w_q, w_k, w_v, w_og, w_if, b_if, hnorm, w_out):
    B, T, _ = h.shape
    f32 = jnp.float32
    q = (h @ w_q).astype(f32).reshape(B, T, ML_HEADS, ML_DQK)
    k = (h @ w_k).astype(f32).reshape(B, T, ML_HEADS, ML_DQK) * (ML_DQK ** -0.5)
    v = (h @ w_v).astype(f32).reshape(B, T, ML_HEADS, ML_DV)
    gates = GATE_CAP * jnp.tanh((h @ w_if + b_if).astype(f32) / GATE_CAP)
    ig = gates[..., :ML_HEADS]
    lf = jax.nn.log_sigmoid(gates[..., ML_HEADS:])
    L = _chunk_len(T, ML_CHUNK)
    tri = jnp.tril(jnp.ones((L, L), dtype=bool))

    def step(carry, xs):
        C, n, m = carry
        qc, kc, vc, igc, lfc = xs
        b = jnp.cumsum(lfc, axis=-1)
        dlog = jnp.where(tri, b[..., :, None] - b[..., None, :] + igc[..., None, :], -jnp.inf)
        inter = b + m[..., None]
        mt = jnp.maximum(inter, jnp.max(dlog, axis=-1))
        wts = jnp.exp(dlog - mt[..., None]) * jnp.einsum('bhtd,bhsd->bhts', qc, kc)
        sc = jnp.exp(inter - mt)
        num = sc[..., None] * jnp.einsum('bhtd,bhdv->bhtv', qc, C) + jnp.einsum('bhts,bhsv->bhtv', wts, vc)
        den = sc * jnp.einsum('bhtd,bhd->bht', qc, n) + jnp.sum(wts, axis=-1)
        out = num / jnp.maximum(jnp.abs(den), jnp.exp(-mt))[..., None]
        mL = mt[..., -1]
        sc_state = jnp.exp(b[..., -1] + m - mL)
        wk = jnp.exp(b[..., -1:] - b + igc - mL[..., None])
        C = sc_state[..., None, None] * C + jnp.einsum('bhs,bhsd,bhsv->bhdv', wk, kc, vc)
        n = sc_state[..., None] * n + jnp.einsum('bhs,bhsd->bhd', wk, kc)
        return (C, n, mL), out

    (C, n, m), o = lax.scan(step, (C0.astype(f32), n0.astype(f32), m0.astype(f32)),
                            (_to_chunks(q, L), _to_chunks(k, L), _to_chunks(v, L),
                             _gates_to_chunks(ig, L), _gates_to_chunks(lf, L)))
    o = _from_chunks(o)
    o = _rmsnorm(o, hnorm.reshape(ML_HEADS, ML_DV)).reshape(B, T, ML_HEADS * ML_DV)
    o = o.astype(h.dtype) * jax.nn.sigmoid(h @ w_og)
    return o @ w_out, (C, n, m)


def _gmlp_mixer(h, w_in, b_in, vg, vb, w_s, b_s, w_out):
    B, T, _ = h.shape
    z = jax.nn.gelu(h @ w_in + b_in, approximate=False)
    u, v = jnp.split(z, 2, axis=-1)
    v = _layernorm(v, vg, vb)
    L = _chunk_len(T, GM_CHUNK)
    tri = jnp.tril(jnp.ones((L, L), dtype=bool))
    ws = jnp.where(tri, w_s[:, :L, :L], 0.0)
    vc = v.reshape(B, T // L, L, GM_GROUPS, GM_GDIM)
    mix = jnp.einsum('gts,bnsgd->bntgd', ws, vc) + b_s[:, :L].T[None, None, :, :, None]
    o = u * mix.reshape(B, T, GM_DIM)
    return o @ w_out, v


def _conv_ffn(h, buf, w_up, cw, cb, w_down):
    T = h.shape[1]
    up = h @ w_up
    hp = jnp.concatenate([buf.astype(up.dtype), up], axis=1)
    y = cb
    for j in range(CONV_W):
        y = y + cw[j] * hp[:, j:j + T]
    a, g = jnp.split(y, 2, axis=-1)
    return (a * jax.nn.silu(g)) @ w_down, hp[:, T:]


def _trunk(x, S_in, C_in, n_in, m_in, conv_in, p):
    lb = jax.nn.softmax(p['hgrn_lb'].astype(jnp.float32), axis=0)
    lbs = jnp.cumsum(lb, axis=0) - lb[0]
    new_S, new_C, new_n, new_m, new_v, new_conv = [], [], [], [], [], []
    for i in range(DEPTH):
        j = i // N_MIXERS
        kind = i % N_MIXERS
        h = _rmsnorm(x, p['norm_mix'][i])
        if kind == 0:
            o, S = _hgrn_mixer(h, S_in[j], p['hgrn_w_q'][j], p['hgrn_w_f'][j], p['hgrn_w_i'][j],
                               p['hgrn_w_g'][j], lbs[j], p['hgrn_onorm'][j], p['hgrn_w_o'][j])
            new_S.append(S)
        elif kind == 1:
            o, (C, n, m) = _mlstm_mixer(h, C_in[j], n_in[j], m_in[j], p['mlstm_w_q'][j], p['mlstm_w_k'][j],
                                        p['mlstm_w_v'][j], p['mlstm_w_og'][j], p['mlstm_w_if'][j],
                                        p['mlstm_b_if'][j], p['mlstm_hnorm'][j], p['mlstm_w_out'][j])
            new_C.append(C)
            new_n.append(n)
            new_m.append(m)
        else:
            o, v = _gmlp_mixer(h, p['gmlp_w_in'][j], p['gmlp_b_in'][j], p['gmlp_vnorm_g'][j],
                               p['gmlp_vnorm_b'][j], p['gmlp_w_s'][j], p['gmlp_b_s'][j], p['gmlp_w_out'][j])
            new_v.append(v)
        x = x + o
        h = _rmsnorm(x, p['norm_ffn'][i])
        o, buf = _conv_ffn(h, conv_in[i], p['ffn_w_up'][i], p['ffn_conv_w'][i], p['ffn_conv_b'][i], p['ffn_w_down'][i])
        new_conv.append(buf)
        x = x + o
    y = _rmsnorm(x, p['norm_final'])
    return (y, jnp.stack(new_S), jnp.stack(new_C), jnp.stack(new_n), jnp.stack(new_m),
            jnp.stack(new_v), jnp.stack(new_conv))


def setup_inputs(seed: int = 0) -> dict:
    key = jax.random.key(seed)
    ks = iter(jax.random.split(key, 48))

    def nrm(shape, scale):
        return scale * jax.random.normal(next(ks), shape, jnp.float32)

    F2 = 2 * FFN_DIM
    res = (2 * DEPTH) ** -0.5
    dn = D_MODEL ** -0.5
    return {
        'x_prompt': nrm((BATCH, SEQ, D_MODEL), 1.0),
        'x_sample': nrm((DEC_BATCH, DEC_SEQ, D_MODEL), 1.0),
        'state_hgrn_S': nrm((N_HGRN, DEC_BATCH, HG_HEADS, HG_DK, HG_DV), 0.5),
        'state_mlstm_C': nrm((N_MLSTM, DEC_BATCH, ML_HEADS, ML_DQK, ML_DV), 0.3),
        'state_mlstm_n': nrm((N_MLSTM, DEC_BATCH, ML_HEADS, ML_DQK), 0.3),
        'state_mlstm_m': nrm((N_MLSTM, DEC_BATCH, ML_HEADS), 1.0),
        'state_ffn_conv': nrm((DEPTH, DEC_BATCH, CONV_W - 1, F2), 1.0),
        'norm_mix': 1.0 + nrm((DEPTH, D_MODEL), 0.02),
        'norm_ffn': 1.0 + nrm((DEPTH, D_MODEL), 0.02),
        'norm_final': 1.0 + nrm((D_MODEL,), 0.02),
        'hgrn_w_q': nrm((N_HGRN, D_MODEL, HG_HEADS * HG_DK), dn),
        'hgrn_w_f': nrm((N_HGRN, D_MODEL, HG_HEADS * HG_DK), dn),
        'hgrn_w_i': nrm((N_HGRN, D_MODEL, HG_HEADS * HG_DV), dn),
        'hgrn_w_g': nrm((N_HGRN, D_MODEL, HG_HEADS * HG_DV), dn),
        'hgrn_lb': nrm((N_HGRN, HG_HEADS * HG_DK), 0.5),
        'hgrn_onorm': 1.0 + nrm((N_HGRN, HG_HEADS * HG_DV), 0.02),
        'hgrn_w_o': nrm((N_HGRN, HG_HEADS * HG_DV, D_MODEL), (HG_HEADS * HG_DV) ** -0.5 * res),
        'mlstm_w_q': nrm((N_MLSTM, D_MODEL, ML_HEADS * ML_DQK), dn),
        'mlstm_w_k': nrm((N_MLSTM, D_MODEL, ML_HEADS * ML_DQK), dn),
        'mlstm_w_v': nrm((N_MLSTM, D_MODEL, ML_HEADS * ML_DV), dn),
        'mlstm_w_og': nrm((N_MLSTM, D_MODEL, ML_HEADS * ML_DV), dn),
        'mlstm_w_if': nrm((N_MLSTM, D_MODEL, 2 * ML_HEADS), dn),
        'mlstm_b_if': jnp.concatenate([nrm((N_MLSTM, ML_HEADS), 0.1) - 1.0,
                                       3.0 + nrm((N_MLSTM, ML_HEADS), 0.5)], axis=-1),
        'mlstm_hnorm': 1.0 + nrm((N_MLSTM, ML_HEADS * ML_DV), 0.02),
        'mlstm_w_out': nrm((N_MLSTM, ML_HEADS * ML_DV, D_MODEL), (ML_HEADS * ML_DV) ** -0.5 * res),
        'gmlp_w_in': nrm((N_GMLP, D_MODEL, 2 * GM_DIM), dn),
        'gmlp_b_in': nrm((N_GMLP, 2 * GM_DIM), 0.02),
        'gmlp_vnorm_g': 1.0 + nrm((N_GMLP, GM_DIM), 0.02),
        'gmlp_vnorm_b': nrm((N_GMLP, GM_DIM), 0.02),
        'gmlp_w_s': nrm((N_GMLP, GM_GROUPS, GM_CHUNK, GM_CHUNK), GM_CHUNK ** -0.5),
        'gmlp_b_s': 1.0 + nrm((N_GMLP, GM_GROUPS, GM_CHUNK), 0.1),
        'gmlp_w_out': nrm((N_GMLP, GM_DIM, D_MODEL), GM_DIM ** -0.5 * res),
        'ffn_w_up': nrm((DEPTH, D_MODEL, F2), dn),
        'ffn_conv_w': nrm((DEPTH, CONV_W, F2), 0.3).at[:, CONV_W - 1].add(1.0),
        'ffn_conv_b': nrm((DEPTH, F2), 0.02),
        'ffn_w_down': nrm((DEPTH, FFN_DIM, D_MODEL), FFN_DIM ** -0.5 * res),
    }


def reference(x_prompt, x_sample, state_hgrn_S, state_mlstm_C, state_mlstm_n, state_mlstm_m, state_ffn_conv,
              norm_mix, norm_ffn, norm_final,
              hgrn_w_q, hgrn_w_f, hgrn_w_i, hgrn_w_g, hgrn_lb, hgrn_onorm, hgrn_w_o,
              mlstm_w_q, mlstm_w_k, mlstm_w_v, mlstm_w_og, mlstm_w_if, mlstm_b_if, mlstm_hnorm, mlstm_w_out,
              gmlp_w_in, gmlp_b_in, gmlp_vnorm_g, gmlp_vnorm_b, gmlp_w_s, gmlp_b_s, gmlp_w_out,
              ffn_w_up, ffn_conv_w, ffn_conv_b, ffn_w_down):
    p = dict(norm_mix=norm_mix, norm_ffn=norm_ffn, norm_final=norm_final,
             hgrn_w_q=hgrn_w_q, hgrn_w_f=hgrn_w_f, hgrn_w_i=hgrn_w_i, hgrn_w_g=hgrn_w_g,
             hgrn_lb=hgrn_lb, hgrn_onorm=hgrn_onorm, hgrn_w_o=hgrn_w_o,
             mlstm_w_q=mlstm_w_q, mlstm_w_k=mlstm_w_k, mlstm_w_v=mlstm_w_v, mlstm_w_og=mlstm_w_og,
             mlstm_w_if=mlstm_w_if, mlstm_b_if=mlstm_b_if, mlstm_hnorm=mlstm_hnorm, mlstm_w_out=mlstm_w_out,
             gmlp_w_in=gmlp_w_in, gmlp_b_in=gmlp_b_in, gmlp_vnorm_g=gmlp_vnorm_g, gmlp_vnorm_b=gmlp_vnorm_b,
             gmlp_w_s=gmlp_w_s, gmlp_b_s=gmlp_b_s, gmlp_w_out=gmlp_w_out,
             ffn_w_up=ffn_w_up, ffn_conv_w=ffn_conv_w, ffn_conv_b=ffn_conv_b, ffn_w_down=ffn_w_down)
    f32 = jnp.float32
    bp = x_prompt.shape[0]
    zS = jnp.zeros((N_HGRN, bp, HG_HEADS, HG_DK, HG_DV), f32)
    zC = jnp.zeros((N_MLSTM, bp, ML_HEADS, ML_DQK, ML_DV), f32)
    zn = jnp.zeros((N_MLSTM, bp, ML_HEADS, ML_DQK), f32)
    zm = jnp.zeros((N_MLSTM, bp, ML_HEADS), f32)
    zconv = jnp.zeros((DEPTH, bp, CONV_W - 1, 2 * FFN_DIM), x_prompt.dtype)
    y_prompt, S_p, C_p, n_p, m_p, _, conv_p = _trunk(x_prompt, zS, zC, zn, zm, zconv, p)
    y_sample, S_s, C_s, n_s, m_s, v_s, conv_s = _trunk(x_sample, state_hgrn_S, state_mlstm_C, state_mlstm_n,
                                                       state_mlstm_m, state_ffn_conv, p)
    return (y_prompt, y_sample, S_p, S_s, C_p, C_s, n_p, n_s, m_p, m_s, v_s, conv_p, conv_s)
```

```cpp
#include <hip/hip_runtime.h>
#include <cstdio>
#include <cstdint>
#ifndef PG8_WGM
#define PG8_WGM 4
#endif
namespace pg8 {
#define PG8_LAS __attribute__((address_space(3)))
typedef unsigned short bf16_t;
typedef short bf16x8 __attribute__((ext_vector_type(8)));
typedef float f32x4 __attribute__((ext_vector_type(4)));
typedef unsigned u32x4 __attribute__((ext_vector_type(4)));
constexpr int BM = 256, BK = 64, HALF = 128, HTB = HALF * BK * 2  , STAGE_BYTES = 8 * HTB, NXCD = 8, WGM = PG8_WGM;

__host__ __device__ __forceinline__ int lds_byte(int r, int c) { const int st = (r >> 4) * 2 + (c >> 5), rr = r & 15, cc = c & 31, ob = rr * 64 + cc * 2; return st * 1024 + (ob ^ (((ob >> 9) & 1) << 5)); }
__host__ __device__ __forceinline__ void stage_rc(int b, int& R, int& C) { const int st = b / 1024, sb = b % 1024, swz = sb ^ (((sb >> 9) & 1) << 5); R = (st >> 1) * 16 + swz / 64; C = (st & 1) * 32 + (swz % 64) / 2; }
__host__ __device__ __forceinline__ int perm32(int rho) { const int n = rho >> 4, i = rho & 15; return 8 * (i >> 2) + 4 * n + (i & 3); }

struct Unit { int pm, pn, kofs, ks, slot; };
struct Gemm { const bf16_t* A; const bf16_t* Bt; int M, N, K, ld; };

struct StaticOrder {
    int nM, nN, nwg, G, c;
    __host__ __device__ void init(int M, int N, int G_, int c_) { nM = M / BM; nN = N / BM; nwg = nM * nN; G = G_; c = c_; }
    __host__ __device__ bool next(int i, Unit& u) const {
        const long L = (long)i * G + c; if (L >= nwg) return false;
        int wgid = (int)L; { const int q = nwg / NXCD, r = nwg % NXCD, xcd = wgid % NXCD, off = wgid / NXCD; wgid = (xcd < r ? xcd * (q + 1) : r * (q + 1) + (xcd - r) * q) + off; }
        const int nig = WGM * nN, gid = wgid / nig, fm = gid * WGM, gsz = (nM - fm) < WGM ? (nM - fm) : WGM;
        u.pm = fm + ((wgid % nig) % gsz); u.pn = (wgid % nig) / gsz; u.kofs = 0; u.ks = 0; u.slot = i; return true;
    }
    __device__ __forceinline__ void a_ready(const Unit&) const {}
    __device__ __forceinline__ void done(const Unit&) const {}
};
struct SplitOrder {
    int nN, nK, Ksub, nunits, G, c;
    __host__ __device__ void init(int Mrows, int N, int nK_, int Ksub_, int G_, int c_) { nN = N / BM; nK = nK_; Ksub = Ksub_; nunits = (Mrows / BM) * nN * nK; G = G_; c = c_; }
    __host__ __device__ bool next(int i, Unit& u) const {
        const int L = i * G + c; if (L >= nunits) return false;
        u.ks = L % nK; const int r = L / nK; u.pn = r % nN; u.pm = r / nN; u.kofs = u.ks * Ksub; u.slot = i; return true;
    }
    __device__ __forceinline__ void a_ready(const Unit&) const {}
    __device__ __forceinline__ void done(const Unit&) const {}
};
__device__ __forceinline__ unsigned cvt_pk_bf16(float lo, float hi) { unsigned r; asm volatile("v_cvt_pk_bf16_f32 %0, %1, %2" : "=v"(r) : "v"(lo), "v"(hi)); return r; }
typedef float f32x2c __attribute__((ext_vector_type(2))); typedef __bf16 bf16x2c __attribute__((ext_vector_type(2)));
__device__ __forceinline__ unsigned pk2_(float lo, float hi) { f32x2c v; v.x = lo; v.y = hi; return __builtin_bit_cast(unsigned, __builtin_convertvector(v, bf16x2c)); }
__device__ __forceinline__ void rows_rstd(const float* SSQ, const Unit& u, int wr, int fr, int fq, float inv_d, float eps, float (&rs)[2][4]) {
#pragma unroll
    for (int ai = 0; ai < 2; ++ai)
#pragma unroll
        for (int m = 0; m < 4; ++m) { const float* p = SSQ + (size_t)(u.pm * BM + ai * HALF + wr * 64 + m * 16 + fr) * 32 + fq * 8;
            const f32x4 a = *(const f32x4*)p, b = *(const f32x4*)(p + 4); float s = ((a[0] + a[1]) + (a[2] + a[3])) + ((b[0] + b[1]) + (b[2] + b[3]));
            s += __shfl_xor(s, 16); s += __shfl_xor(s, 32); rs[ai][m] = 1.0f / sqrtf(s * inv_d + eps); }
}
__device__ __forceinline__ void rows_rstd_lds(const PG8_LAS float* tab, const Unit& u, int wr, int fr, float (&rs)[2][4]) {
#pragma unroll
    for (int ai = 0; ai < 2; ++ai)
#pragma unroll
        for (int m = 0; m < 4; ++m) rs[ai][m] = tab[u.slot * 256 + ai * HALF + wr * 64 + m * 16 + fr];
}
template <int ACT> struct EpiBf16 {
    static constexpr bool PERM = true, AFTER_DRAIN = false;
    bf16_t* O; int ldc; int skip;
    __device__ __forceinline__ void operator()(const f32x4 (&acc)[2][2][4][2], const Unit& u, int wr, int wc, int fr, int fq) const {
        if (skip) return;
        const int row0 = u.pm * BM + wr * 64 + fr; const int col0 = u.pn * BM + wc * 32 + 8 * fq;
#pragma unroll
        for (int ai = 0; ai < 2; ++ai)
#pragma unroll
            for (int m = 0; m < 4; ++m) { bf16_t* rowp = O + (size_t)(row0 + ai * HALF + m * 16) * ldc + col0;
#pragma unroll
                for (int bj = 0; bj < 2; ++bj) { const f32x4 v0 = acc[ai][bj][m][0], v1 = acc[ai][bj][m][1];
                    u32x4 w; w.x = cvt_pk_bf16(v0[0], v0[1]); w.y = cvt_pk_bf16(v0[2], v0[3]); w.z = cvt_pk_bf16(v1[0], v1[1]); w.w = cvt_pk_bf16(v1[2], v1[3]);
                    *(u32x4*)(rowp + bj * HALF) = w; } }
    }
};
struct EpiF32 {
    static constexpr bool PERM = false, AFTER_DRAIN = false;
    float* C; int ldc; const float* bias; int skip; const PG8_LAS float* rtab;
    int gate_pn; float* GATES; const float* b_if;
    __device__ __forceinline__ void operator()(const f32x4 (&acc)[2][2][4][2], const Unit& u, int wr, int wc, int fr, int fq) const {
        if (skip) return;
        float rs[2][4]; rows_rstd_lds(rtab, u, wr, fr, rs);
        const int row0 = u.pm * BM + wr * 64 + fr, col0 = u.pn * BM + wc * 32 + 4 * fq;
        if (u.pn == gate_pn) {
            if (wc == 0) { const f32x4 bb = *(const f32x4*)(b_if + 4 * fq);
#pragma unroll
                for (int ai = 0; ai < 2; ++ai)
#pragma unroll
                    for (int m = 0; m < 4; ++m) { f32x4 o;
#pragma unroll
                        for (int e = 0; e < 4; ++e) { const float pre = acc[ai][0][m][0][e] * rs[ai][m] + bb[e]; const float gate = 15.0f - 30.0f * __builtin_amdgcn_rcpf(1.0f + __expf(pre * (2.0f / 15.0f)));     o[e] = fq < 2 ? gate : -__logf(1.0f + __expf(-gate)); }
                        *(f32x4*)(GATES + (size_t)(row0 + ai * HALF + m * 16) * 16 + 4 * fq) = o; } }
            return;
        }
        f32x4 bv[2][2];
#pragma unroll
        for (int bj = 0; bj < 2; ++bj)
#pragma unroll
            for (int n = 0; n < 2; ++n) bv[bj][n] = bias ? *(const f32x4*)(bias + col0 + bj * HALF + n * 16) : (f32x4){0.f, 0.f, 0.f, 0.f};
#pragma unroll
        for (int ai = 0; ai < 2; ++ai)
#pragma unroll
            for (int m = 0; m < 4; ++m) { float* rowp = C + (size_t)(row0 + ai * HALF + m * 16) * ldc + col0;
#pragma unroll
                for (int bj = 0; bj < 2; ++bj)
#pragma unroll
                    for (int n = 0; n < 2; ++n) *(f32x4*)(rowp + bj * HALF + n * 16) = acc[ai][bj][m][n] * rs[ai][m] + bv[bj][n]; }
    }
};
#if defined(EPI_NT)
#define EPI_ST(T, p, v) __builtin_nontemporal_store((v), (T*)(p))
#else
#define EPI_ST(T, p, v) (*(T*)(p) = (v))
#endif
struct EpiResid {
    static constexpr bool PERM = false, AFTER_DRAIN = false;
    const float* res; float* out; int ldc; bf16_t* XB; float* SSQ; const PG8_LAS float* rtab;
    __device__ __forceinline__ void operator()(const f32x4 (&acc)[2][2][4][2], const Unit& u, int wr, int wc, int fr, int fq) const {
        typedef unsigned u32x2 __attribute__((ext_vector_type(2)));
        const int row0 = u.pm * BM + wr * 64 + fr, col0 = u.pn * BM + wc * 32 + 4 * fq;
#pragma unroll
        for (int ai = 0; ai < 2; ++ai) {
            f32x4 r[4][2][2];
#pragma unroll
            for (int m = 0; m < 4; ++m) { const size_t off = (size_t)(row0 + ai * HALF + m * 16) * ldc + col0;
#pragma unroll
                for (int bj = 0; bj < 2; ++bj)
#pragma unroll
                    for (int n = 0; n < 2; ++n) r[m][bj][n] = *(const f32x4*)(res + off + bj * HALF + n * 16); }
#pragma unroll
            for (int m = 0; m < 4; ++m) { const size_t off = (size_t)(row0 + ai * HALF + m * 16) * ldc + col0;
                const float rsc = rtab ? rtab[u.slot * 256 + ai * HALF + wr * 64 + m * 16 + fr] : 1.0f; float s = 0.f;
#pragma unroll
                for (int bj = 0; bj < 2; ++bj)
#pragma unroll
                    for (int n = 0; n < 2; ++n) { const f32x4 x = acc[ai][bj][m][n] * rsc + r[m][bj][n]; EPI_ST(f32x4, out + off + bj * HALF + n * 16, x);
                        if (XB) { u32x2 w; w.x = pk2_(x[0], x[1]); w.y = pk2_(x[2], x[3]); EPI_ST(u32x2, XB + off + bj * HALF + n * 16, w); }
                        s += (x[0] * x[0] + x[1] * x[1]) + (x[2] * x[2] + x[3] * x[3]); }
                if (XB) { s += __shfl_xor(s, 16); s += __shfl_xor(s, 32);
                    if (fq == 0) SSQ[(size_t)(row0 + ai * HALF + m * 16) * 32 + u.pn * 4 + wc] = s; } }
            asm volatile("" ::: "memory");
        }
    }
};
#if !defined(PART_F32) && !defined(PART_BF16)
#define PART_BF16 1
#endif
struct EpiPart {
    static constexpr bool PERM = false, AFTER_DRAIN = false;
    float* P; int ldc; size_t slab;
    __device__ __forceinline__ void operator()(const f32x4 (&acc)[2][2][4][2], const Unit& u, int wr, int wc, int fr, int fq) const {
        const int row0 = u.pm * BM + wr * 64 + fr, col0 = u.pn * BM + wc * 32 + 4 * fq;
#if defined(PART_BF16)
        typedef unsigned u32x2 __attribute__((ext_vector_type(2)));
        bf16_t* base = (bf16_t*)P + (size_t)u.ks * slab;
#pragma unroll
        for (int ai = 0; ai < 2; ++ai)
#pragma unroll
            for (int m = 0; m < 4; ++m) { bf16_t* rowp = base + (size_t)(row0 + ai * HALF + m * 16) * ldc + col0;
#pragma unroll
                for (int bj = 0; bj < 2; ++bj)
#pragma unroll
                    for (int n = 0; n < 2; ++n) { const f32x4 v = acc[ai][bj][m][n]; u32x2 w; w.x = pk2_(v[0], v[1]); w.y = pk2_(v[2], v[3]); *(u32x2*)(rowp + bj * HALF + n * 16) = w; } }
#else
        float* base = P + (size_t)u.ks * slab;
#pragma unroll
        for (int ai = 0; ai < 2; ++ai)
#pragma unroll
            for (int m = 0; m < 4; ++m) { float* rowp = base + (size_t)(row0 + ai * HALF + m * 16) * ldc + col0;
#pragma unroll
                for (int bj = 0; bj < 2; ++bj)
#pragma unroll
                    for (int n = 0; n < 2; ++n) *(f32x4*)(rowp + bj * HALF + n * 16) = acc[ai][bj][m][n]; }
#endif
    }
};

#ifndef DPP_R1
#define DPP_R1 0x121
#define DPP_R2 0x122
#endif
__device__ __forceinline__ f32x4 dpp_ror4(const f32x4 v, const int which) {
    f32x4 r;
#if defined(DBG_SHFL)
    { const int ln = __lane_id(); const int src = (ln & ~15) | ((ln - which) & 15);
#pragma unroll
      for (int e = 0; e < 4; ++e) r[e] = __shfl(v[e], src);
      return r; }
#endif
#pragma unroll
    for (int e = 0; e < 4; ++e) { const int x = __builtin_bit_cast(int, v[e]);
        r[e] = __builtin_bit_cast(float, which == 1 ? __builtin_amdgcn_update_dpp(0, x, DPP_R1, 0xF, 0xF, false) : __builtin_amdgcn_update_dpp(0, x, DPP_R2, 0xF, 0xF, false)); }
    return r;
}
template <int CTRL> __device__ __forceinline__ f32x4 dpp_mov4(const f32x4 v) {
    f32x4 r;
#pragma unroll
    for (int e = 0; e < 4; ++e) { int x = __builtin_bit_cast(int, v[e]); asm volatile("" : "+v"(x)); int y = __builtin_amdgcn_update_dpp(0, x, CTRL, 0xF, 0xF, true); asm volatile("" : "+v"(y)); r[e] = __builtin_bit_cast(float, y); }
    return r;
}
struct EpiConv {
    static constexpr bool PERM = true, AFTER_DRAIN = false;
    bf16_t* ACT; float* SIDE; float* UPS; float* cvp; const float* cw; const float* cb; int FFd, mp_tiles; const PG8_LAS float* rtab; PG8_LAS float* cwl;
    __device__ __forceinline__ void operator()(f32x4 (&acc)[2][2][4][2], const Unit& u, int wr, int wc, int fr, int fq) const {
        const int F2d = 2 * FFd;
        { float rs[2][4]; rows_rstd_lds(rtab, u, wr, fr, rs);
#pragma unroll
          for (int ai = 0; ai < 2; ++ai)
#pragma unroll
            for (int bj = 0; bj < 2; ++bj)
#pragma unroll
                for (int m = 0; m < 4; ++m)
#pragma unroll
                    for (int n = 0; n < 2; ++n) acc[ai][bj][m][n] = acc[ai][bj][m][n] * rs[ai][m]; }
        const int c0 = u.pn * 128 + wc * 32 + 8 * fq;
#if defined(DBG_CONV_RAW)
        { bf16_t* UPB = (bf16_t*)SIDE; const int row0 = u.pm * BM + wr * 64 + fr;
#pragma unroll
          for (int ai = 0; ai < 2; ++ai)
#pragma unroll
            for (int m = 0; m < 4; ++m) { bf16_t* rp = UPB + (size_t)(row0 + ai * HALF + m * 16) * F2d + c0;
                u32x4 wA, wG; wA.x = pk2_(acc[ai][0][m][0][0], acc[ai][0][m][0][1]); wA.y = pk2_(acc[ai][0][m][0][2], acc[ai][0][m][0][3]); wA.z = pk2_(acc[ai][0][m][1][0], acc[ai][0][m][1][1]); wA.w = pk2_(acc[ai][0][m][1][2], acc[ai][0][m][1][3]);
                wG.x = pk2_(acc[ai][1][m][0][0], acc[ai][1][m][0][1]); wG.y = pk2_(acc[ai][1][m][0][2], acc[ai][1][m][0][3]); wG.z = pk2_(acc[ai][1][m][1][0], acc[ai][1][m][1][1]); wG.w = pk2_(acc[ai][1][m][1][2], acc[ai][1][m][1][3]);
                *(u32x4*)rp = wA; *(u32x4*)(rp + FFd) = wG; }
          return; }
#endif
        if (u.pm >= mp_tiles) {
            const int rloc0 = (u.pm - mp_tiles) * BM + wr * 64 + fr;
#pragma unroll
            for (int ai = 0; ai < 2; ++ai)
#pragma unroll
                for (int m = 0; m < 4; ++m) { float* rp = UPS + (size_t)(rloc0 + ai * HALF + m * 16) * F2d + c0;
#pragma unroll
                    for (int n = 0; n < 2; ++n) { *(f32x4*)(rp + 4 * n) = acc[ai][0][m][n]; *(f32x4*)(rp + FFd + 4 * n) = acc[ai][1][m][n]; } }
            return;
        }
#if !defined(CONV_W_GLOBAL)
        { typedef float f32x2_ __attribute__((ext_vector_type(2)));
          const int t2 = (((wr * 4 + wc) * 64) + fq * 16 + fr) * 2, a = t2 >> 7, col = t2 & 127;
          const float* src = ((a & 3) == 3 ? cb : cw + (size_t)(a & 3) * F2d) + (a >> 2) * FFd + u.pn * 128 + col;
          const f32x2_ v = *(const f32x2_*)src; *(PG8_LAS f32x2_*)(cwl + t2) = v; }
        asm volatile("s_waitcnt lgkmcnt(0)" ::: "memory"); __builtin_amdgcn_s_barrier(); asm volatile("" ::: "memory");
#endif
#pragma unroll
        for (int n = 0; n < 2; ++n) {
            const int c = c0 + 4 * n;
#if !defined(CONV_W_GLOBAL)
            const PG8_LAS float* wl = cwl + wc * 32 + 8 * fq + 4 * n;
            const f32x4 wa0 = *(const PG8_LAS f32x4*)(wl), wa1 = *(const PG8_LAS f32x4*)(wl + 128), wa2 = *(const PG8_LAS f32x4*)(wl + 256), ba = *(const PG8_LAS f32x4*)(wl + 384);
            const f32x4 wg0 = *(const PG8_LAS f32x4*)(wl + 512), wg1 = *(const PG8_LAS f32x4*)(wl + 640), wg2 = *(const PG8_LAS f32x4*)(wl + 768), bg = *(const PG8_LAS f32x4*)(wl + 896);
#else
            const f32x4 wa0 = *(const f32x4*)(cw + c), wa1 = *(const f32x4*)(cw + F2d + c), wa2 = *(const f32x4*)(cw + 2 * F2d + c), ba = *(const f32x4*)(cb + c);
            const f32x4 wg0 = *(const f32x4*)(cw + FFd + c), wg1 = *(const f32x4*)(cw + F2d + FFd + c), wg2 = *(const f32x4*)(cw + 2 * F2d + FFd + c), bg = *(const f32x4*)(cb + FFd + c);
#endif
#pragma unroll
            for (int ai = 0; ai < 2; ++ai) {
                const int blk = u.pm * 4 + ai * 2 + wr;
#pragma unroll
                for (int m = 0; m < 4; ++m) {
                    const f32x4 xa = acc[ai][0][m][n], xg = acc[ai][1][m][n];
                    const f32x4 pa = acc[ai][0][m > 0 ? m - 1 : 0][n], pg = acc[ai][1][m > 0 ? m - 1 : 0][n];
                    const int ln_ = __lane_id(), s1_ = ((ln_ & ~15) | ((ln_ - 1) & 15)) << 2, s2_ = ((ln_ & ~15) | ((ln_ - 2) & 15)) << 2;
                    f32x4 a1c, a2c, g1c, g2c;
#pragma unroll
                    for (int e = 0; e < 4; ++e) {
#if !defined(CONV_BPERMUTE)
                        a1c[e] = __builtin_bit_cast(float, __builtin_amdgcn_update_dpp(0, __builtin_bit_cast(int, fr == 15 ? pa[e] : xa[e]), 0x121, 0xF, 0xF, true));
                        a2c[e] = __builtin_bit_cast(float, __builtin_amdgcn_update_dpp(0, __builtin_bit_cast(int, fr >= 14 ? pa[e] : xa[e]), 0x122, 0xF, 0xF, true));
                        g1c[e] = __builtin_bit_cast(float, __builtin_amdgcn_update_dpp(0, __builtin_bit_cast(int, fr == 15 ? pg[e] : xg[e]), 0x121, 0xF, 0xF, true));
                        g2c[e] = __builtin_bit_cast(float, __builtin_amdgcn_update_dpp(0, __builtin_bit_cast(int, fr >= 14 ? pg[e] : xg[e]), 0x122, 0xF, 0xF, true)); }
#else
                        a1c[e] = __builtin_bit_cast(float, __builtin_amdgcn_ds_bpermute(s1_, __builtin_bit_cast(int, fr == 15 ? pa[e] : xa[e])));
                        a2c[e] = __builtin_bit_cast(float, __builtin_amdgcn_ds_bpermute(s2_, __builtin_bit_cast(int, fr >= 14 ? pa[e] : xa[e])));
                        g1c[e] = __builtin_bit_cast(float, __builtin_amdgcn_ds_bpermute(s1_, __builtin_bit_cast(int, fr == 15 ? pg[e] : xg[e])));
                        g2c[e] = __builtin_bit_cast(float, __builtin_amdgcn_ds_bpermute(s2_, __builtin_bit_cast(int, fr >= 14 ? pg[e] : xg[e]))); }
#endif
                    const f32x4 a1p = a1c, a2p = a2c, g1p = g1c, g2p = g2c;
                    f32x4 o;
#pragma unroll
                    for (int e = 0; e < 4; ++e) {
                        const float a1 = fr == 0 ? a1p[e] : a1c[e], a2 = fr < 2 ? a2p[e] : a2c[e], g1 = fr == 0 ? g1p[e] : g1c[e], g2 = fr < 2 ? g2p[e] : g2c[e];
                        const float ya = ba[e] + wa0[e] * a2 + wa1[e] * a1 + wa2[e] * xa[e], yg = bg[e] + wg0[e] * g2 + wg1[e] * g1 + wg2[e] * xg[e];
                        o[e] = ya * yg * __builtin_amdgcn_rcpf(1.0f + __expf(-yg)); }
                    const int lt = ai * HALF + wr * 64 + m * 16 + fr;
                    if (!(m == 0 && fr < 2)) { typedef unsigned u32x2 __attribute__((ext_vector_type(2))); u32x2 w; w.x = pk2_(o[0], o[1]); w.y = pk2_(o[2], o[3]);
                        *(u32x2*)(ACT + (size_t)(u.pm * BM + lt) * FFd + c) = w; }
                    if (m == 0 && fr < 2) { float* sp = SIDE + ((size_t)blk * 4 + 2 + fr) * F2d + c; *(f32x4*)sp = xa; *(f32x4*)(sp + FFd) = xg; }
                    if (m == 3 && fr >= 14) { float* sp = SIDE + ((size_t)blk * 4 + (fr - 14)) * F2d + c; *(f32x4*)sp = xa; *(f32x4*)(sp + FFd) = xg;
                        if ((u.pm & 7) == 7 && ai == 1 && wr == 1) { float* po = cvp + ((size_t)(u.pm >> 3) * 2 + (fr - 14)) * F2d + c; *(f32x4*)po = xa; *(f32x4*)(po + FFd) = xg; } }
                }
            }
        }
    }
};

template <class Epi, class Sched, bool ALIGN_EPI = false, bool SP2 = false>
__device__ __forceinline__ void gemm_phase(PG8_LAS unsigned char* lds, const Gemm g, const Sched& S, const Epi& E) {
    int tid_ = threadIdx.x; asm volatile("" : "+v"(tid_));
    const int tid = tid_, wid = __builtin_amdgcn_readfirstlane(tid >> 6), lane = tid & 63, wr = wid >> 2, wc = wid & 3, fr = lane & 15, fq = lane >> 4;
    const int K = g.K, nt = K / BK, LD = g.ld;
    unsigned voffA[2], voffB[2];
#pragma unroll
    for (int i = 0; i < 2; ++i) { int R, C; stage_rc(tid * 16 + i * 8192, R, C); const int Rb = Epi::PERM ? ((R & ~31) + perm32(R & 31)) : R;
        voffA[i] = (unsigned)(R * LD + C) * 2u; voffB[i] = (unsigned)(Rb * LD + C) * 2u; }
    const size_t kstep = (size_t)(BK * 2);
    const size_t hstep = (size_t)HALF * LD * 2;
    const size_t tstep = 2 * hstep;
    const unsigned ldsw = (unsigned)wid * 1024u;
    const int aoff = lds_byte(wr * 64 + fr, fq * 8), boff = lds_byte(wc * 32 + fr, fq * 8);
#define PG8_SA(b, h) (((b) * 2 + (h)) * HTB)
#define PG8_SB(b, h) ((4 + (b) * 2 + (h)) * HTB)
#define PG8_STAGE(bufoff, gbase, voff) do { _Pragma("unroll") for (int _i = 0; _i < 2; ++_i) \
        __builtin_amdgcn_global_load_lds((const unsigned*)((const char*)(gbase) + (voff)[_i]), (PG8_LAS unsigned*)(lds + (bufoff) + ldsw + _i * 8192), 16, 0, 0); } while (0)
#define PG8_LDA(dst, b, h) do { _Pragma("unroll") for (int m = 0; m < 4; ++m) _Pragma("unroll") for (int k = 0; k < 2; ++k) dst[m][k] = *(const PG8_LAS bf16x8*)(lds + PG8_SA(b, h) + aoff + m * 2048 + k * 1024); } while (0)
#define PG8_LDB(dst, b, h) do { _Pragma("unroll") for (int n = 0; n < 2; ++n) _Pragma("unroll") for (int k = 0; k < 2; ++k) dst[n][k] = *(const PG8_LAS bf16x8*)(lds + PG8_SB(b, h) + boff + n * 2048 + k * 1024); } while (0)
#define PG8_MMA(ai, bj, At, Bt) do { __builtin_amdgcn_s_setprio(1); _Pragma("unroll") for (int m = 0; m < 4; ++m) _Pragma("unroll") for (int n = 0; n < 2; ++n) _Pragma("unroll") for (int k = 0; k < 2; ++k) \
        acc[ai][bj][m][n] = __builtin_amdgcn_mfma_f32_16x16x32_bf16(Bt[n][k], At[m][k], acc[ai][bj][m][n], 0, 0, 0); __builtin_amdgcn_s_setprio(0); } while (0)
#define PG8_WAIT_V(n) asm volatile("s_waitcnt vmcnt(" #n ")" ::: "memory")
#define PG8_WAIT_L(n) asm volatile("s_waitcnt lgkmcnt(" #n ")" ::: "memory")
#define PG8_BAR __builtin_amdgcn_s_barrier()
#define PG8_SCHED __builtin_amdgcn_sched_barrier(0)
    Unit cur, nxt; int ui = 0;
    if (!S.next(0, cur)) return;
    f32x4 acc[2][2][4][2];
#pragma unroll
    for (int a = 0; a < 2; ++a)
#pragma unroll
        for (int b = 0; b < 2; ++b)
#pragma unroll
            for (int m = 0; m < 4; ++m)
#pragma unroll
                for (int n = 0; n < 2; ++n) acc[a][b][m][n] = (f32x4){0.f, 0.f, 0.f, 0.f};
    bf16x8 At[4][2], B0[2][2], B1[2][2];
    const char* cA = (const char*)g.A + (size_t)cur.pm * tstep + (size_t)cur.kofs * 2; const char* cB = (const char*)g.Bt + (size_t)cur.pn * tstep + (size_t)cur.kofs * 2;
    S.a_ready(cur);
    if constexpr (SP2) {
        PG8_STAGE(PG8_SB(0, 0), cB, voffB); PG8_STAGE(PG8_SB(0, 1), cB + hstep, voffB); PG8_STAGE(PG8_SA(0, 0), cA, voffA); PG8_STAGE(PG8_SA(0, 1), cA + hstep, voffA);
        if (wr == 1) PG8_BAR;
        PG8_WAIT_V(2); PG8_BAR;
        PG8_STAGE(PG8_SB(1, 0), cB + kstep, voffB); PG8_STAGE(PG8_SA(1, 0), cA + kstep, voffA); PG8_STAGE(PG8_SB(1, 1), cB + hstep + kstep, voffB);
        PG8_WAIT_V(6); PG8_BAR;
    } else {
        PG8_STAGE(PG8_SB(0, 0), cB, voffB); PG8_STAGE(PG8_SA(0, 0), cA, voffA); PG8_STAGE(PG8_SB(0, 1), cB + hstep, voffB); PG8_STAGE(PG8_SA(0, 1), cA + hstep, voffA);
        if (wr == 1) PG8_BAR;
        PG8_WAIT_V(4); PG8_BAR;
        PG8_STAGE(PG8_SB(1, 0), cB + kstep, voffB); PG8_STAGE(PG8_SA(1, 0), cA + kstep, voffA); PG8_STAGE(PG8_SB(1, 1), cB + hstep + kstep, voffB);
        PG8_WAIT_V(6); PG8_BAR;
    }
    for (;;) {
        const bool has_next = S.next(ui + 1, nxt);
        const char* nA = has_next ? (const char*)g.A + (size_t)nxt.pm * tstep + (size_t)nxt.kofs * 2 : cA; const char* nB = has_next ? (const char*)g.Bt + (size_t)nxt.pn * tstep + (size_t)nxt.kofs * 2 : cB;
        for (int t = 0; t < nt; t += 2) {
            const bool last = (t == nt - 2);
            const char* a1 = cA + (size_t)(t + 1) * kstep;
            const char* a2 = last ? nA : cA + (size_t)(t + 2) * kstep; const char* b2 = last ? nB : cB + (size_t)(t + 2) * kstep;
            const char* a3 = a2 + kstep; const char* b3 = b2 + kstep;
            if (last && has_next) S.a_ready(nxt);
            if constexpr (SP2) {
            PG8_LDB(B0, 0, 0); PG8_LDB(B1, 0, 1); PG8_SCHED; PG8_LDA(At, 0, 0); PG8_STAGE(PG8_SA(1, 1), a1 + hstep, voffA);
            PG8_WAIT_V(8); PG8_WAIT_L(0); PG8_BAR; PG8_MMA(0, 0, At, B0); PG8_MMA(0, 1, At, B1); PG8_BAR; PG8_SCHED;
            PG8_LDA(At, 0, 1); PG8_STAGE(PG8_SB(0, 0), b2, voffB); PG8_STAGE(PG8_SB(0, 1), b2 + hstep, voffB); PG8_STAGE(PG8_SA(0, 0), a2, voffA);
            PG8_WAIT_V(8); PG8_WAIT_L(0); PG8_BAR; PG8_MMA(1, 0, At, B0); PG8_MMA(1, 1, At, B1); PG8_BAR; PG8_SCHED;
            PG8_LDB(B0, 1, 0); PG8_LDB(B1, 1, 1); PG8_SCHED; PG8_LDA(At, 1, 0); PG8_STAGE(PG8_SA(0, 1), a2 + hstep, voffA);
            PG8_WAIT_V(8); PG8_WAIT_L(0); PG8_BAR; PG8_MMA(0, 0, At, B0); PG8_MMA(0, 1, At, B1); PG8_BAR; PG8_SCHED;
            PG8_LDA(At, 1, 1); PG8_STAGE(PG8_SB(1, 0), b3, voffB); PG8_STAGE(PG8_SB(1, 1), b3 + hstep, voffB); PG8_STAGE(PG8_SA(1, 0), a3, voffA);
            PG8_WAIT_V(8); PG8_WAIT_L(0); PG8_BAR; PG8_MMA(1, 0, At, B0); PG8_MMA(1, 1, At, B1); PG8_BAR; PG8_SCHED;
            } else {
            PG8_LDB(B0, 0, 0); PG8_SCHED; PG8_LDA(At, 0, 0); PG8_STAGE(PG8_SA(1, 1), a1 + hstep, voffA);
            PG8_WAIT_L(8); PG8_BAR; PG8_WAIT_L(0); PG8_MMA(0, 0, At, B0); PG8_BAR; PG8_SCHED;
            PG8_LDB(B1, 0, 1); PG8_STAGE(PG8_SB(0, 0), b2, voffB);
            PG8_BAR; PG8_WAIT_L(0); PG8_MMA(0, 1, At, B1); PG8_BAR;
            PG8_LDA(At, 0, 1); PG8_STAGE(PG8_SA(0, 0), a2, voffA);
            PG8_BAR; PG8_WAIT_L(0); PG8_MMA(1, 0, At, B0); PG8_BAR; PG8_SCHED;
            PG8_STAGE(PG8_SB(0, 1), b2 + hstep, voffB);
            PG8_WAIT_V(6); PG8_BAR; PG8_MMA(1, 1, At, B1); PG8_BAR;
            PG8_LDB(B0, 1, 0); PG8_SCHED; PG8_LDA(At, 1, 0); PG8_STAGE(PG8_SA(0, 1), a2 + hstep, voffA);
            PG8_WAIT_L(8); PG8_BAR; PG8_WAIT_L(0); PG8_MMA(0, 0, At, B0); PG8_BAR; PG8_SCHED;
            PG8_LDB(B1, 1, 1); PG8_STAGE(PG8_SB(1, 0), b3, voffB);
            PG8_BAR; PG8_WAIT_L(0); PG8_MMA(0, 1, At, B1); PG8_BAR;
            PG8_LDA(At, 1, 1); PG8_STAGE(PG8_SA(1, 0), a3, voffA);
            PG8_BAR; PG8_WAIT_L(0); PG8_MMA(1, 0, At, B0); PG8_BAR; PG8_SCHED;
            PG8_STAGE(PG8_SB(1, 1), b3 + hstep, voffB);
            PG8_WAIT_V(6); PG8_BAR; PG8_MMA(1, 1, At, B1); PG8_BAR;
            }
        }
        if constexpr (ALIGN_EPI) { if (wr == 0) PG8_BAR; }
        if constexpr (!Epi::AFTER_DRAIN) { E(acc, cur, wr, wc, fr, fq); S.done(cur); }
        if (!has_next) break;
#pragma unroll
        for (int a = 0; a < 2; ++a)
#pragma unroll
            for (int b = 0; b < 2; ++b)
#pragma unroll
                for (int m = 0; m < 4; ++m)
#pragma unroll
                    for (int n = 0; n < 2; ++n) acc[a][b][m][n] = (f32x4){0.f, 0.f, 0.f, 0.f};
        cur = nxt; cA = nA; cB = nB; ++ui;
        if constexpr (ALIGN_EPI) { if (wr == 1) PG8_BAR; }
    }
    PG8_WAIT_V(0);
    if constexpr (!ALIGN_EPI) { if (wr == 0) PG8_BAR; }
    PG8_BAR;
    if constexpr (Epi::AFTER_DRAIN) { E.fused(acc, cur, wr, wc, fr, fq, lds, wid, lane); S.done(cur); }
#undef PG8_SA
#undef PG8_SB
#undef PG8_STAGE
#undef PG8_LDA
#undef PG8_LDB
#undef PG8_MMA
#undef PG8_WAIT_V
#undef PG8_WAIT_L
#undef PG8_BAR
#undef PG8_SCHED
}
}

#ifndef PG8_SP2
#define PG8_SP2 true
#endif
#ifndef PG8_ALIGN
#define PG8_ALIGN true
#endif

#ifndef SCAN_SPLIT
#define SCAN_SPLIT 4
#endif
#ifndef SCAN_FIRST
#define SCAN_FIRST(w) ((w) >= SCAN_SPLIT)
#endif
#ifndef SCAN_PRIO_POST
#define SCAN_PRIO_POST 1
#endif
#ifndef SCAN_PRIO
#define SCAN_PRIO 1
#endif
constexpr int NWAVES = 8, NTHR = 512;
constexpr int D = 2048, MP = 8192, MS = 512, M = MP + MS, FF = 5632, F2 = 11264;
constexpr int SEQ = 2048, NB = 4, DB = 128, DSQ = 4;
constexpr float EPS = 1e-6f, GATE_CAP = 15.0f;
constexpr size_t O_YP = 0, O_YS = 16777216, O_SP = 17825792, O_SS = 19922944, O_CP = 87031808, O_CS = 88080384, O_NP = 121634816, O_NS = 121638912,
                 O_MP = 121769984, O_MS = 121770016, O_VS = 121771040, O_CVP = 122819616, O_CVS = 123180064, O_END = 134714400;
constexpr size_t MiB = 1u << 20;
constexpr size_t WS_CTL = 0, CTL_ZERO_BYTES = 1 * MiB;
constexpr size_t WS_W = 1 * MiB;
constexpr size_t WS_X = 401 * MiB;
constexpr size_t WS_HB = 469 * MiB;
constexpr size_t WS_PROJ = 503 * MiB;
constexpr size_t WS_OB = 775 * MiB;
constexpr size_t WS_ACT = 809 * MiB;
constexpr size_t WS_SCR = 903 * MiB;
constexpr size_t WS_GATES = 971 * MiB;
constexpr size_t WS_PART = 972 * MiB;
constexpr size_t WS_DENM = 1016 * MiB;
constexpr size_t WS_SSQ = 1017 * MiB;
constexpr size_t WS_OSSQ = 1018 * MiB + 256 * 1024;
constexpr size_t WS_WIN1 = 1019 * MiB;
constexpr size_t WS_END = 1045 * MiB;
constexpr size_t WE_IN0 = 0, WE_OUT0 = 16777216, WE_IN1 = 20971520, WE_OUT1 = 33554432, WE_IN2 = 37748736, WE_OUT2 = 46137344, WE_IN3 = 50331648, WE_OUT3 = 67108864,
                 WE_UP = 71303168, WE_UP_STRIDE = 23068672, WE_DOWN = 163577856, WE_DOWN_STRIDE = 11534336;
constexpr int CW_BAR = 4096, CW_CNT = 200000;
constexpr int RING_BYTES = 131072, LDSCTL_OFF = 146432, MISC_OFF = LDSCTL_OFF + 320, LDS_BYTES = 147456;

#define GAS __attribute__((address_space(1)))
#define LAS __attribute__((address_space(3)))
typedef unsigned short bf16;
typedef unsigned v4u __attribute__((ext_vector_type(4)));
typedef unsigned v2u __attribute__((ext_vector_type(2)));
typedef float f32x4 __attribute__((ext_vector_type(4)));
typedef GAS unsigned gu32;
#define LDS_WAIT() asm volatile("s_waitcnt lgkmcnt(0)" ::: "memory")
#define VM_WAIT() asm volatile("s_waitcnt vmcnt(0)" ::: "memory")
__device__ __forceinline__ unsigned f2bf(float f) { unsigned u = __builtin_bit_cast(unsigned, f); return (u + 0x7fffu + ((u >> 16) & 1u)) >> 16; }
typedef float f32x2_t __attribute__((ext_vector_type(2)));
typedef __bf16 bf16x2_t __attribute__((ext_vector_type(2)));
__device__ __forceinline__ unsigned pk2(float lo, float hi) { f32x2_t v; v.x = lo; v.y = hi; return __builtin_bit_cast(unsigned, __builtin_convertvector(v, bf16x2_t)); }
__device__ __forceinline__ float bf2f(unsigned short b) { return __builtin_bit_cast(float, ((unsigned)b) << 16); }
__device__ __forceinline__ float sigm(float x) { return __builtin_amdgcn_rcpf(1.0f + __expf(-x)); }

#define XB_TMO      128
#define XB_XCNT(j)  (256  + 64 * (j))
#define XB_XSUB(j)  (1280 + 64 * (j))
#define XB_XGEN(j)  (2304 + 64 * (j))
#define XB_TOP      3328
#define XB_TOPGEN   3392
#define XCD_BAR_WORDS 3456
#define XB_SPIN_CAP (1u << 18)
__device__ __forceinline__ unsigned xb_ld(unsigned* p)              { return __hip_atomic_load(p, __ATOMIC_RELAXED, __HIP_MEMORY_SCOPE_AGENT); }
__device__ __forceinline__ unsigned xb_add(unsigned* p, unsigned v) { return __hip_atomic_fetch_add(p, v, __ATOMIC_RELAXED, __HIP_MEMORY_SCOPE_AGENT); }
__device__ __forceinline__ unsigned xb_xcc_id() { return (unsigned)__builtin_amdgcn_s_getreg((3 << 11) | 20) & 0xFu; }
#define XB_SPIN(cond, bar) do { unsigned _sp = 0; while (cond) { __builtin_amdgcn_s_sleep(1); \
    if ((++_sp & 255u) == 0u) { if (xb_ld(&(bar)[XB_TMO])) break; if (_sp > XB_SPIN_CAP) { atomicAdd(&(bar)[XB_TMO], 1u); break; } } } } while (0)
struct XcdBarrier { unsigned* bar; unsigned x; volatile LAS unsigned* st; };
__device__ __forceinline__ XcdBarrier xcd_barrier_post(unsigned* bar, volatile LAS unsigned* st) {
    XcdBarrier b; b.bar = bar; b.x = xb_xcc_id(); b.st = st;
    if (threadIdx.x == 0) (void)xb_add(&bar[XB_XCNT(b.x)], 1u);
    return b;
}
__device__ __forceinline__ void xcd_barrier_complete(unsigned* bar, unsigned x, unsigned& nloc, unsigned& nx) {
    const unsigned G = gridDim.x * gridDim.y * gridDim.z;
    unsigned sum, cnt, mine, sp = 0u;
    for (;;) {
        sum = 0u; cnt = 0u; mine = 0u;
#pragma unroll
        for (unsigned j = 0; j < 16; ++j) { const unsigned c = xb_ld(&bar[XB_XCNT(j)]); sum += c; cnt += (c > 0u) ? 1u : 0u; mine = (j == x) ? c : mine; }
        if (sum == G) break;
        __builtin_amdgcn_s_sleep(1);
        if ((++sp & 255u) == 0u) { if (xb_ld(&bar[XB_TMO])) break; if (sp > XB_SPIN_CAP) { atomicAdd(&bar[XB_TMO], 1u); break; } }
    }
    nloc = mine > 0u ? mine : 1u; nx = cnt > 0u ? cnt : 1u;
}
__device__ __forceinline__ void xcd_barrier(const XcdBarrier& b) {
    asm volatile("s_waitcnt vmcnt(0)" ::: "memory");
    __syncthreads();
    if (threadIdx.x == 0) {
        unsigned* bar = b.bar;
        __builtin_amdgcn_s_waitcnt(0);
        unsigned nloc = b.st[0], nx = b.st[1];
        if (nloc == 0u) { xcd_barrier_complete(bar, b.x, nloc, nx); b.st[0] = nloc; b.st[1] = nx; }
        const unsigned old = xb_add(&bar[XB_XSUB(b.x)], 1u);
        const unsigned gen = old / nloc;
        if (old + 1u == (gen + 1u) * nloc) {
            __builtin_amdgcn_fence(__ATOMIC_RELEASE, "agent");
            asm volatile("s_waitcnt vmcnt(0)" ::: "memory");
            const unsigned og = xb_add(&bar[XB_TOP], 1u);
            const unsigned tg = og / nx;
            if (og + 1u == (tg + 1u) * nx) xb_add(&bar[XB_TOPGEN], 1u);
            else XB_SPIN(xb_ld(&bar[XB_TOPGEN]) == tg, bar);
            __builtin_amdgcn_fence(__ATOMIC_ACQUIRE, "agent");
            xb_add(&bar[XB_XGEN(b.x)], 1u);
            asm volatile("s_waitcnt vmcnt(0)" ::: "memory");
        } else {
            XB_SPIN(xb_ld(&bar[XB_XGEN(b.x)]) == gen, bar);
            __builtin_amdgcn_fence(__ATOMIC_ACQUIRE, "agent");
            asm volatile("s_waitcnt vmcnt(0)" ::: "memory");
        }
    }
    __syncthreads();
}

struct Frame {
    LAS unsigned char* lds;
    volatile LAS unsigned* MISC;
    int tid, lane, wave;
    int vcu, G;
    const float* const* in;
    float* out; unsigned char* ws;
};
__device__ __forceinline__ float wave_sum(float v) {
#pragma unroll
    for (int o = 1; o < 64; o <<= 1) v += __shfl_xor(v, o);
    return v;
}
__device__ __forceinline__ float row16_sum(float v) {
    v += __builtin_bit_cast(float, __builtin_amdgcn_update_dpp(0, __builtin_bit_cast(int, v), 0xB1, 0xF, 0xF, true));
    v += __builtin_bit_cast(float, __builtin_amdgcn_update_dpp(0, __builtin_bit_cast(int, v), 0x4E, 0xF, 0xF, true));
    v += __builtin_bit_cast(float, __builtin_amdgcn_update_dpp(0, __builtin_bit_cast(int, v), 0x141, 0xF, 0xF, true));
    v += __builtin_bit_cast(float, __builtin_amdgcn_update_dpp(0, __builtin_bit_cast(int, v), 0x140, 0xF, 0xF, true));
    return v;
}
struct MatDesc { const float* W; const float* gain; bf16* WT; int K, N, row_off; float scale; int item_end, perm; };
constexpr int N_MAT = 25, DESC_OFF = 135168;
__device__ __forceinline__ void p0_transpose_item(const float* W, const float* gain, float scale, int K, int N, bf16* WT, int row_off, int perm, LAS float* scr, int item, int lane) {
    const int nblk = N / 64, kb = item / nblk, nb = item % nblk, k0 = 64 * kb, n0 = 64 * nb;
    const int d0 = !perm ? n0 : (n0 < FF ? (n0 >> 7) * 256 + (n0 & 127) : ((n0 - FF) >> 7) * 256 + 128 + ((n0 - FF) & 127));
    const int lr = lane >> 4, lc = (lane & 15) * 4;
    f32x4 w[16];
#pragma unroll
    for (int i = 0; i < 16; ++i) w[i] = __builtin_nontemporal_load((const GAS f32x4*)(W + (size_t)(k0 + 4 * i + lr) * N + n0 + lc));
#pragma unroll
    for (int i = 0; i < 16; ++i) { const int kk = 4 * i + lr; const float g = gain ? gain[k0 + kk] * scale : scale;
        LAS float* d = scr + kk * 65 + lc; d[0] = w[i].x * g; d[1] = w[i].y * g; d[2] = w[i].z * g; d[3] = w[i].w * g; }
    LDS_WAIT(); asm volatile("" ::: "memory");
    const int c = lane >> 3, nl = lane & 7;
#pragma unroll
    for (int j = 0; j < 8; ++j) { const int n = nl + 8 * j; const LAS float* s = scr + (8 * c) * 65 + n;
        v4u o; o.x = pk2(s[0 * 65], s[1 * 65]); o.y = pk2(s[2 * 65], s[3 * 65]); o.z = pk2(s[4 * 65], s[5 * 65]); o.w = pk2(s[6 * 65], s[7 * 65]);
        *(GAS v4u*)(WT + (size_t)(row_off + d0 + n) * K + k0 + 8 * c) = o; }
    LDS_WAIT(); asm volatile("" ::: "memory");
}
#define SET_DESC(idx, Wp, gp, WTp, Kv, Nv, ro, sc) SET_DESCP(idx, Wp, gp, WTp, Kv, Nv, ro, sc, 0)
#define SET_DESCP(idx, Wp, gp, WTp, Kv, Nv, ro, sc, pm_) do { LAS MatDesc* d_ = desc + (idx); d_->W = (Wp); d_->gain = (gp); d_->WT = (WTp); d_->K = (Kv); d_->N = (Nv); d_->row_off = (ro); d_->scale = (sc); \
    tot_ += ((Kv) / 64) * ((Nv) / 64); d_->item_end = tot_; d_->perm = (pm_); } while (0)

__device__ __forceinline__ void norm_rows(Frame& F, int mode, int nparts, const float* xp, const float* xs, const float* gain, const float* w_if, const float* b_if) {
    float* X = (float*)(F.ws + WS_X); bf16* HB = (bf16*)(F.ws + WS_HB); float* GATES = (float*)(F.ws + WS_GATES);
    const int gw = F.vcu * NWAVES + F.wave, NGW = F.G * NWAVES, lane = F.lane;
    for (int m = gw; m < M; m += NGW) {
        const float* src = (mode & 1) ? (m < MP ? xp + (size_t)m * D : xs + (size_t)(m - MP) * D) : X + (size_t)m * D;
        const GAS f32x4* xr = (const GAS f32x4*)src + lane;
        f32x4 v[8]; float ss = 0.f;
#pragma unroll
        for (int j = 0; j < 8; ++j) v[j] = xr[64 * j];
        __builtin_amdgcn_sched_barrier(0);
#pragma unroll
        for (int j = 0; j < 8; ++j) ss += (v[j].x * v[j].x + v[j].y * v[j].y) + (v[j].z * v[j].z + v[j].w * v[j].w);
        if ((mode & 8) && m >= MP) {
            const GAS f32x4* pr = (const GAS f32x4*)((const float*)(F.ws + WS_PART) + (size_t)(m - MP) * D) + lane;
            for (int p = 0; p < nparts; ++p) {
#pragma unroll
                for (int j = 0; j < 8; ++j) v[j] += pr[(size_t)p * (MS * D / 4) + 64 * j]; }
            ss = 0.f; GAS f32x4* xo = (GAS f32x4*)(X + (size_t)m * D) + lane;
#pragma unroll
            for (int j = 0; j < 8; ++j) { xo[64 * j] = v[j]; ss += (v[j].x * v[j].x + v[j].y * v[j].y) + (v[j].z * v[j].z + v[j].w * v[j].w); }
        }
        const float wave_sum_keep = wave_sum(ss);
        const float rstd = 1.0f / sqrtf(wave_sum_keep * (1.0f / D) + EPS);
        if ((mode & 1) && !(mode & 32)) { GAS f32x4* xo = (GAS f32x4*)(X + (size_t)m * D) + lane;
#pragma unroll
            for (int j = 0; j < 8; ++j) xo[64 * j] = v[j]; }
        if (mode & 2) { GAS f32x4* yo = (GAS f32x4*)(F.out + (size_t)m * D) + lane; const GAS f32x4* g4 = (const GAS f32x4*)gain + lane;
            f32x4 gq[8];
#pragma unroll
            for (int j = 0; j < 8; ++j) gq[j] = g4[64 * j];
#pragma unroll
            for (int j = 0; j < 8; ++j) yo[64 * j] = v[j] * rstd * gq[j]; }
        else { GAS v2u* ho = (GAS v2u*)(HB + (size_t)m * D) + lane; const float sc_ = (mode & 16) ? 1.0f : rstd;
#pragma unroll
            for (int j = 0; j < 8; ++j) { v2u w; w.x = pk2(v[j].x * sc_, v[j].y * sc_); w.y = pk2(v[j].z * sc_, v[j].w * sc_); ho[64 * j] = w; }
            if ((mode & 16) && lane < 32) ((float*)(F.ws + WS_SSQ))[(size_t)m * 32 + lane] = lane == 0 ? wave_sum_keep : 0.f; }
    }
}

__device__ __forceinline__ float hgrn_lb(int j, const float* lbp, int c) { return j == 0 ? 0.f : fmaxf(sigm(lbp[2048 + c] - lbp[c]), 0.f); }
constexpr int RTAB_OFF = 136448, RTAB_SLOTS = 6;
template <class Sched> __device__ __forceinline__ void fill_rstd_table16(Frame& F, const Sched& S) {
    const float* OSSQ = (const float*)(F.ws + WS_OSSQ); LAS float* tab = (LAS float*)(F.lds + RTAB_OFF);
    pg8::Unit u;
    for (int i = 0; i < RTAB_SLOTS && S.next(i, u); ++i) {
        const int r = F.tid >> 1, hf = F.tid & 1; const float* p = OSSQ + ((size_t)u.pm * 256 + r) * 16 + hf * 8;
        const f32x4 a = *(const GAS f32x4*)p, b = *(const GAS f32x4*)(p + 4);
        float s = ((a.x + a.y) + (a.z + a.w)) + ((b.x + b.y) + (b.z + b.w));
        s += __shfl_xor(s, 1);
        if (hf == 0) tab[i * 256 + r] = 1.0f / sqrtf(s * (1.0f / D) + EPS);
    }
    __syncthreads();
}
template <class Sched> __device__ __forceinline__ void fill_rstd_table(Frame& F, const Sched& S) {
    const float* SSQ = (const float*)(F.ws + WS_SSQ); LAS float* tab = (LAS float*)(F.lds + RTAB_OFF);
    pg8::Unit u;
    for (int i = 0; i < RTAB_SLOTS && S.next(i, u); ++i) {
        const int r = F.tid >> 1, hf = F.tid & 1; const float* p = SSQ + ((size_t)u.pm * 256 + r) * 32 + hf * 16;
        const f32x4 a = *(const GAS f32x4*)p, b = *(const GAS f32x4*)(p + 4), c = *(const GAS f32x4*)(p + 8), d = *(const GAS f32x4*)(p + 12);
        float s = (((a.x + a.y) + (a.z + a.w)) + ((b.x + b.y) + (b.z + b.w))) + (((c.x + c.y) + (c.z + c.w)) + ((d.x + d.y) + (d.z + d.w)));
        s += __shfl_xor(s, 1);
        if (hf == 0) tab[i * 256 + r] = 1.0f / sqrtf(s * (1.0f / D) + EPS);
    }
    __syncthreads();
}
template <int NK> __device__ __forceinline__ void part_sum16(const float* PARTf, size_t eoff, size_t stride, f32x4 (&ps)[4]) {
    const bf16* pp = (const bf16*)PARTf + eoff; v4u a[NK], b[NK];
#pragma unroll
    for (int k = 0; k < NK; ++k) { a[k] = *(const GAS v4u*)(pp + (size_t)k * stride); b[k] = *(const GAS v4u*)(pp + (size_t)k * stride + 8); }
#pragma unroll
    for (int q = 0; q < 4; ++q) ps[q] = (f32x4){0.f, 0.f, 0.f, 0.f};
#pragma unroll
    for (int k = 0; k < NK; ++k) {
        ps[0] += (f32x4){__builtin_bit_cast(float, a[k].x << 16), __builtin_bit_cast(float, a[k].x & 0xffff0000u), __builtin_bit_cast(float, a[k].y << 16), __builtin_bit_cast(float, a[k].y & 0xffff0000u)};
        ps[1] += (f32x4){__builtin_bit_cast(float, a[k].z << 16), __builtin_bit_cast(float, a[k].z & 0xffff0000u), __builtin_bit_cast(float, a[k].w << 16), __builtin_bit_cast(float, a[k].w & 0xffff0000u)};
        ps[2] += (f32x4){__builtin_bit_cast(float, b[k].x << 16), __builtin_bit_cast(float, b[k].x & 0xffff0000u), __builtin_bit_cast(float, b[k].y << 16), __builtin_bit_cast(float, b[k].y & 0xffff0000u)};
        ps[3] += (f32x4){__builtin_bit_cast(float, b[k].z << 16), __builtin_bit_cast(float, b[k].z & 0xffff0000u), __builtin_bit_cast(float, b[k].w << 16), __builtin_bit_cast(float, b[k].w & 0xffff0000u)}; }
}
template <int NK> __device__ __forceinline__ void sample_reduce(Frame& F, const pg8::SplitOrder& S, unsigned* cnt, const float* res_s  , const float* oss  ) {
    constexpr int nK = NK;
    float* X = (float*)(F.ws + WS_X); bf16* XB = (bf16*)(F.ws + WS_HB); float* SSQ = (float*)(F.ws + WS_SSQ); const float* PART = (const float*)(F.ws + WS_PART);
    pg8::Unit u;
    if (!S.next(0, u)) return;
    asm volatile("s_waitcnt vmcnt(0)" ::: "memory"); __syncthreads();
    if (F.tid == 0) {
        __builtin_amdgcn_fence(__ATOMIC_RELEASE, "agent"); asm volatile("s_waitcnt vmcnt(0)" ::: "memory");
        for (int i = 0; S.next(i, u); ++i) (void)__hip_atomic_fetch_add(cnt + (u.pm * 8 + u.pn) * 64, 1u, __ATOMIC_RELAXED, __HIP_MEMORY_SCOPE_AGENT);
    }
    const int RS = (256 + nK - 1) / nK;
    for (int i = 0; S.next(i, u); ++i) {
        if (F.tid == 0) {
            unsigned* c = cnt + (u.pm * 8 + u.pn) * 64; unsigned sp = 0;
            while (__hip_atomic_load(c, __ATOMIC_RELAXED, __HIP_MEMORY_SCOPE_AGENT) < (unsigned)nK) { __builtin_amdgcn_s_sleep(1); if (++sp > (1u << 22)) break; }
            __builtin_amdgcn_fence(__ATOMIC_ACQUIRE, "agent"); asm volatile("s_waitcnt vmcnt(0)" ::: "memory");
        }
        __syncthreads();
        const int r0 = u.ks * RS, r1 = (r0 + RS) < 256 ? (r0 + RS) : 256;
        for (int rb = r0; rb < r1; rb += 32) {
            const int rl = rb + (F.tid >> 4); const int cc = (F.tid & 15) * 16;
            float s = 0.f;
            if (rl < r1) {
                const size_t srow = (size_t)u.pm * 256 + rl; const size_t off = srow * D + u.pn * 256 + cc;
                f32x4 x[4], ps[4]; float rsc = 1.0f;
                if (oss) { const float* op_ = oss + ((size_t)MP + srow) * 16; const f32x4 a_ = *(const GAS f32x4*)op_, b_ = *(const GAS f32x4*)(op_ + 4), c_ = *(const GAS f32x4*)(op_ + 8), d_ = *(const GAS f32x4*)(op_ + 12);
                    const float t_ = (((a_.x + a_.y) + (a_.z + a_.w)) + ((b_.x + b_.y) + (b_.z + b_.w))) + (((c_.x + c_.y) + (c_.z + c_.w)) + ((d_.x + d_.y) + (d_.z + d_.w))); rsc = 1.0f / sqrtf(t_ * (1.0f / D) + EPS); }
#pragma unroll
                for (int q = 0; q < 4; ++q) x[q] = *(const GAS f32x4*)(res_s + off + 4 * q);
                part_sum16<NK>(PART, off, (size_t)MS * D, ps);
#pragma unroll
                for (int q = 0; q < 4; ++q) x[q] += ps[q] * rsc;
#pragma unroll
                for (int q = 0; q < 4; ++q) { *(GAS f32x4*)(X + (size_t)MP * D + off + 4 * q) = x[q];
                    v2u w; w.x = pk2(x[q].x, x[q].y); w.y = pk2(x[q].z, x[q].w); *(GAS v2u*)(XB + (size_t)MP * D + off + 4 * q) = w;
                    s += (x[q].x * x[q].x + x[q].y * x[q].y) + (x[q].z * x[q].z + x[q].w * x[q].w); }
            }
            s = row16_sum(s);
            if (rl < r1 && (F.tid & 15) == 0) { float* sq = SSQ + ((size_t)MP + (size_t)u.pm * 256 + rl) * 32 + u.pn * 4; *(GAS f32x4*)sq = (f32x4){s, 0.f, 0.f, 0.f}; }
        }
    }
}
__device__ __forceinline__ void sample_reduce_rows(Frame& F, int nK) {
    float* X = (float*)(F.ws + WS_X); bf16* XB = (bf16*)(F.ws + WS_HB); float* SSQ = (float*)(F.ws + WS_SSQ); const float* PART = (const float*)(F.ws + WS_PART);
    const int gw = F.vcu * NWAVES + F.wave, NGW = F.G * NWAVES, lane = F.lane;
    for (int r = gw; r < MS; r += NGW) {
        f32x4 v[8]; float ss = 0.f;
#pragma unroll
        for (int j = 0; j < 8; ++j) v[j] = ((const GAS f32x4*)(X + (size_t)(MP + r) * D) + lane)[64 * j];
        for (int k = 0; k < nK; ++k) {
#pragma unroll
            for (int j = 0; j < 8; ++j) v[j] += ((const GAS f32x4*)(PART + (size_t)k * MS * D + (size_t)r * D) + lane)[64 * j]; }
#pragma unroll
        for (int j = 0; j < 8; ++j) { ((GAS f32x4*)(X + (size_t)(MP + r) * D) + lane)[64 * j] = v[j];
            v2u w; w.x = pk2(v[j].x, v[j].y); w.y = pk2(v[j].z, v[j].w); ((GAS v2u*)(XB + (size_t)(MP + r) * D) + lane)[64 * j] = w;
            ss += (v[j].x * v[j].x + v[j].y * v[j].y) + (v[j].z * v[j].z + v[j].w * v[j].w); }
        ss = wave_sum(ss);
        if (lane < 32) SSQ[(size_t)(MP + r) * 32 + lane] = lane == 0 ? ss : 0.f;
    }
}
template <int NK> __device__ __forceinline__ void sample_reduce_proj(Frame& F, const pg8::SplitOrder& S, unsigned* cnt, int Ncols, const float* bias) {
    constexpr int nK = NK;
    float* PROJ = (float*)(F.ws + WS_PROJ); const float* SSQ = (const float*)(F.ws + WS_SSQ); const float* PART = (const float*)(F.ws + WS_SCR);
    pg8::Unit u;
    if (!S.next(0, u)) return;
    asm volatile("s_waitcnt vmcnt(0)" ::: "memory"); __syncthreads();
    if (F.tid == 0) {
        __builtin_amdgcn_fence(__ATOMIC_RELEASE, "agent"); asm volatile("s_waitcnt vmcnt(0)" ::: "memory");
        for (int i = 0; S.next(i, u); ++i) (void)__hip_atomic_fetch_add(cnt + (u.pm * S.nN + u.pn) * 64, 1u, __ATOMIC_RELAXED, __HIP_MEMORY_SCOPE_AGENT);
    }
    const int RS = (256 + nK - 1) / nK;
    for (int i = 0; S.next(i, u); ++i) {
        if (F.tid == 0) {
            unsigned* c = cnt + (u.pm * S.nN + u.pn) * 64; unsigned sp = 0;
            while (__hip_atomic_load(c, __ATOMIC_RELAXED, __HIP_MEMORY_SCOPE_AGENT) < (unsigned)nK) { __builtin_amdgcn_s_sleep(1); if (++sp > (1u << 22)) break; }
            __builtin_amdgcn_fence(__ATOMIC_ACQUIRE, "agent"); asm volatile("s_waitcnt vmcnt(0)" ::: "memory");
        }
        __syncthreads();
        const int r0 = u.ks * RS, r1 = (r0 + RS) < 256 ? (r0 + RS) : 256;
        for (int rb = r0; rb < r1; rb += 32) {
            const int rl = rb + (F.tid >> 4); const int cc = (F.tid & 15) * 16;
            if (rl < r1) {
                const size_t srow = (size_t)u.pm * 256 + rl; const size_t col = (size_t)u.pn * 256 + cc;
                const float* sq = SSQ + ((size_t)MP + srow) * 32; float t_ = 0.f;
#pragma unroll
                for (int q = 0; q < 8; ++q) { const f32x4 a_ = *(const GAS f32x4*)(sq + 4 * q); t_ += (a_.x + a_.y) + (a_.z + a_.w); }
                const float rsc = 1.0f / sqrtf(t_ * (1.0f / D) + EPS);
                f32x4 ps[4], bq[4];
#pragma unroll
                for (int q = 0; q < 4; ++q) bq[q] = bias ? *(const GAS f32x4*)(bias + col + 4 * q) : (f32x4){0.f, 0.f, 0.f, 0.f};
                part_sum16<NK>(PART, (size_t)srow * Ncols + col, (size_t)MS * Ncols, ps);
#pragma unroll
                for (int q = 0; q < 4; ++q) { const f32x4 o = ps[q] * rsc + bq[q];
                    *(GAS f32x4*)(PROJ + ((size_t)MP + srow) * Ncols + col + 4 * q) = o; }
            }
        }
    }
}
typedef short bf16x8 __attribute__((ext_vector_type(8)));
typedef unsigned long long u64;
__device__ __forceinline__ bf16x8 mk_bf16x8(u64 lo, u64 hi) { typedef u64 u64x2 __attribute__((ext_vector_type(2))); u64x2 t; t.x = lo; t.y = hi; return __builtin_bit_cast(bf16x8, t); }
__device__ __forceinline__ bf16x8 pack8(const f32x4 a, const f32x4 b) { v4u w; w.x = pk2(a.x, a.y); w.y = pk2(a.z, a.w); w.z = pk2(b.x, b.y); w.w = pk2(b.z, b.w); return __builtin_bit_cast(bf16x8, w); }
#define MFMA16(a, b, c) __builtin_amdgcn_mfma_f32_16x16x32_bf16((a), (b), (c), 0, 0, 0)
__device__ __forceinline__ void hgrn_scan_mfma(Frame& F, int j, const float* lbp, const float* onorm, int item) {
    const float* proj = (const float*)(F.ws + WS_PROJ); bf16* OB = (bf16*)(F.ws + WS_OB); float* OSSQ = (float*)(F.ws + WS_OSSQ);
    LAS unsigned char* L = F.lds;
    const int tid = F.tid, lane = F.lane, w = F.wave;
    constexpr int CH = 32, NCH = SEQ / CH, QT = 0, KT = 8704, KH = 17408, VT = 27648, GG = 37888, PBUF = 38400, TOT = 76800;
    const int b = item >> 4, h = item & 15;
    const size_t row0 = (size_t)b * SEQ;
    const unsigned upk = (unsigned)(((w & 1) << 6) | lane);
    const int tq = w >> 1, pk = ((w & 1) << 6) | lane;
    const int lr = lane & 15, g = lane >> 4;
    const float lb = hgrn_lb(j, lbp, h * 128 + pk), omlb = 1.f - lb;
    const float on_ = onorm[h * 128 + 16 * w + lr];
    float gpre[8];
    constexpr int OSSL = 80896;
    float kv[8], qv[8], lc[8], vv[8], rf[8], rq[8], rv[8];
    f32x4 S[8];
#pragma unroll
    for (int i = 0; i < 8; ++i) S[i] = (f32x4){0.f, 0.f, 0.f, 0.f};
#define HG2_LOAD(c) do { _Pragma("unroll") for (int i = 0; i < 8; ++i) { const float* p_ = proj + (row0 + (c) * CH + 8 * tq + i) * 8192 + h * 128; rq[i] = p_[upk]; rf[i] = p_[2048u + upk]; rv[i] = p_[4096u + upk]; } } while (0)
#define HG2_P1(c) do { float run_ = 0.f; _Pragma("unroll") for (int i = 0; i < 8; ++i) { const float e_ = __expf(fminf(-rf[i], 80.f)), r_ = __builtin_amdgcn_rcpf(1.0f + e_); \
            kv[i] = omlb * e_ * r_; run_ += __builtin_amdgcn_logf(lb + omlb * r_); lc[i] = run_;     qv[i] = rq[i] * __builtin_amdgcn_rcpf(1.0f + __expf(fminf(-rq[i], 80.f))); vv[i] = rv[i]; } \
            *(LAS float*)(L + TOT + (((c) & 1) * 512 + tq * 128 + pk) * 4) = run_; } while (0)
#define HG2_P2(c) do { LAS unsigned char* P_ = L + ((c) & 1) * PBUF; const LAS float* T_ = (const LAS float*)(L + TOT + ((c) & 1) * 2048); \
            const float t0_ = T_[pk], t1_ = T_[128 + pk], t2_ = T_[256 + pk], t3_ = T_[384 + pk]; \
            const float off_ = tq == 0 ? 0.f : tq == 1 ? t0_ : tq == 2 ? t0_ + t1_ : t0_ + t1_ + t2_, bL_ = (t0_ + t1_) + (t2_ + t3_), gL_ = __builtin_amdgcn_exp2f(bL_); \
            float kh_[8]; _Pragma("unroll") for (int i = 0; i < 8; ++i) { const float b_ = off_ + lc[i]; \
                { const float x_ = qv[i] * __builtin_amdgcn_exp2f(b_); *(LAS unsigned short*)(P_ + QT + (8 * tq + i) * 272 + pk * 2) = (unsigned short)pk2(x_, x_); } \
                { const float x_ = kv[i] * __builtin_amdgcn_exp2f(fminf(-b_, 115.4f)); *(LAS unsigned short*)(P_ + KT + (8 * tq + i) * 272 + pk * 2) = (unsigned short)pk2(x_, x_); kh_[i] = x_ * gL_; } } \
            { v4u o_; o_.x = pk2(kh_[0], kh_[1]); o_.y = pk2(kh_[2], kh_[3]); o_.z = pk2(kh_[4], kh_[5]); o_.w = pk2(kh_[6], kh_[7]); *(LAS v4u*)(P_ + KH + pk * 80 + tq * 16) = o_; } \
            { v4u o_; o_.x = pk2(vv[0], vv[1]); o_.y = pk2(vv[2], vv[3]); o_.z = pk2(vv[4], vv[5]); o_.w = pk2(vv[6], vv[7]); *(LAS v4u*)(P_ + VT + pk * 80 + tq * 16) = o_; } \
            if (tq == 0) *(LAS float*)(P_ + GG + pk * 4) = gL_; } while (0)
#define HG2_M(n) do         { \
            const LAS unsigned char* P = L + (n & 1) * PBUF; \
            f32x4 at00 = (f32x4){0.f, 0.f, 0.f, 0.f}, at01 = at00, at11 = at00, o0 = at00, o1 = at00; \
_Pragma("unroll") \
            for (int kk = 0; kk < 4; ++kk) { \
                const bf16x8 a0 = *(const LAS bf16x8*)(P + KT + lr * 272 + kk * 64 + g * 16), a1 = *(const LAS bf16x8*)(P + KT + (16 + lr) * 272 + kk * 64 + g * 16); \
                const bf16x8 b0 = *(const LAS bf16x8*)(P + QT + lr * 272 + kk * 64 + g * 16), b1 = *(const LAS bf16x8*)(P + QT + (16 + lr) * 272 + kk * 64 + g * 16); \
                at00 = MFMA16(a0, b0, at00); at01 = MFMA16(a0, b1, at01); at11 = MFMA16(a1, b1, at11); \
                const bf16x8 sb = pack8(S[2 * kk], S[2 * kk + 1]); \
                const bf16x8 qa0 = mk_bf16x8(*(const LAS u64*)(P + QT + lr * 272 + kk * 64 + g * 8), *(const LAS u64*)(P + QT + lr * 272 + kk * 64 + 32 + g * 8)); \
                const bf16x8 qa1 = mk_bf16x8(*(const LAS u64*)(P + QT + (16 + lr) * 272 + kk * 64 + g * 8), *(const LAS u64*)(P + QT + (16 + lr) * 272 + kk * 64 + 32 + g * 8)); \
                o0 = MFMA16(qa0, sb, o0); o1 = MFMA16(qa1, sb, o1); \
            } \
_Pragma("unroll") \
            for (int r = 0; r < 4; ++r) { const bool keep = (4 * g + r) <= lr; at00[r] = keep ? at00[r] : 0.f; at11[r] = keep ? at11[r] : 0.f; } \
            const f32x4 zero4 = (f32x4){0.f, 0.f, 0.f, 0.f}; \
            const bf16x8 pa0 = pack8(at00, zero4), pa1 = pack8(at01, at11); \
            const int vcol = 16 * w + lr; \
            const bf16x8 vb = mk_bf16x8(*(const LAS u64*)(P + VT + vcol * 80 + g * 8), *(const LAS u64*)(P + VT + vcol * 80 + 32 + g * 8)); \
            o0 = MFMA16(pa0, vb, o0); o1 = MFMA16(pa1, vb, o1); \
            { const float* gp = proj + (row0 + n * CH + 4 * g) * 8192 + 6144 + h * 128 + vcol; bf16* ob = OB + (row0 + n * CH + 4 * g) * D + h * 128 + vcol; \
              LAS float* osl = (LAS float*)(L + OSSL) + (n & 1) * 256; \
_Pragma("unroll") \
              for (int r = 0; r < 4; ++r) { const float g0 = gpre[r], g1 = gpre[4 + r]; \
                const float y0 = o0[r] * on_ * __builtin_amdgcn_rcpf(1.0f + __expf(-g0)), y1 = o1[r] * on_ * __builtin_amdgcn_rcpf(1.0f + __expf(-g1)); \
                ob[(size_t)r * D] = (bf16)pk2(y0, y0); ob[(size_t)(16 + r) * D] = (bf16)pk2(y1, y1); \
                const float q0 = row16_sum(o0[r] * o0[r]), q1 = row16_sum(o1[r] * o1[r]); \
                if (lr == 0) { osl[(4 * g + r) * 8 + w] = q0; osl[(16 + 4 * g + r) * 8 + w] = q1; } } \
              if (n + 1 < NCH) { _Pragma("unroll") for (int r = 0; r < 4; ++r) { gpre[r] = gp[(size_t)(CH + r) * 8192]; gpre[4 + r] = gp[(size_t)(CH + 16 + r) * 8192]; } } } \
            const bf16x8 vn = *(const LAS bf16x8*)(P + VT + vcol * 80 + g * 16); \
_Pragma("unroll") \
            for (int kt = 0; kt < 8; ++kt) { \
                const f32x4 gk = *(const LAS f32x4*)(P + GG + (16 * kt + 4 * g) * 4); \
                const bf16x8 ka = *(const LAS bf16x8*)(P + KH + (16 * kt + lr) * 80 + g * 16); \
                S[kt] = MFMA16(ka, vn, S[kt] * gk); \
            } \
        } while (0)
    { const float* gp0 = proj + (row0 + 4 * g) * 8192 + 6144 + h * 128 + 16 * w + lr;
#pragma unroll
      for (int r = 0; r < 4; ++r) { gpre[r] = gp0[(size_t)r * 8192]; gpre[4 + r] = gp0[(size_t)(16 + r) * 8192]; } }
    __syncthreads();
    HG2_LOAD(0); HG2_P1(0); __syncthreads();
    HG2_P2(0); HG2_LOAD(1); HG2_P1(1); HG2_LOAD(2); __syncthreads();
    for (int n = 0; n < NCH; ++n) {
        if (SCAN_FIRST(w)) { __builtin_amdgcn_s_setprio(SCAN_PRIO); HG2_M(n); __builtin_amdgcn_s_setprio(0); }
        if (n >= 1 && tid < 32) { const LAS float* osl = (const LAS float*)(L + OSSL) + ((n - 1) & 1) * 256 + tid * 8; const f32x4 a_ = *(const LAS f32x4*)osl, b_ = *(const LAS f32x4*)(osl + 4);
            OSSQ[(row0 + (n - 1) * CH + tid) * 16 + h] = ((a_.x + a_.y) + (a_.z + a_.w)) + ((b_.x + b_.y) + (b_.z + b_.w)); }
        if (n + 1 < NCH) HG2_P2(n + 1);
        if (n + 2 < NCH) HG2_P1(n + 2);
        if (n + 3 < NCH) HG2_LOAD(n + 3);
        if (!SCAN_FIRST(w)) { __builtin_amdgcn_s_setprio(SCAN_PRIO); HG2_M(n); __builtin_amdgcn_s_setprio(0); }
        __syncthreads();
    }
#undef HG2_M
    if (tid < 32) { const LAS float* osl = (const LAS float*)(L + OSSL) + ((NCH - 1) & 1) * 256 + tid * 8; const f32x4 a_ = *(const LAS f32x4*)osl, b_ = *(const LAS f32x4*)(osl + 4);
        OSSQ[(row0 + (NCH - 1) * CH + tid) * 16 + h] = ((a_.x + a_.y) + (a_.z + a_.w)) + ((b_.x + b_.y) + (b_.z + b_.w)); }
    float* So = F.out + O_SP + ((size_t)(j * NB + b) * 16 + h) * 16384 + 16 * w + lr;
#pragma unroll
    for (int kt = 0; kt < 8; ++kt)
#pragma unroll
        for (int r = 0; r < 4; ++r) So[(size_t)(16 * kt + 4 * g + r) * 128] = S[kt][r];
#undef HG2_LOAD
#undef HG2_P1
#undef HG2_P2
}
__device__ __forceinline__ void hgrn_sample(Frame& F, int j, const float* lbp, const float* onorm, const float* S_in, int it0, int itstep) {
    const float* proj = (const float*)(F.ws + WS_PROJ); bf16* OB = (bf16*)(F.ws + WS_OB); float* OSSQ = (float*)(F.ws + WS_OSSQ);
    LAS float* L = (LAS float*)F.lds;
    const int tid = F.tid;
    {
        constexpr int SF = 0, SK = 512, SQ = 1024, SV = 1536, RED = 2048;
        const int v4 = tid & 31, kb = tid >> 5;
        for (int it = it0; it < DB * 16; it += itstep) {
            const int b = it >> 4, h = it & 15;
            __syncthreads();
            const float* S0 = S_in + ((size_t)(j * DB + b) * 16 + h) * 16384;
            f32x4 S[8];
#pragma unroll
            for (int i = 0; i < 8; ++i) S[i] = *(const GAS f32x4*)(S0 + (kb + 16 * i) * 128 + v4 * 4);
            { const int tok = tid >> 7, c = tid & 127; const size_t row = MP + b * DSQ + tok;
              const float fp = proj[row * 8192 + 2048 + h * 128 + c], qr = proj[row * 8192 + h * 128 + c], vr = proj[row * 8192 + 4096 + h * 128 + c];
              const float lb = hgrn_lb(j, lbp, h * 128 + c);
              L[SF + tid] = lb + (1.f - lb) * sigm(fp); L[SK + tid] = (1.f - lb) * sigm(-fp); L[SQ + tid] = qr * sigm(qr); L[SV + tid] = vr; }
            __syncthreads();
#pragma unroll
            for (int tok = 0; tok < DSQ; ++tok) {
                const f32x4 vv = *(const LAS f32x4*)(L + SV + tok * 128 + v4 * 4);
                f32x4 o = (f32x4){0.f, 0.f, 0.f, 0.f};
#pragma unroll
                for (int i = 0; i < 8; ++i) { const int k = kb + 16 * i; const float fk = L[SF + tok * 128 + k], kk = L[SK + tok * 128 + k], qq = L[SQ + tok * 128 + k];
                    S[i] = S[i] * fk + vv * kk; o += S[i] * qq; }
                *(LAS f32x4*)(L + RED + ((tok * 16 + kb) * 32 + v4) * 4) = o;
            }
            __syncthreads();
            { const int tok = tid >> 7, v = tid & 127; float s = 0.f;
#pragma unroll
              for (int k2 = 0; k2 < 16; ++k2) s += L[RED + (tok * 16 + k2) * 128 + v];
              const size_t row = MP + b * DSQ + tok; const float gg = proj[row * 8192 + 6144 + h * 128 + v];
              const float y = s * onorm[h * 128 + v] * __builtin_amdgcn_rcpf(1.0f + __expf(-gg)); OB[row * D + h * 128 + v] = (bf16)pk2(y, y);
              const float q = wave_sum(s * s); if (F.lane == 0) L[SF + F.wave] = q; }
            __syncthreads();
            if (tid < DSQ) OSSQ[(size_t)(MP + b * DSQ + tid) * 16 + h] = L[SF + 2 * tid] + L[SF + 2 * tid + 1];
            float* So = F.out + O_SS + ((size_t)(j * DB + b) * 16 + h) * 16384;
#pragma unroll
            for (int i = 0; i < 8; ++i) *(GAS f32x4*)(So + (kb + 16 * i) * 128 + v4 * 4) = S[i];
        }
    }
}
__device__ __forceinline__ void hgrn_scan(Frame& F, int j, const float* lbp, const float* onorm, const float* S_in, int part = 3) {
    const int bx = blockIdx.x, G = F.G;
    if (G > 64) { if (bx < 64) { if (part & 1) hgrn_scan_mfma(F, j, lbp, onorm, bx); } else if (part & 2) hgrn_sample(F, j, lbp, onorm, S_in, bx - 64, G - 64); }
    else { for (int it = bx; it < 64; it += G) hgrn_scan_mfma(F, j, lbp, onorm, it); hgrn_sample(F, j, lbp, onorm, S_in, bx, G); }
}
__device__ __forceinline__ void hgrn_post(Frame& F, const float* onorm) {
    const float* proj = (const float*)(F.ws + WS_PROJ); const float* scr = (const float*)(F.ws + WS_SCR); bf16* OB = (bf16*)(F.ws + WS_OB);
    const int gw = F.vcu * NWAVES + F.wave, NGW = F.G * NWAVES, lane = F.lane;
    for (int m = gw; m < M; m += NGW) {
        const GAS f32x4* xr = (const GAS f32x4*)(scr + (size_t)m * D) + lane; const GAS f32x4* gr = (const GAS f32x4*)(proj + (size_t)m * 8192 + 6144) + lane; const GAS f32x4* nr = (const GAS f32x4*)onorm + lane;
        f32x4 v[8]; float ss = 0.f;
#pragma unroll
        for (int j = 0; j < 8; ++j) { v[j] = xr[64 * j]; ss += (v[j].x * v[j].x + v[j].y * v[j].y) + (v[j].z * v[j].z + v[j].w * v[j].w); }
        const float rstd = 1.0f / sqrtf(wave_sum(ss) * (1.0f / D) + EPS);
        GAS v2u* ho = (GAS v2u*)(OB + (size_t)m * D) + lane;
#pragma unroll
        for (int j = 0; j < 8; ++j) { const f32x4 g = gr[64 * j], nn = nr[64 * j]; f32x4 o;
#pragma unroll
            for (int e = 0; e < 4; ++e) o[e] = v[j][e] * rstd * nn[e] * sigm(g[e]);
            v2u w; w.x = pk2(o.x, o.y); w.y = pk2(o.z, o.w); ho[64 * j] = w; }
    }
}
__device__ __forceinline__ void mlstm_scan_mfma(Frame& F, int item) {
    const float* proj = (const float*)(F.ws + WS_PROJ); float* scr = (float*)(F.ws + WS_SCR); const float* GATES = (const float*)(F.ws + WS_GATES); float* DENM = (float*)(F.ws + WS_DENM);
    LAS unsigned char* L = F.lds;
    const int tid = F.tid, lane = F.lane, w = F.wave;
    constexpr int CH = 32, NCH = SEQ / CH, PW = 6144, QT = 0, KT = 8704, KH = 17408, VT = 27648, PBUF = 37888, SCAL = 75776, SCSZ = 640;
    const int b = item >> 4, h = (item >> 1) & 7, vh = item & 1;
    const size_t row0 = (size_t)b * SEQ;
    const unsigned upk = (unsigned)(((w & 1) << 6) | lane);
    const int tq = w >> 1, pk = ((w & 1) << 6) | lane;
    const int lr = lane & 15, g = lane >> 4;
    const bool nwave = (vh == 0 && w == 7);
    float rk[8], rq[8], rv[8], rig = 0.f, rlf = 0.f, m_prev = 0.f;
    f32x4 C[8], N[8];
#pragma unroll
    for (int i = 0; i < 8; ++i) { C[i] = (f32x4){0.f, 0.f, 0.f, 0.f}; N[i] = (f32x4){0.f, 0.f, 0.f, 0.f}; }
    const bf16x8 ones = (lr == 0) ? (bf16x8){0x3F80, 0x3F80, 0x3F80, 0x3F80, 0x3F80, 0x3F80, 0x3F80, 0x3F80} : (bf16x8){0, 0, 0, 0, 0, 0, 0, 0};
#define ML2_LOAD(c) do { _Pragma("unroll") for (int i = 0; i < 8; ++i) { const float* p_ = proj + (row0 + (c) * CH + 8 * tq + i) * PW + h * 128; rq[i] = p_[upk]; rk[i] = p_[1024u + upk]; rv[i] = p_[(unsigned)(2048 + h * 128 + vh * 128) + upk]; } \
            } while (0)
#define ML2_GLOAD(c) do { if (w == 0 && lane < 32) { const size_t rg_ = row0 + (c) * CH + lane; rig = GATES[rg_ * 16 + h]; rlf = GATES[rg_ * 16 + 8 + h]; } } while (0)
#define ML2_P1(c) do { if (w == 0) { float bt_ = rlf; _Pragma("unroll") for (int d_ = 1; d_ < 32; d_ <<= 1) { const float t_ = __shfl_up(bt_, d_); if (lane >= d_) bt_ += t_; } \
                const float u_ = rig - bt_; float pm_ = u_; _Pragma("unroll") for (int d_ = 1; d_ < 32; d_ <<= 1) { const float t_ = __shfl_up(pm_, d_); if (lane >= d_) pm_ = fmaxf(pm_, t_); } \
                const float mt_ = fmaxf(bt_ + m_prev, bt_ + pm_); const float bL_ = __shfl(bt_, 31), mL_ = __shfl(mt_, 31); \
                LAS float* S_ = (LAS float*)(L + SCAL + ((c) & 3) * SCSZ); \
                if (lane < 32) { S_[lane] = u_; S_[32 + lane] = bt_ - mt_; S_[64 + lane] = __expf(bt_ + m_prev - mt_); S_[96 + lane] = __expf(u_ + bL_ - mL_); \
                    if (vh == 0) DENM[(row0 + (c) * CH + lane) * 16 + 8 + h] = mt_; } \
                if (lane == 0) S_[128] = __expf(bL_ + m_prev - mL_); \
                m_prev = mL_; } } while (0)
#define ML2_P2(c) do { LAS unsigned char* P_ = L + ((c) & 1) * PBUF; const LAS float* S_ = (const LAS float*)(L + SCAL + ((c) & 3) * SCSZ); \
            float kh_[8]; _Pragma("unroll") for (int i = 0; i < 8; ++i) { \
                *(LAS unsigned short*)(P_ + QT + (8 * tq + i) * 272 + pk * 2) = (unsigned short)pk2(rq[i], rq[i]); \
                *(LAS unsigned short*)(P_ + KT + (8 * tq + i) * 272 + pk * 2) = (unsigned short)pk2(rk[i], rk[i]); \
                kh_[i] = rk[i] * S_[96 + 8 * tq + i]; } \
            { v4u o_; o_.x = pk2(kh_[0], kh_[1]); o_.y = pk2(kh_[2], kh_[3]); o_.z = pk2(kh_[4], kh_[5]); o_.w = pk2(kh_[6], kh_[7]); *(LAS v4u*)(P_ + KH + pk * 80 + tq * 16) = o_; } \
            { v4u o_; o_.x = pk2(rv[0], rv[1]); o_.y = pk2(rv[2], rv[3]); o_.z = pk2(rv[4], rv[5]); o_.w = pk2(rv[6], rv[7]); *(LAS v4u*)(P_ + VT + pk * 80 + tq * 16) = o_; } } while (0)
#define ML2_TILE(St, vb_, vn_, o0_, o1_) do { \
            _Pragma("unroll") for (int kk = 0; kk < 4; ++kk) { const bf16x8 sb_ = pack8(St[2 * kk], St[2 * kk + 1]); \
                const bf16x8 qa0_ = mk_bf16x8(*(const LAS u64*)(P + QT + lr * 272 + kk * 64 + g * 8), *(const LAS u64*)(P + QT + lr * 272 + kk * 64 + 32 + g * 8)); \
                const bf16x8 qa1_ = mk_bf16x8(*(const LAS u64*)(P + QT + (16 + lr) * 272 + kk * 64 + g * 8), *(const LAS u64*)(P + QT + (16 + lr) * 272 + kk * 64 + 32 + g * 8)); \
                o0_ = MFMA16(qa0_, sb_, o0_); o1_ = MFMA16(qa1_, sb_, o1_); } \
            o0_ = o0_ * sc0; o1_ = o1_ * sc1; \
            o0_ = MFMA16(pa0, vb_, o0_); o1_ = MFMA16(pa1, vb_, o1_); __builtin_amdgcn_sched_barrier(0); \
            _Pragma("unroll") for (int kt = 0; kt < 8; ++kt) { const bf16x8 ka_ = *(const LAS bf16x8*)(P + KH + (16 * kt + lr) * 80 + g * 16); St[kt] = MFMA16(ka_, vn_, St[kt] * scst); } } while (0)
#define ML2_M(n) do { const LAS unsigned char* P = L + ((n) & 1) * PBUF; const LAS float* SC_ = (const LAS float*)(L + SCAL + ((n) & 3) * SCSZ); \
            f32x4 at00 = (f32x4){0.f, 0.f, 0.f, 0.f}, at01 = at00, at11 = at00; \
            _Pragma("unroll") for (int kk = 0; kk < 4; ++kk) { \
                const bf16x8 a0 = *(const LAS bf16x8*)(P + KT + lr * 272 + kk * 64 + g * 16), a1 = *(const LAS bf16x8*)(P + KT + (16 + lr) * 272 + kk * 64 + g * 16); \
                const bf16x8 b0 = *(const LAS bf16x8*)(P + QT + lr * 272 + kk * 64 + g * 16), b1 = *(const LAS bf16x8*)(P + QT + (16 + lr) * 272 + kk * 64 + g * 16); \
                at00 = MFMA16(a0, b0, at00); at01 = MFMA16(a0, b1, at01); at11 = MFMA16(a1, b1, at11); } \
            { const f32x4 u0 = *(const LAS f32x4*)(SC_ + 4 * g), u1 = *(const LAS f32x4*)(SC_ + 16 + 4 * g); const float w0 = SC_[32 + lr], w1 = SC_[48 + lr]; \
              _Pragma("unroll") for (int r = 0; r < 4; ++r) { const bool keep = (4 * g + r) <= lr; \
                at00[r] = keep ? at00[r] * __expf(u0[r] + w0) : 0.f; at01[r] = at01[r] * __expf(u0[r] + w1); at11[r] = keep ? at11[r] * __expf(u1[r] + w1) : 0.f; } } \
            const f32x4 zero4 = (f32x4){0.f, 0.f, 0.f, 0.f}; \
            const bf16x8 pa0 = pack8(at00, zero4), pa1 = pack8(at01, at11); __builtin_amdgcn_sched_barrier(0); \
            const f32x4 sc0 = *(const LAS f32x4*)(SC_ + 64 + 4 * g), sc1 = *(const LAS f32x4*)(SC_ + 80 + 4 * g); const float scst = SC_[128]; \
            const int vcol = 16 * w + lr; \
            { const bf16x8 vb = mk_bf16x8(*(const LAS u64*)(P + VT + vcol * 80 + g * 8), *(const LAS u64*)(P + VT + vcol * 80 + 32 + g * 8)); \
              const bf16x8 vn = *(const LAS bf16x8*)(P + VT + vcol * 80 + g * 16); \
              f32x4 o0 = zero4, o1 = zero4; \
              ML2_TILE(C, vb, vn, o0, o1); \
              float* op = scr + (row0 + (n) * CH + 4 * g) * D + h * 256 + vh * 128 + vcol; \
              _Pragma("unroll") for (int r = 0; r < 4; ++r) { op[(size_t)r * D] = o0[r]; op[(size_t)(16 + r) * D] = o1[r]; } } \
            __builtin_amdgcn_sched_barrier(0); \
            if (nwave) { f32x4 o0 = zero4, o1 = zero4; \
              ML2_TILE(N, ones, ones, o0, o1); \
              if (lr == 0) { float* dp = DENM + (row0 + (n) * CH + 4 * g) * 16 + h; \
                _Pragma("unroll") for (int r = 0; r < 4; ++r) { dp[(size_t)r * 16] = o0[r]; dp[(size_t)(16 + r) * 16] = o1[r]; } } } } while (0)
    __syncthreads();
    ML2_GLOAD(0); ML2_P1(0); ML2_GLOAD(1); ML2_LOAD(0); __syncthreads();
    ML2_P2(0); ML2_LOAD(1); ML2_P1(1); ML2_GLOAD(2); __syncthreads();
    for (int n = 0; n < NCH; ++n) {
        if (SCAN_FIRST(w)) { __builtin_amdgcn_s_setprio(SCAN_PRIO); ML2_M(n); __builtin_amdgcn_s_setprio(0); }
        if (n + 1 < NCH) { ML2_P2(n + 1); }
        if (n + 2 < NCH) { ML2_LOAD(n + 2); ML2_P1(n + 2); }
        if (n + 3 < NCH) { ML2_GLOAD(n + 3); }
        if (!SCAN_FIRST(w)) { __builtin_amdgcn_s_setprio(SCAN_PRIO); ML2_M(n); __builtin_amdgcn_s_setprio(0); }
        __syncthreads();
    }
#undef ML2_GLOAD
    float* Co = F.out + O_CP + ((size_t)(b * 8 + h) * 128) * 256 + vh * 128 + 16 * w + lr;
#pragma unroll
    for (int kt = 0; kt < 8; ++kt)
#pragma unroll
        for (int r = 0; r < 4; ++r) Co[(size_t)(16 * kt + 4 * g + r) * 256] = C[kt][r];
    if (nwave && lr == 0) {
#pragma unroll
        for (int kt = 0; kt < 8; ++kt)
#pragma unroll
            for (int r = 0; r < 4; ++r) F.out[O_NP + (size_t)(b * 8 + h) * 128 + 16 * kt + 4 * g + r] = N[kt][r]; }
    if (vh == 0 && w == 0 && lane == 0) F.out[O_MP + b * 8 + h] = m_prev;
#undef ML2_LOAD
#undef ML2_P1
#undef ML2_P2
#undef ML2_TILE
#undef ML2_M
}
__device__ __forceinline__ void mlstm_sample(Frame& F, const float* C_in, const float* n_in, const float* m_in, int it0, int itstep) {
    const float* proj = (const float*)(F.ws + WS_PROJ); float* scr = (float*)(F.ws + WS_SCR); const float* GATES = (const float*)(F.ws + WS_GATES); float* DENM = (float*)(F.ws + WS_DENM);
    LAS float* L = (LAS float*)F.lds;
    const int tid = F.tid, lane = F.lane, wave = F.wave;
    constexpr int PW = 6144;
    {
        constexpr int SK = 0, SQ = 512, SV = 1024, SG = 2048, DD = 2064, EM = 2072, RED = 2080;
        const int v4 = tid & 63, kb = tid >> 6;
        for (int it = it0; it < DB * 8; it += itstep) {
            const int b = it >> 3, h = it & 7;
            __syncthreads();
            const float* C0 = C_in + ((size_t)(b * 8 + h) * 128) * 256;
            f32x4 C[16];
#pragma unroll
            for (int i = 0; i < 16; ++i) C[i] = *(const GAS f32x4*)(C0 + (kb + 8 * i) * 256 + v4 * 4);
            float nn = (tid < 128) ? n_in[(size_t)(b * 8 + h) * 128 + tid] : 0.f;
            float m = m_in[b * 8 + h];
            { const int tok = tid >> 7, c = tid & 127; const size_t row = MP + b * DSQ + tok;
              L[SK + tid] = proj[row * PW + 1024 + h * 128 + c]; L[SQ + tid] = proj[row * PW + h * 128 + c];
#pragma unroll
              for (int r = 0; r < 2; ++r) { const int idx = tid + 512 * r, tk = idx >> 8, cc = idx & 255; L[SV + idx] = proj[(size_t)(MP + b * DSQ + tk) * PW + 2048 + h * 256 + cc]; }
              if (tid < 4) { L[SG + tid] = GATES[(size_t)(MP + b * DSQ + tid) * 16 + h]; L[SG + 4 + tid] = GATES[(size_t)(MP + b * DSQ + tid) * 16 + 8 + h]; } }
            __syncthreads();
#pragma unroll
            for (int tok = 0; tok < DSQ; ++tok) {
                const float ig = L[SG + tok], lf = L[SG + 4 + tok];
                const float mn = fmaxf(lf + m, ig), a = __expf(lf + m - mn), bb = __expf(ig - mn); m = mn;
                const f32x4 vv = *(const LAS f32x4*)(L + SV + tok * 256 + v4 * 4);
                f32x4 o = (f32x4){0.f, 0.f, 0.f, 0.f};
#pragma unroll
                for (int i = 0; i < 16; ++i) { const int k = kb + 8 * i; const float kk = bb * L[SK + tok * 128 + k], qq = L[SQ + tok * 128 + k];
                    C[i] = C[i] * a + vv * kk; o += C[i] * qq; }
                *(LAS f32x4*)(L + RED + ((tok * 8 + kb) * 64 + v4) * 4) = o;
                if (tid < 128) { nn = a * nn + bb * L[SK + tok * 128 + tid]; const float p = wave_sum(nn * L[SQ + tok * 128 + tid]); if (lane == 0) L[DD + tok * 2 + wave] = p; }
                if (tid == 0) L[EM + tok] = __expf(-m);
            }
            __syncthreads();
#pragma unroll
            for (int r = 0; r < 2; ++r) { const int idx = tid + 512 * r, tok = idx >> 8, v = idx & 255; float s = 0.f;
#pragma unroll
                for (int k2 = 0; k2 < 8; ++k2) s += L[RED + (tok * 8 + k2) * 256 + v];
                const float den = L[DD + tok * 2] + L[DD + tok * 2 + 1];
                scr[(size_t)(MP + b * DSQ + tok) * D + h * 256 + v] = s / fmaxf(fabsf(den), L[EM + tok]); }
            float* Co = F.out + O_CS + ((size_t)(b * 8 + h) * 128) * 256;
#pragma unroll
            for (int i = 0; i < 16; ++i) *(GAS f32x4*)(Co + (kb + 8 * i) * 256 + v4 * 4) = C[i];
            if (tid < 128) F.out[O_NS + (size_t)(b * 8 + h) * 128 + tid] = nn;
            if (tid == 0) F.out[O_MS + b * 8 + h] = m;
            if (tid < DSQ) { DENM[(size_t)(MP + b * DSQ + tid) * 16 + h] = 1.0f; DENM[(size_t)(MP + b * DSQ + tid) * 16 + 8 + h] = 0.0f; }
        }
    }
}
__device__ __forceinline__ void mlstm_scan(Frame& F, const float* C_in, const float* n_in, const float* m_in) {
    const int bx = blockIdx.x, G = F.G;
    if (G > 64) { if (bx < 64) mlstm_scan_mfma(F, bx); else mlstm_sample(F, C_in, n_in, m_in, bx - 64, G - 64); }
    else { for (int it = bx; it < 64; it += G) mlstm_scan_mfma(F, it); mlstm_sample(F, C_in, n_in, m_in, bx, G); }
}
__device__ __forceinline__ void mlstm_post(Frame& F, const float* hnorm) {
    const float* proj = (const float*)(F.ws + WS_PROJ); const float* scr = (const float*)(F.ws + WS_SCR); bf16* OB = (bf16*)(F.ws + WS_OB); const float* DENM = (const float*)(F.ws + WS_DENM);
    const int gw = F.vcu * NWAVES + F.wave, NGW = F.G * NWAVES, lane = F.lane;
    for (int m = gw; m < M; m += NGW) {
        const GAS f32x4* xr = (const GAS f32x4*)(scr + (size_t)m * D) + lane; const GAS f32x4* gr = (const GAS f32x4*)(proj + (size_t)m * 6144 + 4096) + lane; const GAS f32x4* nr = (const GAS f32x4*)hnorm + lane;
        GAS v2u* ho = (GAS v2u*)(OB + (size_t)m * D) + lane;
        const float dm = DENM[(size_t)m * 16 + (lane & 15)];
        f32x4 xv[8], gv[8], nv[8];
#pragma unroll
        for (int j = 0; j < 8; ++j) { xv[j] = xr[64 * j]; gv[j] = gr[64 * j]; nv[j] = nr[64 * j]; }
        float ss[8];
#pragma unroll
        for (int j = 0; j < 8; ++j) {
            const float den_ = __builtin_bit_cast(float, __builtin_amdgcn_readlane(__builtin_bit_cast(int, dm), j)), mt_ = __builtin_bit_cast(float, __builtin_amdgcn_readlane(__builtin_bit_cast(int, dm), 8 + j));
            const float dn = 1.0f / fmaxf(fabsf(den_), __expf(-mt_));
            xv[j] = xv[j] * dn; ss[j] = (xv[j].x * xv[j].x + xv[j].y * xv[j].y) + (xv[j].z * xv[j].z + xv[j].w * xv[j].w); }
#pragma unroll
        for (int o = 1; o < 64; o <<= 1) {
#pragma unroll
            for (int j = 0; j < 8; ++j) ss[j] += __shfl_xor(ss[j], o); }
#pragma unroll
        for (int j = 0; j < 8; ++j) {
            const float rstd = 1.0f / sqrtf(ss[j] * (1.0f / 256.0f) + EPS);
            const f32x4 v = xv[j], g = gv[j], nn = nv[j]; f32x4 o;
#pragma unroll
            for (int e = 0; e < 4; ++e) o[e] = v[e] * rstd * nn[e] * sigm(g[e]);
            v2u w; w.x = pk2(o.x, o.y); w.y = pk2(o.z, o.w); ho[64 * j] = w; }
    }
}

__device__ __forceinline__ float gelu_erf(float v) {
    const float av = fabsf(v), t = __builtin_amdgcn_rcpf(av * 0.2316418882f + 1.0f);
    float q = t * 0.5307027145f + (-0.7265760135f); q = q * t + 0.7107068705f; q = q * t + (-0.142248368f); q = q * t + 0.127414796f; q = q * t;
    const float m = v * (q * __builtin_amdgcn_exp2f((v * v) * (-0.72134752044f)));
    return v < 0.f ? m : v - m;
}
__device__ __forceinline__ void gmlp_a(Frame& F, const float* vg, const float* vb) {
    float* proj = (float*)(F.ws + WS_PROJ); float* scr = (float*)(F.ws + WS_SCR);
    const int gw = F.vcu * NWAVES + F.wave, NGW = F.G * NWAVES, lane = F.lane;
    for (int m = gw; m < M; m += NGW) {
        const GAS f32x4* zr = (const GAS f32x4*)(proj + (size_t)m * 4096 + 2048) + lane;
        f32x4 v[8]; float s = 0.f;
#pragma unroll
        for (int j = 0; j < 8; ++j) { const f32x4 z = zr[64 * j];
#pragma unroll
            for (int e = 0; e < 4; ++e) v[j][e] = gelu_erf(z[e]);
            s += (v[j].x + v[j].y) + (v[j].z + v[j].w); }
        const float mean = wave_sum(s) * (1.0f / D); float s2 = 0.f;
#pragma unroll
        for (int j = 0; j < 8; ++j) { v[j] = v[j] - mean; s2 += (v[j].x * v[j].x + v[j].y * v[j].y) + (v[j].z * v[j].z + v[j].w * v[j].w); }
        const float rstd = 1.0f / sqrtf(wave_sum(s2) * (1.0f / D) + EPS);
        GAS v2u* so = (GAS v2u*)((bf16*)scr + (size_t)m * D) + lane; const GAS f32x4* g4 = (const GAS f32x4*)vg + lane; const GAS f32x4* b4 = (const GAS f32x4*)vb + lane;
        f32x4 gq[8], bq[8];
#pragma unroll
        for (int j = 0; j < 8; ++j) { gq[j] = g4[64 * j]; bq[j] = b4[64 * j]; }
#pragma unroll
        for (int j = 0; j < 8; ++j) { const f32x4 o = v[j] * rstd * gq[j] + bq[j];
            if (m < MP) { v2u w_; w_.x = pk2(o.x, o.y); w_.y = pk2(o.z, o.w); so[64 * j] = w_; }
            else ((GAS f32x4*)(F.out + O_VS + (size_t)(m - MP) * D) + lane)[64 * j] = o; }
    }
}
__device__ __forceinline__ void gmlp_b(Frame& F, const float* w_s, const float* b_s) {
    const float* proj = (const float*)(F.ws + WS_PROJ); const float* scr = (const float*)(F.ws + WS_SCR); bf16* OB = (bf16*)(F.ws + WS_OB);
    LAS unsigned char* L = F.lds;
    const int tid = F.tid, lane = F.lane, w = F.wave, lr = lane & 15, g4 = lane >> 4;
    constexpr int WB_ = 0, VT_ = 34816, RS = 272;
    for (int it = F.vcu; it < NB * 16 * 16; it += F.G) {
        const int g = it & 15, n = (it >> 4) & 15, b = it >> 8;
        const size_t row0 = (size_t)b * SEQ + n * 128;
        __syncthreads();
        f32x4 wvv[8];
#pragma unroll
        for (int i = 0; i < 8; ++i) { const int idx = tid + 512 * i, tr = idx >> 5, s4 = idx & 31; wvv[i] = *(const GAS f32x4*)(w_s + (size_t)g * 16384 + tr * 128 + s4 * 4); }
#pragma unroll
        for (int i = 0; i < 8; ++i) { const int idx = tid + 512 * i, tr = idx >> 5, s4 = idx & 31;
            const f32x4 wv = wvv[i]; f32x4 m;
#pragma unroll
            for (int e = 0; e < 4; ++e) m[e] = (s4 * 4 + e <= tr) ? wv[e] : 0.f;
            v2u o; o.x = pk2(m.x, m.y); o.y = pk2(m.z, m.w); *(LAS v2u*)(L + WB_ + tr * RS + s4 * 8) = o; }
        { const int d = tid & 127, sq = tid >> 7;
#pragma unroll
          for (int k8 = 0; k8 < 4; ++k8) { unsigned x[8];
#pragma unroll
            for (int e = 0; e < 8; ++e) x[e] = ((const bf16*)scr)[(row0 + 32 * sq + 8 * k8 + e) * D + g * 128 + d];
            v4u o; o.x = x[0] | (x[1] << 16); o.y = x[2] | (x[3] << 16); o.z = x[4] | (x[5] << 16); o.w = x[6] | (x[7] << 16);
            *(LAS v4u*)(L + VT_ + d * RS + (32 * sq + 8 * k8) * 2) = o; } }
        __syncthreads();
        f32x4 acc[8];
#pragma unroll
        for (int di = 0; di < 8; ++di) acc[di] = (f32x4){0.f, 0.f, 0.f, 0.f};
        const int nks = (16 * w + 15) / 32 + 1;
        for (int ks = 0; ks < nks; ++ks) {
            const bf16x8 a = *(const LAS bf16x8*)(L + WB_ + (16 * w + lr) * RS + ks * 64 + g4 * 16);
#pragma unroll
            for (int di = 0; di < 8; ++di) { const bf16x8 bb = *(const LAS bf16x8*)(L + VT_ + (16 * di + lr) * RS + ks * 64 + g4 * 16); acc[di] = MFMA16(a, bb, acc[di]); }
        }
        float uu[4][8], bsr[4];
#pragma unroll
        for (int r = 0; r < 4; ++r) { const int tt = 16 * w + 4 * g4 + r; bsr[r] = b_s[g * 128 + tt];
#pragma unroll
            for (int di = 0; di < 8; ++di) uu[r][di] = proj[(row0 + tt) * 4096 + g * 128 + 16 * di + lr]; }
#pragma unroll
        for (int r = 0; r < 4; ++r) { const int tt = 16 * w + 4 * g4 + r; const size_t row = row0 + tt;
#pragma unroll
            for (int di = 0; di < 8; ++di) { const int d = 16 * di + lr; const float o = (acc[di][r] + bsr[r]) * gelu_erf(uu[r][di]);
                OB[row * D + g * 128 + d] = (bf16)pk2(o, o); } }
    }
    for (int it = F.vcu * NTHR + tid; it < MS * (D / 4); it += F.G * NTHR) {
        const int r = it >> 9, c4 = it & 511, b = r >> 2, t = r & 3, c = c4 * 4, g = c >> 7;
        f32x4 mix; { const float bs = b_s[g * 128 + t]; mix = (f32x4){bs, bs, bs, bs}; }
        { f32x4 vr[DSQ]; float ws_[DSQ];
#pragma unroll
          for (int s = 0; s < DSQ; ++s) { vr[s] = *(const GAS f32x4*)(F.out + O_VS + (size_t)(b * DSQ + s) * D + c); ws_[s] = w_s[(size_t)g * 16384 + t * 128 + s]; }
#pragma unroll
          for (int s = 0; s < DSQ; ++s) if (s <= t) mix += vr[s] * ws_[s]; }
        const f32x4 uz = *(const GAS f32x4*)(proj + (size_t)(MP + r) * 4096 + c); const f32x4 u = (f32x4){gelu_erf(uz.x), gelu_erf(uz.y), gelu_erf(uz.z), gelu_erf(uz.w)}; const f32x4 o = mix * u;
        v2u w; w.x = pk2(o.x, o.y); w.y = pk2(o.z, o.w); *(GAS v2u*)(OB + (size_t)(MP + r) * D + c) = w;
    }
}

__device__ __forceinline__ void bf8_to_f(const v4u w, float (&x)[8]) {
    x[0] = __builtin_bit_cast(float, w.x << 16); x[1] = __builtin_bit_cast(float, w.x & 0xffff0000u); x[2] = __builtin_bit_cast(float, w.y << 16); x[3] = __builtin_bit_cast(float, w.y & 0xffff0000u);
    x[4] = __builtin_bit_cast(float, w.z << 16); x[5] = __builtin_bit_cast(float, w.z & 0xffff0000u); x[6] = __builtin_bit_cast(float, w.w << 16); x[7] = __builtin_bit_cast(float, w.w & 0xffff0000u);
}
__device__ __forceinline__ void ld8f(const float* p, float (&x)[8]) { const f32x4 a = *(const GAS f32x4*)p, b = *(const GAS f32x4*)(p + 4); x[0] = a.x; x[1] = a.y; x[2] = a.z; x[3] = a.w; x[4] = b.x; x[5] = b.y; x[6] = b.z; x[7] = b.w; }
__device__ __forceinline__ void st8f(float* p, const float (&x)[8]) { *(GAS f32x4*)p = (f32x4){x[0], x[1], x[2], x[3]}; *(GAS f32x4*)(p + 4) = (f32x4){x[4], x[5], x[6], x[7]}; }
__device__ __forceinline__ void conv_fix(Frame& F, int layer, const float* cw, const float* cb, const float* st_in) {
    const float* SIDE = (const float*)(F.ws + WS_PROJ); const float* UPS = (const float*)(F.ws + WS_PROJ + 32 * MiB); bf16* ACT = (bf16*)(F.ws + WS_ACT);
    constexpr int NCH = FF / 8;
    for (int it = F.vcu * NTHR + F.tid; it < (MP / 64) * NCH; it += F.G * NTHR) {
        const int ch = it % NCH, blk = it / NCH, c = ch * 8;
        float wa[3][8], wg[3][8], ba[8], bg[8];
#pragma unroll
        for (int j = 0; j < 3; ++j) { ld8f(cw + (size_t)j * F2 + c, wa[j]); ld8f(cw + (size_t)j * F2 + FF + c, wg[j]); }
        ld8f(cb + c, ba); ld8f(cb + FF + c, bg);
        float a2[8], a1[8], g2[8], g1[8], x0a[8], x0g[8], x1a[8], x1g[8];
        if ((blk & 31) != 0) { const float* sp = SIDE + ((size_t)(blk - 1) * 4) * F2; ld8f(sp + c, a2); ld8f(sp + FF + c, g2); ld8f(sp + F2 + c, a1); ld8f(sp + F2 + FF + c, g1); }
        else {
#pragma unroll
            for (int e = 0; e < 8; ++e) { a2[e] = 0.f; a1[e] = 0.f; g2[e] = 0.f; g1[e] = 0.f; } }
        { const float* sp = SIDE + ((size_t)blk * 4 + 2) * F2; ld8f(sp + c, x0a); ld8f(sp + FF + c, x0g); ld8f(sp + F2 + c, x1a); ld8f(sp + F2 + FF + c, x1g); }
        float o0[8], o1[8];
#pragma unroll
        for (int e = 0; e < 8; ++e) {
            const float ya0 = ba[e] + wa[0][e] * a2[e] + wa[1][e] * a1[e] + wa[2][e] * x0a[e], yg0 = bg[e] + wg[0][e] * g2[e] + wg[1][e] * g1[e] + wg[2][e] * x0g[e];
            const float ya1 = ba[e] + wa[0][e] * a1[e] + wa[1][e] * x0a[e] + wa[2][e] * x1a[e], yg1 = bg[e] + wg[0][e] * g1[e] + wg[1][e] * x0g[e] + wg[2][e] * x1g[e];
            o0[e] = ya0 * (yg0 * sigm(yg0)); o1[e] = ya1 * (yg1 * sigm(yg1)); }
        v4u w; w.x = pk2(o0[0], o0[1]); w.y = pk2(o0[2], o0[3]); w.z = pk2(o0[4], o0[5]); w.w = pk2(o0[6], o0[7]);
        *(GAS v4u*)(ACT + (size_t)(blk * 64) * FF + c) = w;
        w.x = pk2(o1[0], o1[1]); w.y = pk2(o1[2], o1[3]); w.z = pk2(o1[4], o1[5]); w.w = pk2(o1[6], o1[7]);
        *(GAS v4u*)(ACT + (size_t)(blk * 64 + 1) * FF + c) = w;
    }
    for (int it = F.vcu * NTHR + F.tid; it < DB * NCH; it += F.G * NTHR) {
        const int ch = it % NCH, b = it / NCH, c = ch * 8;
        float wa[3][8], wg[3][8], ba[8], bg[8];
#pragma unroll
        for (int j = 0; j < 3; ++j) { ld8f(cw + (size_t)j * F2 + c, wa[j]); ld8f(cw + (size_t)j * F2 + FF + c, wg[j]); }
        ld8f(cb + c, ba); ld8f(cb + FF + c, bg);
        float a2[8], a1[8], g2[8], g1[8];
        const float* sp = st_in + ((size_t)(layer * DB + b) * 2) * F2;
        ld8f(sp + c, a2); ld8f(sp + FF + c, g2); ld8f(sp + F2 + c, a1); ld8f(sp + F2 + FF + c, g1);
#pragma unroll
        for (int t = 0; t < DSQ; ++t) {
            const size_t rl = (size_t)b * DSQ + t; float xa[8], xg[8];
            ld8f(UPS + rl * F2 + c, xa); ld8f(UPS + rl * F2 + FF + c, xg);
            float o[8];
#pragma unroll
            for (int e = 0; e < 8; ++e) { const float ya = ba[e] + wa[0][e] * a2[e] + wa[1][e] * a1[e] + wa[2][e] * xa[e], yg = bg[e] + wg[0][e] * g2[e] + wg[1][e] * g1[e] + wg[2][e] * xg[e];
                o[e] = ya * (yg * sigm(yg)); a2[e] = a1[e]; a1[e] = xa[e]; g2[e] = g1[e]; g1[e] = xg[e]; }
            v4u w; w.x = pk2(o[0], o[1]); w.y = pk2(o[2], o[3]); w.z = pk2(o[4], o[5]); w.w = pk2(o[6], o[7]);
            *(GAS v4u*)(ACT + (MP + rl) * FF + c) = w;
            if (t >= 2) { float* po = F.out + O_CVS + ((size_t)(layer * DB + b) * 2 + (t - 2)) * F2; st8f(po + c, xa); st8f(po + FF + c, xg); }
        }
    }
}
__device__ __forceinline__ void conv_ffn(Frame& F, int layer, const float* cw, const float* cb, const float* st_in) {
    const bf16* UP = (const bf16*)(F.ws + WS_PROJ); bf16* ACT = (bf16*)(F.ws + WS_ACT);
    constexpr int RB = 16, NCH = FF / 8;
    for (int it = F.vcu * NTHR + F.tid; it < (MP / RB) * NCH; it += F.G * NTHR) {
        const int ch = it % NCH, rb = it / NCH, c = ch * 8; const int r0 = rb * RB;
        float wa[3][8], wg[3][8], ba[8], bg[8];
#pragma unroll
        for (int j = 0; j < 3; ++j) { ld8f(cw + (size_t)j * F2 + c, wa[j]); ld8f(cw + (size_t)j * F2 + FF + c, wg[j]); }
        ld8f(cb + c, ba); ld8f(cb + FF + c, bg);
        float a2[8], a1[8], g2[8], g1[8];
        if ((r0 & (SEQ - 1)) != 0) { bf8_to_f(*(const GAS v4u*)(UP + (size_t)(r0 - 2) * F2 + c), a2); bf8_to_f(*(const GAS v4u*)(UP + (size_t)(r0 - 1) * F2 + c), a1);
                                     bf8_to_f(*(const GAS v4u*)(UP + (size_t)(r0 - 2) * F2 + FF + c), g2); bf8_to_f(*(const GAS v4u*)(UP + (size_t)(r0 - 1) * F2 + FF + c), g1); }
        else {
#pragma unroll
            for (int e = 0; e < 8; ++e) { a2[e] = 0.f; a1[e] = 0.f; g2[e] = 0.f; g1[e] = 0.f; } }
#pragma unroll 4
        for (int rr = 0; rr < RB; ++rr) {
            const int r = r0 + rr; float xa[8], xg[8];
            bf8_to_f(*(const GAS v4u*)(UP + (size_t)r * F2 + c), xa); bf8_to_f(*(const GAS v4u*)(UP + (size_t)r * F2 + FF + c), xg);
            float o[8];
#pragma unroll
            for (int e = 0; e < 8; ++e) { const float ya = ba[e] + wa[0][e] * a2[e] + wa[1][e] * a1[e] + wa[2][e] * xa[e], yg = bg[e] + wg[0][e] * g2[e] + wg[1][e] * g1[e] + wg[2][e] * xg[e];
                o[e] = ya * (yg * sigm(yg)); a2[e] = a1[e]; a1[e] = xa[e]; g2[e] = g1[e]; g1[e] = xg[e]; }
            v4u w; w.x = pk2(o[0], o[1]); w.y = pk2(o[2], o[3]); w.z = pk2(o[4], o[5]); w.w = pk2(o[6], o[7]);
            *(GAS v4u*)(ACT + (size_t)r * FF + c) = w;
            const int tin = r & (SEQ - 1);
            if (tin >= SEQ - 2) { float* po = F.out + O_CVP + ((size_t)(layer * NB + (r >> 11)) * 2 + (tin - (SEQ - 2))) * F2; st8f(po + c, xa); st8f(po + FF + c, xg); }
        }
    }
    for (int it = F.vcu * NTHR + F.tid; it < DB * NCH; it += F.G * NTHR) {
        const int ch = it % NCH, b = it / NCH, c = ch * 8;
        float wa[3][8], wg[3][8], ba[8], bg[8];
#pragma unroll
        for (int j = 0; j < 3; ++j) { ld8f(cw + (size_t)j * F2 + c, wa[j]); ld8f(cw + (size_t)j * F2 + FF + c, wg[j]); }
        ld8f(cb + c, ba); ld8f(cb + FF + c, bg);
        float a2[8], a1[8], g2[8], g1[8];
        const float* sp = st_in + ((size_t)(layer * DB + b) * 2) * F2;
        ld8f(sp + c, a2); ld8f(sp + FF + c, g2); ld8f(sp + F2 + c, a1); ld8f(sp + F2 + FF + c, g1);
#pragma unroll
        for (int t = 0; t < DSQ; ++t) {
            const size_t r = MP + b * DSQ + t; float xa[8], xg[8];
            bf8_to_f(*(const GAS v4u*)(UP + r * F2 + c), xa); bf8_to_f(*(const GAS v4u*)(UP + r * F2 + FF + c), xg);
            float o[8];
#pragma unroll
            for (int e = 0; e < 8; ++e) { const float ya = ba[e] + wa[0][e] * a2[e] + wa[1][e] * a1[e] + wa[2][e] * xa[e], yg = bg[e] + wg[0][e] * g2[e] + wg[1][e] * g1[e] + wg[2][e] * xg[e];
                o[e] = ya * (yg * sigm(yg)); a2[e] = a1[e]; a1[e] = xa[e]; g2[e] = g1[e]; g1[e] = xg[e]; }
            v4u w; w.x = pk2(o[0], o[1]); w.y = pk2(o[2], o[3]); w.z = pk2(o[4], o[5]); w.w = pk2(o[6], o[7]);
            *(GAS v4u*)(ACT + r * FF + c) = w;
            if (t >= 2) { float* po = F.out + O_CVS + ((size_t)(layer * DB + b) * 2 + (t - 2)) * F2; st8f(po + c, xa); st8f(po + FF + c, xg); }
        }
    }
}

#ifndef EN_P0
#define EN_P0 1
#endif
#ifndef EN_GIN
#define EN_GIN 1
#endif
#ifndef EN_MIXA
#define EN_MIXA 1
#endif
#ifndef EN_MIXB
#define EN_MIXB 1
#endif
#ifndef EN_GOUT
#define EN_GOUT 1
#endif
#ifndef EN_NORM
#define EN_NORM 1
#endif
#ifndef EN_GUP
#define EN_GUP 1
#endif
#ifndef EN_CONV
#define EN_CONV 1
#endif
#ifndef EN_GDOWN
#define EN_GDOWN 1
#endif
#ifndef REP_P0
#define REP_P0 1
#endif
#ifndef REP_GIN
#define REP_GIN 1
#endif
#ifndef REP_MIXA
#define REP_MIXA 1
#endif
#ifndef REP_MIXB
#define REP_MIXB 1
#endif
#ifndef REP_NORM
#define REP_NORM 1
#endif
#ifndef REP_GUP
#define REP_GUP 1
#endif
#ifndef REP_CONV
#define REP_CONV 1
#endif
#ifndef REP_GOUT
#define REP_GOUT 1
#endif
#ifndef REP_GDOWN
#define REP_GDOWN 1
#endif
constexpr int NPHASE = 37;
#ifndef MK_N_LAUNCHES
#define MK_N_LAUNCHES 1
#endif
#define FFN_DESC(li_) do { SET_DESCP(di, INP(32) + (size_t)(li_) * D * F2, INP(8) + (li_) * D, WB + WE_UP + (size_t)(li_) * WE_UP_STRIDE, D, F2, 0, 1.0f, 1); ++di; \
        SET_DESC(di, INP(35) + (size_t)(li_) * FF * D, (const float*)nullptr, WB + WE_DOWN + (size_t)(li_) * WE_DOWN_STRIDE, FF, D, 0, 1.0f); ++di; } while (0)
#define HGRN_DESC(jj_) do { const int li__ = (jj_) * 3; const float* gn = INP(7) + li__ * D; bf16* wi = WB + ((jj_) ? WE_IN3 : WE_IN0); bf16* wo = WB + ((jj_) ? WE_OUT3 : WE_OUT0); const size_t so = (size_t)(jj_) * D * D; \
        SET_DESC(di, INP(10) + so, gn, wi, D, D, 0, 1.0f); ++di; SET_DESC(di, INP(11) + so, gn, wi, D, D, 2048, 1.0f); ++di; \
        SET_DESC(di, INP(12) + so, gn, wi, D, D, 4096, 1.0f); ++di; SET_DESC(di, INP(13) + so, gn, wi, D, D, 6144, 1.0f); ++di; \
        SET_DESC(di, INP(16) + so, (const float*)nullptr, wo, D, D, 0, 1.0f); ++di; } while (0)
#define BUILD_DESC() do { if (F.tid == 0) { int tot_ = 0; int di = 0; \
        HGRN_DESC(0); FFN_DESC(0); \
        { const float* gn = INP(7) + 1 * D; bf16* wi = (bf16*)(args.ws + WS_WIN1); \
          SET_DESC(di, INP(17), gn, wi, D, 1024, 0, 1.0f); ++di; SET_DESC(di, INP(18), gn, wi, D, 1024, 1024, 0.08838834764831845f); ++di; \
          SET_DESC(di, INP(19), gn, wi, D, 2048, 2048, 1.0f); ++di; SET_DESC(di, INP(20), gn, wi, D, 2048, 4096, 1.0f); ++di; \
          SET_DESC(di, INP(24), (const float*)nullptr, WB + WE_OUT1, D, D, 0, 1.0f); ++di; } FFN_DESC(1); \
        { const float* gn = INP(7) + 2 * D; \
          SET_DESC(di, INP(25), gn, WB + WE_IN2, D, 4096, 0, 1.0f); ++di; SET_DESC(di, INP(31), (const float*)nullptr, WB + WE_OUT2, D, D, 0, 1.0f); ++di; } FFN_DESC(2); \
        HGRN_DESC(1); FFN_DESC(3); } } while (0)
#define CONVERT_FR(d_lo, d_hi, n0_, n1_, den_, widx, nw) do { LAS float* scr_ = (LAS float*)(F.lds + F.wave * 16640); \
        const int itA_ = (d_lo) ? desc[(d_lo) - 1].item_end : 0, itB_ = desc[(d_hi) - 1].item_end; \
        const int it0_ = itA_ + (int)((long)(itB_ - itA_) * (n0_) / (den_)), it1_ = itA_ + (int)((long)(itB_ - itA_) * (n1_) / (den_)); \
        for (int it = it0_ + (widx); it < it1_; it += (nw)) { int d = (d_lo); while (d < (d_hi) - 1 && desc[d].item_end <= it) ++d; \
            const int first = d ? desc[d - 1].item_end : 0; \
            p0_transpose_item(desc[d].W, desc[d].gain, desc[d].scale, desc[d].K, desc[d].N, desc[d].WT, desc[d].row_off, desc[d].perm, scr_, it - first, F.lane); } } while (0)
#define CONVERT(d_lo, d_hi, widx, nw) CONVERT_FR(d_lo, d_hi, 0, 1, 1, widx, nw)
constexpr int INTAB_OFF = 142592;
__device__ __forceinline__ const float* lds_ptr(LAS unsigned char* p) { const unsigned long long v = *(LAS unsigned long long*)p;
    const unsigned lo_ = __builtin_amdgcn_readfirstlane((unsigned)v), hi_ = __builtin_amdgcn_readfirstlane((unsigned)(v >> 32)); return (const float*)(((unsigned long long)hi_ << 32) | lo_); }
struct Args { const float* in[36]; float* out; unsigned char* ws; int ph_lo, ph_hi, li, pad; };
__global__ void __launch_bounds__(NTHR, 2) mk_fwd(Args args) {
    extern __shared__ __attribute__((aligned(16))) unsigned char lds[];
    Frame F;
    F.lds = (LAS unsigned char*)lds;
    F.MISC = (volatile LAS unsigned*)(F.lds + MISC_OFF);
    F.tid = threadIdx.x; F.lane = F.tid & 63; F.wave = __builtin_amdgcn_readfirstlane(F.tid >> 6);
    F.G = gridDim.x; { const int bx = blockIdx.x; F.vcu = (F.G % 8 == 0) ? (bx % 8) * (F.G / 8) + bx / 8 : bx; }
    F.out = args.out; F.ws = args.ws;
    for (int u = F.tid; u < (LDS_BYTES - LDSCTL_OFF) / 4; u += NTHR) ((LAS unsigned*)(F.lds + LDSCTL_OFF))[u] = 0u;
    __syncthreads();
    if (F.tid < 36) ((LAS unsigned long long*)(F.lds + INTAB_OFF))[F.tid] = (unsigned long long)args.in[F.tid];
    __syncthreads();
#define INP(k) lds_ptr(F.lds + INTAB_OFF + 8 * (k))
    const int lo = args.ph_lo, hi = args.ph_hi;
    bf16* WB = (bf16*)(args.ws + WS_W);
    LAS MatDesc* desc = (LAS MatDesc*)(F.lds + DESC_OFF);
    BUILD_DESC();
    unsigned* barw = (unsigned*)(args.ws + WS_CTL) + CW_BAR + args.li * XCD_BAR_WORDS;
    XcdBarrier bar; bar.bar = barw; bar.x = 0; bar.st = nullptr;
    if (hi - lo > 1) bar = xcd_barrier_post(barw, F.MISC + 8);
#define IN(k) (lo <= (k) && (k) < hi)
#define FRESH() do { int t_ = threadIdx.x; asm volatile("" : "+v"(t_)); F.tid = t_; F.lane = t_ & 63; F.wave = __builtin_amdgcn_readfirstlane(t_ >> 6); } while (0)
#if defined(DBG_CONV_RAW)
#define CONV_FN conv_ffn
#else
#define CONV_FN conv_fix
#endif
#ifndef PROBE_NOSTORE
#define PROBE_NOSTORE 0
#endif
#ifndef PROBE_NOML
#define PROBE_NOML 0
#endif
#ifndef PROBE_PART
#define PROBE_PART 3
#endif
#ifndef REP_BAR
#define REP_BAR 1
#endif
#if defined(PROBE_K2)
#define K2_RERUN(gg, Mm, Nn) do { xcd_barrier(bar); _Pragma("unroll 1") for (int rr_ = 0; rr_ < PROBE_K2; ++rr_) { FRESH(); pg8::StaticOrder Sx; Sx.init((Mm), (Nn), F.G, (int)blockIdx.x); int one_ = 1; asm volatile("" : "+s"(one_)); pg8::EpiBf16<0> Ex{(pg8::bf16_t*)(args.ws + WS_SCR), 256, one_}; \
        pg8::gemm_phase<pg8::EpiBf16<0>, pg8::StaticOrder, PG8_ALIGN, PG8_SP2>(F.lds, (gg), Sx, Ex); } xcd_barrier(bar); } while (0)
#else
#define K2_RERUN(gg, Mm, Nn) do { } while (0)
#endif
#define SEAM(k) do { if (IN(k) && IN((k) + 1)) { _Pragma("unroll 1") for (int rb_ = 0; rb_ < REP_BAR; ++rb_) xcd_barrier(bar); } } while (0)
    float* X = (float*)(args.ws + WS_X); bf16* HB = (bf16*)(args.ws + WS_HB); float* PROJ = (float*)(args.ws + WS_PROJ); bf16* UP = (bf16*)(args.ws + WS_PROJ);
    bf16* OB = (bf16*)(args.ws + WS_OB); bf16* ACT = (bf16*)(args.ws + WS_ACT); float* PART = (float*)(args.ws + WS_PART); float* SSQ = (float*)(args.ws + WS_SSQ);
    unsigned* CNT = (unsigned*)(args.ws + WS_CTL) + CW_CNT;

    if (EN_P0 && IN(0)) {
        FRESH();
        __syncthreads();
        {
            const int dhi = F.G > 64 ? 7 : N_MAT;
            CONVERT(0, dhi, F.vcu * NWAVES + F.wave, F.G * NWAVES);
        }
        { bf16* wi = (bf16*)(args.ws + WS_WIN1); const float* gn = INP(7) + 1 * D; const float* wif = INP(21);
          for (int idx = F.vcu * NTHR + F.tid; idx < 256 * (D / 2); idx += F.G * NTHR) { const int r = idx / (D / 2), k2 = (idx % (D / 2)) * 2;
              unsigned w = 0u; if (r < 16) w = pk2(wif[(size_t)k2 * 16 + r] * gn[k2], wif[(size_t)(k2 + 1) * 16 + r] * gn[k2 + 1]);
              *(GAS unsigned*)(wi + (size_t)(6144 + r) * D + k2) = w; } }
        norm_rows(F, 1 | 16 | 32, 0, INP(0), INP(1), nullptr, nullptr, nullptr);
        SEAM(0);
    }
    for (int i = 0; i < 4; ++i) {
        const int kind = i % 3, base = 1 + 9 * i, j = i / 3;
        const size_t we_in = i == 0 ? WE_IN0 : i == 1 ? WE_IN1 : i == 2 ? WE_IN2 : WE_IN3, we_out = i == 0 ? WE_OUT0 : i == 1 ? WE_OUT1 : i == 2 ? WE_OUT2 : WE_OUT3;
        const int Nin = kind == 0 ? 8192 : kind == 1 ? 6144 : 4096;
        if (EN_GIN && IN(base + 0)) {
            FRESH();
            const int Ng = kind == 1 ? 6400 : Nin;
            const bool split = (kind != 1) && (F.G >= 256);
            const bf16* Wt = kind == 1 ? (const bf16*)(args.ws + WS_WIN1) : WB + we_in;
            pg8::Gemm g{HB, Wt, split ? MP : M, Ng, D, D}; pg8::StaticOrder S; S.init(split ? MP : M, Ng, F.G, (int)blockIdx.x);
            fill_rstd_table(F, S);
            { pg8::EpiF32 E{PROJ, Nin, kind == 2 ? INP(26) : (const float*)nullptr, 0, (const LAS float*)(F.lds + RTAB_OFF),
                    kind == 1 ? 24 : -1, (float*)(args.ws + WS_GATES), INP(22)};
            pg8::gemm_phase<pg8::EpiF32, pg8::StaticOrder, PG8_ALIGN, PG8_SP2>(F.lds, g, S, E); }
            if (split) { pg8::Gemm g2{HB + (size_t)MP * D, Wt, MS, Ng, 512, D}; pg8::SplitOrder S2; S2.init(MS, Ng, 4, 512, F.G, (int)blockIdx.x);
                pg8::EpiPart E2{(float*)(args.ws + WS_SCR), Ng, (size_t)MS * Ng};
                pg8::gemm_phase<pg8::EpiPart, pg8::SplitOrder, PG8_ALIGN, PG8_SP2>(F.lds, g2, S2, E2);
                sample_reduce_proj<4>(F, S2, CNT + 8192 + (size_t)i * 64 * 64, Ng, kind == 2 ? INP(26) : (const float*)nullptr); }
            if (i == 1 && F.G > 64) {
                const int rem = (M / 256) * (Ng / 256) % F.G, bx = (int)blockIdx.x;
                if (rem != 0 && bx >= rem) { __syncthreads(); CONVERT_FR(18, N_MAT, 0, 9, 20, (bx - rem) * NWAVES + F.wave, (F.G - rem) * NWAVES); }
                else if (rem == 0) { __syncthreads(); CONVERT_FR(18, N_MAT, 0, 9, 20, F.vcu * NWAVES + F.wave, F.G * NWAVES); }
            }
            SEAM(base + 0);
        }
        if (EN_MIXA && IN(base + 1)) {
            FRESH();
            if (kind == 0) { { FRESH(); hgrn_scan(F, j, INP(14), INP(15) + j * D, INP(2), 3); }
                if (i == 0 && F.G > 64 && blockIdx.x >= 64) { __syncthreads();
                    CONVERT(7, 14, ((int)blockIdx.x - 64) * NWAVES + F.wave, (F.G - 64) * NWAVES); } }
            else if (kind == 1) { { FRESH(); mlstm_scan(F, INP(3), INP(4), INP(5)); }
                if (F.G > 64 && blockIdx.x >= 64) { __syncthreads();
                    CONVERT(14, 18, ((int)blockIdx.x - 64) * NWAVES + F.wave, (F.G - 64) * NWAVES); CONVERT_FR(18, N_MAT, 9, 20, 20, ((int)blockIdx.x - 64) * NWAVES + F.wave, (F.G - 64) * NWAVES); } }
            else gmlp_a(F, INP(27), INP(28));
            SEAM(base + 1);
        }
        if (EN_MIXB && kind != 0 && IN(base + 2)) {
            FRESH();
            {
            if (kind == 1) mlstm_post(F, INP(23));
            else gmlp_b(F, INP(29), INP(30)); }
            SEAM(base + 2);
        }
        if (EN_GOUT && IN(base + 3)) {
            FRESH();
            { pg8::Gemm g{OB, WB + we_out, MP, D, D, D}; pg8::StaticOrder S; S.init(MP, D, F.G, (int)blockIdx.x);
              if (kind == 0) fill_rstd_table16(F, S);
              { pg8::EpiResid E{i == 0 ? INP(0) : (const float*)X, X, D, HB, SSQ, kind == 0 ? (const LAS float*)(F.lds + RTAB_OFF) : (const LAS float*)nullptr};
              pg8::gemm_phase<pg8::EpiResid, pg8::StaticOrder, PG8_ALIGN, PG8_SP2>(F.lds, g, S, E); } K2_RERUN(g, MP, D); }
            { pg8::Gemm g{OB + (size_t)MP * D, WB + we_out, MS, D, 256, D}; pg8::SplitOrder S; S.init(MS, D, 8, 256, F.G, (int)blockIdx.x);
              pg8::EpiPart E{PART, D, (size_t)MS * D};
              pg8::gemm_phase<pg8::EpiPart, pg8::SplitOrder, PG8_ALIGN, PG8_SP2>(F.lds, g, S, E);
#if !defined(DBG_REDUCE_PHASE)
              sample_reduce<8>(F, S, CNT + (size_t)(2 * i) * 16 * 64, i == 0 ? INP(1) : (const float*)(X + (size_t)MP * D), kind == 0 ? (const float*)(args.ws + WS_OSSQ) : (const float*)nullptr);
#endif
            }
            SEAM(base + 3);
#if defined(DBG_REDUCE_PHASE)
            FRESH(); sample_reduce_rows(F, 4); xcd_barrier(bar);
#endif
        }
        if (EN_GUP && IN(base + 5)) {
            FRESH();
            pg8::Gemm g{HB, WB + WE_UP + (size_t)i * WE_UP_STRIDE, M, F2, D, D}; pg8::StaticOrder S; S.init(M, F2, F.G, (int)blockIdx.x);
            fill_rstd_table(F, S);
            { pg8::EpiConv E{ACT, PROJ, PROJ + 8 * MiB, args.out + O_CVP + (size_t)i * NB * 2 * F2, INP(33) + (size_t)i * 3 * F2, INP(34) + (size_t)i * F2, FF, MP / 256, (const LAS float*)(F.lds + RTAB_OFF), (LAS float*)(F.lds + RING_BYTES)};
              pg8::gemm_phase<pg8::EpiConv, pg8::StaticOrder, PG8_ALIGN, PG8_SP2>(F.lds, g, S, E); }
            SEAM(base + 5);
        }
        if (EN_CONV && IN(base + 6)) { FRESH(); CONV_FN(F, i, INP(33) + (size_t)i * 3 * F2, INP(34) + (size_t)i * F2, INP(6)); SEAM(base + 6); }
        if (EN_GDOWN && IN(base + 7)) {
            FRESH();
            { pg8::Gemm g{ACT, WB + WE_DOWN + (size_t)i * WE_DOWN_STRIDE, MP, D, FF, FF}; pg8::StaticOrder S; S.init(MP, D, F.G, (int)blockIdx.x);
              { pg8::EpiResid E{X, X, D, i == 3 ? (bf16*)nullptr : HB, SSQ, (const LAS float*)nullptr};
              pg8::gemm_phase<pg8::EpiResid, pg8::StaticOrder, PG8_ALIGN, PG8_SP2>(F.lds, g, S, E); } }
            { pg8::Gemm g{ACT + (size_t)MP * FF, WB + WE_DOWN + (size_t)i * WE_DOWN_STRIDE, MS, D, 512, FF}; pg8::SplitOrder S; S.init(MS, D, 11, 512, F.G, (int)blockIdx.x);
              pg8::EpiPart E{PART, D, (size_t)MS * D};
              pg8::gemm_phase<pg8::EpiPart, pg8::SplitOrder, PG8_ALIGN, PG8_SP2>(F.lds, g, S, E);
#if !defined(DBG_REDUCE_PHASE)
              sample_reduce<11>(F, S, CNT + (size_t)(2 * i + 1) * 16 * 64, (const float*)(X + (size_t)MP * D), (const float*)nullptr);
#endif
            }
            SEAM(base + 7);
#if defined(DBG_REDUCE_PHASE)
            FRESH(); sample_reduce_rows(F, 11); xcd_barrier(bar);
#endif
        }
        if (EN_NORM && i == 3 && IN(base + 8)) { FRESH(); norm_rows(F, 2, 0, nullptr, nullptr, INP(9), nullptr, nullptr); }
    }
#undef IN
#undef SEAM
}

extern "C" void kernel_launch(void* const* d_in, const int* in_sizes, int n_in, void* d_out, int out_size, void* d_ws, size_t ws_size, hipStream_t stream) {
    static int grid = 0;
    if (grid == 0) {
        if (n_in != 36 || (size_t)out_size != O_END || ws_size < WS_END) { fprintf(stderr, "kernel_launch: unexpected shapes: n_in %d out %d ws %zu (need %zu)\n", n_in, out_size, ws_size, (size_t)WS_END); grid = -1; return; }
        int dev = 0, cus = 0;
        if (hipGetDevice(&dev) != hipSuccess || hipDeviceGetAttribute(&cus, hipDeviceAttributeMultiprocessorCount, dev) != hipSuccess) { grid = -1; return; }
        if (hipFuncSetAttribute((const void*)mk_fwd, hipFuncAttributeMaxDynamicSharedMemorySize, LDS_BYTES) != hipSuccess) { fprintf(stderr, "kernel_launch: hipFuncSetAttribute failed\n"); grid = -1; return; }
        int per_cu = 0;
        if (hipOccupancyMaxActiveBlocksPerMultiprocessor(&per_cu, (const void*)mk_fwd, NTHR, LDS_BYTES) != hipSuccess || per_cu < 1) { fprintf(stderr, "kernel_launch: occupancy query says %d blocks per CU\n", per_cu); }
        (void)hipGetLastError();
        grid = cus;
    }
    if (grid < 0) return;
    (void)hipMemsetAsync((char*)d_ws + WS_CTL, 0, CTL_ZERO_BYTES, stream);
    Args a{};
    for (int i = 0; i < 36; ++i) a.in[i] = (const float*)d_in[i];
    a.out = (float*)d_out; a.ws = (unsigned char*)d_ws; a.pad = 0;
#if MK_N_LAUNCHES == 1
    a.ph_lo = 0; a.ph_hi = NPHASE; a.li = 0;
    hipLaunchKernelGGL(mk_fwd, dim3(grid), dim3(NTHR), LDS_BYTES, stream, a);
#else
    for (int p = 0; p < NPHASE; ++p) { a.ph_lo = p; a.ph_hi = p + 1; a.li = p;
        hipLaunchKernelGGL(mk_fwd, dim3(grid), dim3(NTHR), LDS_BYTES, stream, a); }
#endif
}
```

```cpp
#include <hip/hip_runtime.h>
#include <cstdio>
#include <cstdint>
#ifndef PG8_WGM
#define PG8_WGM 4
#endif
namespace pg8 {
#define PG8_LAS __attribute__((address_space(3)))
typedef unsigned short bf16_t;
typedef short bf16x8 __attribute__((ext_vector_type(8)));
typedef float f32x4 __attribute__((ext_vector_type(4)));
typedef unsigned u32x4 __attribute__((ext_vector_type(4)));
constexpr int BM = 256, BK = 64, HALF = 128, HTB = HALF * BK * 2  , STAGE_BYTES = 8 * HTB, NXCD = 8, WGM = PG8_WGM;

__host__ __device__ __forceinline__ int lds_byte(int r, int c) { const int st = (r >> 4) * 2 + (c >> 5), rr = r & 15, cc = c & 31, ob = rr * 64 + cc * 2; return st * 1024 + (ob ^ (((ob >> 9) & 1) << 5)); }
__host__ __device__ __forceinline__ void stage_rc(int b, int& R, int& C) { const int st = b / 1024, sb = b % 1024, swz = sb ^ (((sb >> 9) & 1) << 5); R = (st >> 1) * 16 + swz / 64; C = (st & 1) * 32 + (swz % 64) / 2; }
__host__ __device__ __forceinline__ int perm32(int rho) { const int n = rho >> 4, i = rho & 15; return 8 * (i >> 2) + 4 * n + (i & 3); }

struct Unit { int pm, pn, kofs, ks, slot; };
struct Gemm { const bf16_t* A; const bf16_t* Bt; int M, N, K, ld; };

struct StaticOrder {
    int nM, nN, nwg, G, c;
    __host__ __device__ void init(int M, int N, int G_, int c_) { nM = M / BM; nN = N / BM; nwg = nM * nN; G = G_; c = c_; }
    __host__ __device__ bool next(int i, Unit& u) const {
        const long L = (long)i * G + c; if (L >= nwg) return false;
        int wgid = (int)L; { const int q = nwg / NXCD, r = nwg % NXCD, xcd = wgid % NXCD, off = wgid / NXCD; wgid = (xcd < r ? xcd * (q + 1) : r * (q + 1) + (xcd - r) * q) + off; }
        const int nig = WGM * nN, gid = wgid / nig, fm = gid * WGM, gsz = (nM - fm) < WGM ? (nM - fm) : WGM;
        u.pm = fm + ((wgid % nig) % gsz); u.pn = (wgid % nig) / gsz; u.kofs = 0; u.ks = 0; u.slot = i; return true;
    }
    __device__ __forceinline__ void a_ready(const Unit&) const {}
    __device__ __forceinline__ void done(const Unit&) const {}
};
struct SplitOrder {
    int nN, nK, Ksub, nunits, G, c;
    __host__ __device__ void init(int Mrows, int N, int nK_, int Ksub_, int G_, int c_) { nN = N / BM; nK = nK_; Ksub = Ksub_; nunits = (Mrows / BM) * nN * nK; G = G_; c = c_; }
    __host__ __device__ bool next(int i, Unit& u) const {
        const int L = i * G + c; if (L >= nunits) return false;
        u.ks = L % nK; const int r = L / nK; u.pn = r % nN; u.pm = r / nN; u.kofs = u.ks * Ksub; u.slot = i; return true;
    }
    __device__ __forceinline__ void a_ready(const Unit&) const {}
    __device__ __forceinline__ void done(const Unit&) const {}
};
__device__ __forceinline__ unsigned cvt_pk_bf16(float lo, float hi) { unsigned r; asm volatile("v_cvt_pk_bf16_f32 %0, %1, %2" : "=v"(r) : "v"(lo), "v"(hi)); return r; }
typedef float f32x2c __attribute__((ext_vector_type(2))); typedef __bf16 bf16x2c __attribute__((ext_vector_type(2)));
__device__ __forceinline__ unsigned pk2_(float lo, float hi) { f32x2c v; v.x = lo; v.y = hi; return __builtin_bit_cast(unsigned, __builtin_convertvector(v, bf16x2c)); }
__device__ __forceinline__ void rows_rstd(const float* SSQ, const Unit& u, int wr, int fr, int fq, float inv_d, float eps, float (&rs)[2][4]) {
#pragma unroll
    for (int ai = 0; ai < 2; ++ai)
#pragma unroll
        for (int m = 0; m < 4; ++m) { const float* p = SSQ + (size_t)(u.pm * BM + ai * HALF + wr * 64 + m * 16 + fr) * 32 + fq * 8;
            const f32x4 a = *(const f32x4*)p, b = *(const f32x4*)(p + 4); float s = ((a[0] + a[1]) + (a[2] + a[3])) + ((b[0] + b[1]) + (b[2] + b[3]));
            s += __shfl_xor(s, 16); s += __shfl_xor(s, 32); rs[ai][m] = 1.0f / sqrtf(s * inv_d + eps); }
}
__device__ __forceinline__ void rows_rstd_lds(const PG8_LAS float* tab, const Unit& u, int wr, int fr, float (&rs)[2][4]) {
#pragma unroll
    for (int ai = 0; ai < 2; ++ai)
#pragma unroll
        for (int m = 0; m < 4; ++m) rs[ai][m] = tab[u.slot * 256 + ai * HALF + wr * 64 + m * 16 + fr];
}
template <int ACT> struct EpiBf16 {
    static constexpr bool PERM = true, AFTER_DRAIN = false;
    bf16_t* O; int ldc; int skip;
    __device__ __forceinline__ void operator()(const f32x4 (&acc)[2][2][4][2], const Unit& u, int wr, int wc, int fr, int fq) const {
        if (skip) return;
        const int row0 = u.pm * BM + wr * 64 + fr; const int col0 = u.pn * BM + wc * 32 + 8 * fq;
#pragma unroll
        for (int ai = 0; ai < 2; ++ai)
#pragma unroll
            for (int m = 0; m < 4; ++m) { bf16_t* rowp = O + (size_t)(row0 + ai * HALF + m * 16) * ldc + col0;
#pragma unroll
                for (int bj = 0; bj < 2; ++bj) { const f32x4 v0 = acc[ai][bj][m][0], v1 = acc[ai][bj][m][1];
                    u32x4 w; w.x = cvt_pk_bf16(v0[0], v0[1]); w.y = cvt_pk_bf16(v0[2], v0[3]); w.z = cvt_pk_bf16(v1[0], v1[1]); w.w = cvt_pk_bf16(v1[2], v1[3]);
                    *(u32x4*)(rowp + bj * HALF) = w; } }
    }
};
struct EpiF32 {
    static constexpr bool PERM = false, AFTER_DRAIN = false;
    float* C; int ldc; const float* bias; int skip; const PG8_LAS float* rtab;
    int gate_pn; float* GATES; const float* b_if;
    __device__ __forceinline__ void operator()(const f32x4 (&acc)[2][2][4][2], const Unit& u, int wr, int wc, int fr, int fq) const {
        if (skip) return;
        float rs[2][4]; rows_rstd_lds(rtab, u, wr, fr, rs);
        const int row0 = u.pm * BM + wr * 64 + fr, col0 = u.pn * BM + wc * 32 + 4 * fq;
        if (u.pn == gate_pn) {
            if (wc == 0) { const f32x4 bb = *(const f32x4*)(b_if + 4 * fq);
#pragma unroll
                for (int ai = 0; ai < 2; ++ai)
#pragma unroll
                    for (int m = 0; m < 4; ++m) { f32x4 o;
#pragma unroll
                        for (int e = 0; e < 4; ++e) { const float pre = acc[ai][0][m][0][e] * rs[ai][m] + bb[e]; const float gate = 15.0f - 30.0f * __builtin_amdgcn_rcpf(1.0f + __expf(pre * (2.0f / 15.0f)));     o[e] = fq < 2 ? gate : -__logf(1.0f + __expf(-gate)); }
                        *(f32x4*)(GATES + (size_t)(row0 + ai * HALF + m * 16) * 16 + 4 * fq) = o; } }
            return;
        }
        f32x4 bv[2][2];
#pragma unroll
        for (int bj = 0; bj < 2; ++bj)
#pragma unroll
            for (int n = 0; n < 2; ++n) bv[bj][n] = bias ? *(const f32x4*)(bias + col0 + bj * HALF + n * 16) : (f32x4){0.f, 0.f, 0.f, 0.f};
#pragma unroll
        for (int ai = 0; ai < 2; ++ai)
#pragma unroll
            for (int m = 0; m < 4; ++m) { float* rowp = C + (size_t)(row0 + ai * HALF + m * 16) * ldc + col0;
#pragma unroll
                for (int bj = 0; bj < 2; ++bj)
#pragma unroll
                    for (int n = 0; n < 2; ++n) *(f32x4*)(rowp + bj * HALF + n * 16) = acc[ai][bj][m][n] * rs[ai][m] + bv[bj][n]; }
    }
};
#if defined(EPI_NT)
#define EPI_ST(T, p, v) __builtin_nontemporal_store((v), (T*)(p))
#else
#define EPI_ST(T, p, v) (*(T*)(p) = (v))
#endif
struct EpiResid {
    static constexpr bool PERM = false, AFTER_DRAIN = false;
    const float* res; float* out; int ldc; bf16_t* XB; float* SSQ; const PG8_LAS float* rtab;
    __device__ __forceinline__ void operator()(const f32x4 (&acc)[2][2][4][2], const Unit& u, int wr, int wc, int fr, int fq) const {
        typedef unsigned u32x2 __attribute__((ext_vector_type(2)));
        const int row0 = u.pm * BM + wr * 64 + fr, col0 = u.pn * BM + wc * 32 + 4 * fq;
#pragma unroll
        for (int ai = 0; ai < 2; ++ai) {
            f32x4 r[4][2][2];
#pragma unroll
            for (int m = 0; m < 4; ++m) { const size_t off = (size_t)(row0 + ai * HALF + m * 16) * ldc + col0;
#pragma unroll
                for (int bj = 0; bj < 2; ++bj)
#pragma unroll
                    for (int n = 0; n < 2; ++n) r[m][bj][n] = *(const f32x4*)(res + off + bj * HALF + n * 16); }
#pragma unroll
            for (int m = 0; m < 4; ++m) { const size_t off = (size_t)(row0 + ai * HALF + m * 16) * ldc + col0;
                const float rsc = rtab ? rtab[u.slot * 256 + ai * HALF + wr * 64 + m * 16 + fr] : 1.0f; float s = 0.f;
#pragma unroll
                for (int bj = 0; bj < 2; ++bj)
#pragma unroll
                    for (int n = 0; n < 2; ++n) { const f32x4 x = acc[ai][bj][m][n] * rsc + r[m][bj][n]; EPI_ST(f32x4, out + off + bj * HALF + n * 16, x);
                        if (XB) { u32x2 w; w.x = pk2_(x[0], x[1]); w.y = pk2_(x[2], x[3]); EPI_ST(u32x2, XB + off + bj * HALF + n * 16, w); }
                        s += (x[0] * x[0] + x[1] * x[1]) + (x[2] * x[2] + x[3] * x[3]); }
                if (XB) { s += __shfl_xor(s, 16); s += __shfl_xor(s, 32);
                    if (fq == 0) SSQ[(size_t)(row0 + ai * HALF + m * 16) * 32 + u.pn * 4 + wc] = s; } }
            asm volatile("" ::: "memory");
        }
    }
};
#if !defined(PART_F32) && !defined(PART_BF16)
#define PART_BF16 1
#endif
struct EpiPart {
    static constexpr bool PERM = false, AFTER_DRAIN = false;
    float* P; int ldc; size_t slab;
    __device__ __forceinline__ void operator()(const f32x4 (&acc)[2][2][4][2], const Unit& u, int wr, int wc, int fr, int fq) const {
        const int row0 = u.pm * BM + wr * 64 + fr, col0 = u.pn * BM + wc * 32 + 4 * fq;
#if defined(PART_BF16)
        typedef unsigned u32x2 __attribute__((ext_vector_type(2)));
        bf16_t* base = (bf16_t*)P + (size_t)u.ks * slab;
#pragma unroll
        for (int ai = 0; ai < 2; ++ai)
#pragma unroll
            for (int m = 0; m < 4; ++m) { bf16_t* rowp = base + (size_t)(row0 + ai * HALF + m * 16) * ldc + col0;
#pragma unroll
                for (int bj = 0; bj < 2; ++bj)
#pragma unroll
                    for (int n = 0; n < 2; ++n) { const f32x4 v = acc[ai][bj][m][n]; u32x2 w; w.x = pk2_(v[0], v[1]); w.y = pk2_(v[2], v[3]); *(u32x2*)(rowp + bj * HALF + n * 16) = w; } }
#else
        float* base = P + (size_t)u.ks * slab;
#pragma unroll
        for (int ai = 0; ai < 2; ++ai)
#pragma unroll
            for (int m = 0; m < 4; ++m) { float* rowp = base + (size_t)(row0 + ai * HALF + m * 16) * ldc + col0;
#pragma unroll
                for (int bj = 0; bj < 2; ++bj)
#pragma unroll
                    for (int n = 0; n < 2; ++n) *(f32x4*)(rowp + bj * HALF + n * 16) = acc[ai][bj][m][n]; }
#endif
    }
};

#ifndef DPP_R1
#define DPP_R1 0x121
#define DPP_R2 0x122
#endif
__device__ __forceinline__ f32x4 dpp_ror4(const f32x4 v, const int which) {
    f32x4 r;
#if defined(DBG_SHFL)
    { const int ln = __lane_id(); const int src = (ln & ~15) | ((ln - which) & 15);
#pragma unroll
      for (int e = 0; e < 4; ++e) r[e] = __shfl(v[e], src);
      return r; }
#endif
#pragma unroll
    for (int e = 0; e < 4; ++e) { const int x = __builtin_bit_cast(int, v[e]);
        r[e] = __builtin_bit_cast(float, which == 1 ? __builtin_amdgcn_update_dpp(0, x, DPP_R1, 0xF, 0xF, false) : __builtin_amdgcn_update_dpp(0, x, DPP_R2, 0xF, 0xF, false)); }
    return r;
}
template <int CTRL> __device__ __forceinline__ f32x4 dpp_mov4(const f32x4 v) {
    f32x4 r;
#pragma unroll
    for (int e = 0; e < 4; ++e) { int x = __builtin_bit_cast(int, v[e]); asm volatile("" : "+v"(x)); int y = __builtin_amdgcn_update_dpp(0, x, CTRL, 0xF, 0xF, true); asm volatile("" : "+v"(y)); r[e] = __builtin_bit_cast(float, y); }
    return r;
}
struct EpiConv {
    static constexpr bool PERM = true, AFTER_DRAIN = false;
    bf16_t* ACT; float* SIDE; float* UPS; float* cvp; const float* cw; const float* cb; int FFd, mp_tiles; const PG8_LAS float* rtab; PG8_LAS float* cwl;
    __device__ __forceinline__ void operator()(f32x4 (&acc)[2][2][4][2], const Unit& u, int wr, int wc, int fr, int fq) const {
        const int F2d = 2 * FFd;
        { float rs[2][4]; rows_rstd_lds(rtab, u, wr, fr, rs);
#pragma unroll
          for (int ai = 0; ai < 2; ++ai)
#pragma unroll
            for (int bj = 0; bj < 2; ++bj)
#pragma unroll
                for (int m = 0; m < 4; ++m)
#pragma unroll
                    for (int n = 0; n < 2; ++n) acc[ai][bj][m][n] = acc[ai][bj][m][n] * rs[ai][m]; }
        const int c0 = u.pn * 128 + wc * 32 + 8 * fq;
#if defined(DBG_CONV_RAW)
        { bf16_t* UPB = (bf16_t*)SIDE; const int row0 = u.pm * BM + wr * 64 + fr;
#pragma unroll
          for (int ai = 0; ai < 2; ++ai)
#pragma unroll
            for (int m = 0; m < 4; ++m) { bf16_t* rp = UPB + (size_t)(row0 + ai * HALF + m * 16) * F2d + c0;
                u32x4 wA, wG; wA.x = pk2_(acc[ai][0][m][0][0], acc[ai][0][m][0][1]); wA.y = pk2_(acc[ai][0][m][0][2], acc[ai][0][m][0][3]); wA.z = pk2_(acc[ai][0][m][1][0], acc[ai][0][m][1][1]); wA.w = pk2_(acc[ai][0][m][1][2], acc[ai][0][m][1][3]);
                wG.x = pk2_(acc[ai][1][m][0][0], acc[ai][1][m][0][1]); wG.y = pk2_(acc[ai][1][m][0][2], acc[ai][1][m][0][3]); wG.z = pk2_(acc[ai][1][m][1][0], acc[ai][1][m][1][1]); wG.w = pk2_(acc[ai][1][m][1][2], acc[ai][1][m][1][3]);
                *(u32x4*)rp = wA; *(u32x4*)(rp + FFd) = wG; }
          return; }
#endif
        if (u.pm >= mp_tiles) {
            const int rloc0 = (u.pm - mp_tiles) * BM + wr * 64 + fr;
#pragma unroll
            for (int ai = 0; ai < 2; ++ai)
#pragma unroll
                for (int m = 0; m < 4; ++m) { float* rp = UPS + (size_t)(rloc0 + ai * HALF + m * 16) * F2d + c0;
#pragma unroll
                    for (int n = 0; n < 2; ++n) { *(f32x4*)(rp + 4 * n) = acc[ai][0][m][n]; *(f32x4*)(rp + FFd + 4 * n) = acc[ai][1][m][n]; } }
            return;
        }
#if !defined(CONV_W_GLOBAL)
        { typedef float f32x2_ __attribute__((ext_vector_type(2)));
          const int t2 = (((wr * 4 + wc) * 64) + fq * 16 + fr) * 2, a = t2 >> 7, col = t2 & 127;
          const float* src = ((a & 3) == 3 ? cb : cw + (size_t)(a & 3) * F2d) + (a >> 2) * FFd + u.pn * 128 + col;
          const f32x2_ v = *(const f32x2_*)src; *(PG8_LAS f32x2_*)(cwl + t2) = v; }
        asm volatile("s_waitcnt lgkmcnt(0)" ::: "memory"); __builtin_amdgcn_s_barrier(); asm volatile("" ::: "memory");
#endif
#pragma unroll
        for (int n = 0; n < 2; ++n) {
            const int c = c0 + 4 * n;
#if !defined(CONV_W_GLOBAL)
            const PG8_LAS float* wl = cwl + wc * 32 + 8 * fq + 4 * n;
            const f32x4 wa0 = *(const PG8_LAS f32x4*)(wl), wa1 = *(const PG8_LAS f32x4*)(wl + 128), wa2 = *(const PG8_LAS f32x4*)(wl + 256), ba = *(const PG8_LAS f32x4*)(wl + 384);
            const f32x4 wg0 = *(const PG8_LAS f32x4*)(wl + 512), wg1 = *(const PG8_LAS f32x4*)(wl + 640), wg2 = *(const PG8_LAS f32x4*)(wl + 768), bg = *(const PG8_LAS f32x4*)(wl + 896);
#else
            const f32x4 wa0 = *(const f32x4*)(cw + c), wa1 = *(const f32x4*)(cw + F2d + c), wa2 = *(const f32x4*)(cw + 2 * F2d + c), ba = *(const f32x4*)(cb + c);
            const f32x4 wg0 = *(const f32x4*)(cw + FFd + c), wg1 = *(const f32x4*)(cw + F2d + FFd + c), wg2 = *(const f32x4*)(cw + 2 * F2d + FFd + c), bg = *(const f32x4*)(cb + FFd + c);
#endif
#pragma unroll
            for (int ai = 0; ai < 2; ++ai) {
                const int blk = u.pm * 4 + ai * 2 + wr;
#pragma unroll
                for (int m = 0; m < 4; ++m) {
                    const f32x4 xa = acc[ai][0][m][n], xg = acc[ai][1][m][n];
                    const f32x4 pa = acc[ai][0][m > 0 ? m - 1 : 0][n], pg = acc[ai][1][m > 0 ? m - 1 : 0][n];
                    const int ln_ = __lane_id(), s1_ = ((ln_ & ~15) | ((ln_ - 1) & 15)) << 2, s2_ = ((ln_ & ~15) | ((ln_ - 2) & 15)) << 2;
                    f32x4 a1c, a2c, g1c, g2c;
#pragma unroll
                    for (int e = 0; e < 4; ++e) {
#if !defined(CONV_BPERMUTE)
                        a1c[e] = __builtin_bit_cast(float, __builtin_amdgcn_update_dpp(0, __builtin_bit_cast(int, fr == 15 ? pa[e] : xa[e]), 0x121, 0xF, 0xF, true));
                        a2c[e] = __builtin_bit_cast(float, __builtin_amdgcn_update_dpp(0, __builtin_bit_cast(int, fr >= 14 ? pa[e] : xa[e]), 0x122, 0xF, 0xF, true));
                        g1c[e] = __builtin_bit_cast(float, __builtin_amdgcn_update_dpp(0, __builtin_bit_cast(int, fr == 15 ? pg[e] : xg[e]), 0x121, 0xF, 0xF, true));
                        g2c[e] = __builtin_bit_cast(float, __builtin_amdgcn_update_dpp(0, __builtin_bit_cast(int, fr >= 14 ? pg[e] : xg[e]), 0x122, 0xF, 0xF, true)); }
#else
                        a1c[e] = __builtin_bit_cast(float, __builtin_amdgcn_ds_bpermute(s1_, __builtin_bit_cast(int, fr == 15 ? pa[e] : xa[e])));
                        a2c[e] = __builtin_bit_cast(float, __builtin_amdgcn_ds_bpermute(s2_, __builtin_bit_cast(int, fr >= 14 ? pa[e] : xa[e])));
                        g1c[e] = __builtin_bit_cast(float, __builtin_amdgcn_ds_bpermute(s1_, __builtin_bit_cast(int, fr == 15 ? pg[e] : xg[e])));
                        g2c[e] = __builtin_bit_cast(float, __builtin_amdgcn_ds_bpermute(s2_, __builtin_bit_cast(int, fr >= 14 ? pg[e] : xg[e]))); }
#endif
                    const f32x4 a1p = a1c, a2p = a2c, g1p = g1c, g2p = g2c;
                    f32x4 o;
#pragma unroll
                    for (int e = 0; e < 4; ++e) {
                        const float a1 = fr == 0 ? a1p[e] : a1c[e], a2 = fr < 2 ? a2p[e] : a2c[e], g1 = fr == 0 ? g1p[e] : g1c[e], g2 = fr < 2 ? g2p[e] : g2c[e];
                        const float ya = ba[e] + wa0[e] * a2 + wa1[e] * a1 + wa2[e] * xa[e], yg = bg[e] + wg0[e] * g2 + wg1[e] * g1 + wg2[e] * xg[e];
                        o[e] = ya * yg * __builtin_amdgcn_rcpf(1.0f + __expf(-yg)); }
                    const int lt = ai * HALF + wr * 64 + m * 16 + fr;
                    if (!(m == 0 && fr < 2)) { typedef unsigned u32x2 __attribute__((ext_vector_type(2))); u32x2 w; w.x = pk2_(o[0], o[1]); w.y = pk2_(o[2], o[3]);
                        *(u32x2*)(ACT + (size_t)(u.pm * BM + lt) * FFd + c) = w; }
                    if (m == 0 && fr < 2) { float* sp = SIDE + ((size_t)blk * 4 + 2 + fr) * F2d + c; *(f32x4*)sp = xa; *(f32x4*)(sp + FFd) = xg; }
                    if (m == 3 && fr >= 14) { float* sp = SIDE + ((size_t)blk * 4 + (fr - 14)) * F2d + c; *(f32x4*)sp = xa; *(f32x4*)(sp + FFd) = xg;
                        if ((u.pm & 7) == 7 && ai == 1 && wr == 1) { float* po = cvp + ((size_t)(u.pm >> 3) * 2 + (fr - 14)) * F2d + c; *(f32x4*)po = xa; *(f32x4*)(po + FFd) = xg; } }
                }
            }
        }
    }
};

template <class Epi, class Sched, bool ALIGN_EPI = false, bool SP2 = false>
__device__ __forceinline__ void gemm_phase(PG8_LAS unsigned char* lds, const Gemm g, const Sched& S, const Epi& E) {
    int tid_ = threadIdx.x; asm volatile("" : "+v"(tid_));
    const int tid = tid_, wid = __builtin_amdgcn_readfirstlane(tid >> 6), lane = tid & 63, wr = wid >> 2, wc = wid & 3, fr = lane & 15, fq = lane >> 4;
    const int K = g.K, nt = K / BK, LD = g.ld;
    unsigned voffA[2], voffB[2];
#pragma unroll
    for (int i = 0; i < 2; ++i) { int R, C; stage_rc(tid * 16 + i * 8192, R, C); const int Rb = Epi::PERM ? ((R & ~31) + perm32(R & 31)) : R;
        voffA[i] = (unsigned)(R * LD + C) * 2u; voffB[i] = (unsigned)(Rb * LD + C) * 2u; }
    const size_t kstep = (size_t)(BK * 2);
    const size_t hstep = (size_t)HALF * LD * 2;
    const size_t tstep = 2 * hstep;
    const unsigned ldsw = (unsigned)wid * 1024u;
    const int aoff = lds_byte(wr * 64 + fr, fq * 8), boff = lds_byte(wc * 32 + fr, fq * 8);
#define PG8_SA(b, h) (((b) * 2 + (h)) * HTB)
#define PG8_SB(b, h) ((4 + (b) * 2 + (h)) * HTB)
#define PG8_STAGE(bufoff, gbase, voff) do { _Pragma("unroll") for (int _i = 0; _i < 2; ++_i) \
        __builtin_amdgcn_global_load_lds((const unsigned*)((const char*)(gbase) + (voff)[_i]), (PG8_LAS unsigned*)(lds + (bufoff) + ldsw + _i * 8192), 16, 0, 0); } while (0)
#define PG8_LDA(dst, b, h) do { _Pragma("unroll") for (int m = 0; m < 4; ++m) _Pragma("unroll") for (int k = 0; k < 2; ++k) dst[m][k] = *(const PG8_LAS bf16x8*)(lds + PG8_SA(b, h) + aoff + m * 2048 + k * 1024); } while (0)
#define PG8_LDB(dst, b, h) do { _Pragma("unroll") for (int n = 0; n < 2; ++n) _Pragma("unroll") for (int k = 0; k < 2; ++k) dst[n][k] = *(const PG8_LAS bf16x8*)(lds + PG8_SB(b, h) + boff + n * 2048 + k * 1024); } while (0)
#define PG8_MMA(ai, bj, At, Bt) do { __builtin_amdgcn_s_setprio(1); _Pragma("unroll") for (int m = 0; m < 4; ++m) _Pragma("unroll") for (int n = 0; n < 2; ++n) _Pragma("unroll") for (int k = 0; k < 2; ++k) \
        acc[ai][bj][m][n] = __builtin_amdgcn_mfma_f32_16x16x32_bf16(Bt[n][k], At[m][k], acc[ai][bj][m][n], 0, 0, 0); __builtin_amdgcn_s_setprio(0); } while (0)
#define PG8_WAIT_V(n) asm volatile("s_waitcnt vmcnt(" #n ")" ::: "memory")
#define PG8_WAIT_L(n) asm volatile("s_waitcnt lgkmcnt(" #n ")" ::: "memory")
#define PG8_BAR __builtin_amdgcn_s_barrier()
#define PG8_SCHED __builtin_amdgcn_sched_barrier(0)
    Unit cur, nxt; int ui = 0;
    if (!S.next(0, cur)) return;
    f32x4 acc[2][2][4][2];
#pragma unroll
    for (int a = 0; a < 2; ++a)
#pragma unroll
        for (int b = 0; b < 2; ++b)
#pragma unroll
            for (int m = 0; m < 4; ++m)
#pragma unroll
                for (int n = 0; n < 2; ++n) acc[a][b][m][n] = (f32x4){0.f, 0.f, 0.f, 0.f};
    bf16x8 At[4][2], B0[2][2], B1[2][2];
    const char* cA = (const char*)g.A + (size_t)cur.pm * tstep + (size_t)cur.kofs * 2; const char* cB = (const char*)g.Bt + (size_t)cur.pn * tstep + (size_t)cur.kofs * 2;
    S.a_ready(cur);
    if constexpr (SP2) {
        PG8_STAGE(PG8_SB(0, 0), cB, voffB); PG8_STAGE(PG8_SB(0, 1), cB + hstep, voffB); PG8_STAGE(PG8_SA(0, 0), cA, voffA); PG8_STAGE(PG8_SA(0, 1), cA + hstep, voffA);
        if (wr == 1) PG8_BAR;
        PG8_WAIT_V(2); PG8_BAR;
        PG8_STAGE(PG8_SB(1, 0), cB + kstep, voffB); PG8_STAGE(PG8_SA(1, 0), cA + kstep, voffA); PG8_STAGE(PG8_SB(1, 1), cB + hstep + kstep, voffB);
        PG8_WAIT_V(6); PG8_BAR;
    } else {
        PG8_STAGE(PG8_SB(0, 0), cB, voffB); PG8_STAGE(PG8_SA(0, 0), cA, voffA); PG8_STAGE(PG8_SB(0, 1), cB + hstep, voffB); PG8_STAGE(PG8_SA(0, 1), cA + hstep, voffA);
        if (wr == 1) PG8_BAR;
        PG8_WAIT_V(4); PG8_BAR;
        PG8_STAGE(PG8_SB(1, 0), cB + kstep, voffB); PG8_STAGE(PG8_SA(1, 0), cA + kstep, voffA); PG8_STAGE(PG8_SB(1, 1), cB + hstep + kstep, voffB);
        PG8_WAIT_V(6); PG8_BAR;
    }
    for (;;) {
        const bool has_next = S.next(ui + 1, nxt);
        const char* nA = has_next ? (const char*)g.A + (size_t)nxt.pm * tstep + (size_t)nxt.kofs * 2 : cA; const char* nB = has_next ? (const char*)g.Bt + (size_t)nxt.pn * tstep + (size_t)nxt.kofs * 2 : cB;
        for (int t = 0; t < nt; t += 2) {
            const bool last = (t == nt - 2);
            const char* a1 = cA + (size_t)(t + 1) * kstep;
            const char* a2 = last ? nA : cA + (size_t)(t + 2) * kstep; const char* b2 = last ? nB : cB + (size_t)(t + 2) * kstep;
            const char* a3 = a2 + kstep; const char* b3 = b2 + kstep;
            if (last && has_next) S.a_ready(nxt);
            if constexpr (SP2) {
            PG8_LDB(B0, 0, 0); PG8_LDB(B1, 0, 1); PG8_SCHED; PG8_LDA(At, 0, 0); PG8_STAGE(PG8_SA(1, 1), a1 + hstep, voffA);
            PG8_WAIT_V(8); PG8_WAIT_L(0); PG8_BAR; PG8_MMA(0, 0, At, B0); PG8_MMA(0, 1, At, B1); PG8_BAR; PG8_SCHED;
            PG8_LDA(At, 0, 1); PG8_STAGE(PG8_SB(0, 0), b2, voffB); PG8_STAGE(PG8_SB(0, 1), b2 + hstep, voffB); PG8_STAGE(PG8_SA(0, 0), a2, voffA);
            PG8_WAIT_V(8); PG8_WAIT_L(0); PG8_BAR; PG8_MMA(1, 0, At, B0); PG8_MMA(1, 1, At, B1); PG8_BAR; PG8_SCHED;
            PG8_LDB(B0, 1, 0); PG8_LDB(B1, 1, 1); PG8_SCHED; PG8_LDA(At, 1, 0); PG8_STAGE(PG8_SA(0, 1), a2 + hstep, voffA);
            PG8_WAIT_V(8); PG8_WAIT_L(0); PG8_BAR; PG8_MMA(0, 0, At, B0); PG8_MMA(0, 1, At, B1); PG8_BAR; PG8_SCHED;
            PG8_LDA(At, 1, 1); PG8_STAGE(PG8_SB(1, 0), b3, voffB); PG8_STAGE(PG8_SB(1, 1), b3 + hstep, voffB); PG8_STAGE(PG8_SA(1, 0), a3, voffA);
            PG8_WAIT_V(8); PG8_WAIT_L(0); PG8_BAR; PG8_MMA(1, 0, At, B0); PG8_MMA(1, 1, At, B1); PG8_BAR; PG8_SCHED;
            } else {
            PG8_LDB(B0, 0, 0); PG8_SCHED; PG8_LDA(At, 0, 0); PG8_STAGE(PG8_SA(1, 1), a1 + hstep, voffA);
            PG8_WAIT_L(8); PG8_BAR; PG8_WAIT_L(0); PG8_MMA(0, 0, At, B0); PG8_BAR; PG8_SCHED;
            PG8_LDB(B1, 0, 1); PG8_STAGE(PG8_SB(0, 0), b2, voffB);
            PG8_BAR; PG8_WAIT_L(0); PG8_MMA(0, 1, At, B1); PG8_BAR;
            PG8_LDA(At, 0, 1); PG8_STAGE(PG8_SA(0, 0), a2, voffA);
            PG8_BAR; PG8_WAIT_L(0); PG8_MMA(1, 0, At, B0); PG8_BAR; PG8_SCHED;
            PG8_STAGE(PG8_SB(0, 1), b2 + hstep, voffB);
            PG8_WAIT_V(6); PG8_BAR; PG8_MMA(1, 1, At, B1); PG8_BAR;
            PG8_LDB(B0, 1, 0); PG8_SCHED; PG8_LDA(At, 1, 0); PG8_STAGE(PG8_SA(0, 1), a2 + hstep, voffA);
            PG8_WAIT_L(8); PG8_BAR; PG8_WAIT_L(0); PG8_MMA(0, 0, At, B0); PG8_BAR; PG8_SCHED;
            PG8_LDB(B1, 1, 1); PG8_STAGE(PG8_SB(1, 0), b3, voffB);
            PG8_BAR; PG8_WAIT_L(0); PG8_MMA(0, 1, At, B1); PG8_BAR;
            PG8_LDA(At, 1, 1); PG8_STAGE(PG8_SA(1, 0), a3, voffA);
            PG8_BAR; PG8_WAIT_L(0); PG8_MMA(1, 0, At, B0); PG8_BAR; PG8_SCHED;
            PG8_STAGE(PG8_SB(1, 1), b3 + hstep, voffB);
            PG8_WAIT_V(6); PG8_BAR; PG8_MMA(1, 1, At, B1); PG8_BAR;
            }
        }
        if constexpr (ALIGN_EPI) { if (wr == 0) PG8_BAR; }
        if constexpr (!Epi::AFTER_DRAIN) { E(acc, cur, wr, wc, fr, fq); S.done(cur); }
        if (!has_next) break;
#pragma unroll
        for (int a = 0; a < 2; ++a)
#pragma unroll
            for (int b = 0; b < 2; ++b)
#pragma unroll
                for (int m = 0; m < 4; ++m)
#pragma unroll
                    for (int n = 0; n < 2; ++n) acc[a][b][m][n] = (f32x4){0.f, 0.f, 0.f, 0.f};
        cur = nxt; cA = nA; cB = nB; ++ui;
        if constexpr (ALIGN_EPI) { if (wr == 1) PG8_BAR; }
    }
    PG8_WAIT_V(0);
    if constexpr (!ALIGN_EPI) { if (wr == 0) PG8_BAR; }
    PG8_BAR;
    if constexpr (Epi::AFTER_DRAIN) { E.fused(acc, cur, wr, wc, fr, fq, lds, wid, lane); S.done(cur); }
#undef PG8_SA
#undef PG8_SB
#undef PG8_STAGE
#undef PG8_LDA
#undef PG8_LDB
#undef PG8_MMA
#undef PG8_WAIT_V
#undef PG8_WAIT_L
#undef PG8_BAR
#undef PG8_SCHED
}
}

#ifndef PG8_SP2
#define PG8_SP2 true
#endif
#ifndef PG8_ALIGN
#define PG8_ALIGN true
#endif

#ifndef SCAN_SPLIT
#define SCAN_SPLIT 4
#endif
#ifndef SCAN_FIRST
#define SCAN_FIRST(w) ((w) >= SCAN_SPLIT)
#endif
#ifndef SCAN_PRIO_POST
#define SCAN_PRIO_POST 1
#endif
#ifndef SCAN_PRIO
#define SCAN_PRIO 1
#endif
constexpr int NWAVES = 8, NTHR = 512;
constexpr int D = 2048, MP = 8192, MS = 512, M = MP + MS, FF = 5632, F2 = 11264;
constexpr int SEQ = 2048, NB = 4, DB = 128, DSQ = 4;
constexpr float EPS = 1e-6f, GATE_CAP = 15.0f;
constexpr size_t O_YP = 0, O_YS = 16777216, O_SP = 17825792, O_SS = 19922944, O_CP = 87031808, O_CS = 88080384, O_NP = 121634816, O_NS = 121638912,
                 O_MP = 121769984, O_MS = 121770016, O_VS = 121771040, O_CVP = 122819616, O_CVS = 123180064, O_END = 134714400;
constexpr size_t MiB = 1u << 20;
constexpr size_t WS_CTL = 0, CTL_ZERO_BYTES = 1 * MiB;
constexpr size_t WS_W = 1 * MiB;
constexpr size_t WS_X = 401 * MiB;
constexpr size_t WS_HB = 469 * MiB;
constexpr size_t WS_PROJ = 503 * MiB;
constexpr size_t WS_OB = 775 * MiB;
constexpr size_t WS_ACT = 809 * MiB;
constexpr size_t WS_SCR = 903 * MiB;
constexpr size_t WS_GATES = 971 * MiB;
constexpr size_t WS_PART = 972 * MiB;
constexpr size_t WS_DENM = 1016 * MiB;
constexpr size_t WS_SSQ = 1017 * MiB;
constexpr size_t WS_OSSQ = 1018 * MiB + 256 * 1024;
constexpr size_t WS_WIN1 = 1019 * MiB;
constexpr size_t WS_END = 1045 * MiB;
constexpr size_t WE_IN0 = 0, WE_OUT0 = 16777216, WE_IN1 = 20971520, WE_OUT1 = 33554432, WE_IN2 = 37748736, WE_OUT2 = 46137344, WE_IN3 = 50331648, WE_OUT3 = 67108864,
                 WE_UP = 71303168, WE_UP_STRIDE = 23068672, WE_DOWN = 163577856, WE_DOWN_STRIDE = 11534336;
constexpr int CW_BAR = 4096, CW_CNT = 200000;
constexpr int RING_BYTES = 131072, LDSCTL_OFF = 146432, MISC_OFF = LDSCTL_OFF + 320, LDS_BYTES = 147456;

#define GAS __attribute__((address_space(1)))
#define LAS __attribute__((address_space(3)))
typedef unsigned short bf16;
typedef unsigned v4u __attribute__((ext_vector_type(4)));
typedef unsigned v2u __attribute__((ext_vector_type(2)));
typedef float f32x4 __attribute__((ext_vector_type(4)));
typedef GAS unsigned gu32;
#define LDS_WAIT() asm volatile("s_waitcnt lgkmcnt(0)" ::: "memory")
#define VM_WAIT() asm volatile("s_waitcnt vmcnt(0)" ::: "memory")
__device__ __forceinline__ unsigned f2bf(float f) { unsigned u = __builtin_bit_cast(unsigned, f); return (u + 0x7fffu + ((u >> 16) & 1u)) >> 16; }
typedef float f32x2_t __attribute__((ext_vector_type(2)));
typedef __bf16 bf16x2_t __attribute__((ext_vector_type(2)));
__device__ __forceinline__ unsigned pk2(float lo, float hi) { f32x2_t v; v.x = lo; v.y = hi; return __builtin_bit_cast(unsigned, __builtin_convertvector(v, bf16x2_t)); }
__device__ __forceinline__ float bf2f(unsigned short b) { return __builtin_bit_cast(float, ((unsigned)b) << 16); }
__device__ __forceinline__ float sigm(float x) { return __builtin_amdgcn_rcpf(1.0f + __expf(-x)); }

#define XB_TMO      128
#define XB_XCNT(j)  (256  + 64 * (j))
#define XB_XSUB(j)  (1280 + 64 * (j))
#define XB_XGEN(j)  (2304 + 64 * (j))
#define XB_TOP      3328
#define XB_TOPGEN   3392
#define XCD_BAR_WORDS 3456
#define XB_SPIN_CAP (1u << 18)
__device__ __forceinline__ unsigned xb_ld(unsigned* p)              { return __hip_atomic_load(p, __ATOMIC_RELAXED, __HIP_MEMORY_SCOPE_AGENT); }
__device__ __forceinline__ unsigned xb_add(unsigned* p, unsigned v) { return __hip_atomic_fetch_add(p, v, __ATOMIC_RELAXED, __HIP_MEMORY_SCOPE_AGENT); }
__device__ __forceinline__ unsigned xb_xcc_id() { return (unsigned)__builtin_amdgcn_s_getreg((3 << 11) | 20) & 0xFu; }
#define XB_SPIN(cond, bar) do { unsigned _sp = 0; while (cond) { __builtin_amdgcn_s_sleep(1); \
    if ((++_sp & 255u) == 0u) { if (xb_ld(&(bar)[XB_TMO])) break; if (_sp > XB_SPIN_CAP) { atomicAdd(&(bar)[XB_TMO], 1u); break; } } } } while (0)
struct XcdBarrier { unsigned* bar; unsigned x; volatile LAS unsigned* st; };
__device__ __forceinline__ XcdBarrier xcd_barrier_post(unsigned* bar, volatile LAS unsigned* st) {
    XcdBarrier b; b.bar = bar; b.x = xb_xcc_id(); b.st = st;
    if (threadIdx.x == 0) (void)xb_add(&bar[XB_XCNT(b.x)], 1u);
    return b;
}
__device__ __forceinline__ void xcd_barrier_complete(unsigned* bar, unsigned x, unsigned& nloc, unsigned& nx) {
    const unsigned G = gridDim.x * gridDim.y * gridDim.z;
    unsigned sum, cnt, mine, sp = 0u;
    for (;;) {
        sum = 0u; cnt = 0u; mine = 0u;
#pragma unroll
        for (unsigned j = 0; j < 16; ++j) { const unsigned c = xb_ld(&bar[XB_XCNT(j)]); sum += c; cnt += (c > 0u) ? 1u : 0u; mine = (j == x) ? c : mine; }
        if (sum == G) break;
        __builtin_amdgcn_s_sleep(1);
        if ((++sp & 255u) == 0u) { if (xb_ld(&bar[XB_TMO])) break; if (sp > XB_SPIN_CAP) { atomicAdd(&bar[XB_TMO], 1u); break; } }
    }
    nloc = mine > 0u ? mine : 1u; nx = cnt > 0u ? cnt : 1u;
}
__device__ __forceinline__ void xcd_barrier(const XcdBarrier& b) {
    asm volatile("s_waitcnt vmcnt(0)" ::: "memory");
    __syncthreads();
    if (threadIdx.x == 0) {
        unsigned* bar = b.bar;
        __builtin_amdgcn_s_waitcnt(0);
        unsigned nloc = b.st[0], nx = b.st[1];
        if (nloc == 0u) { xcd_barrier_complete(bar, b.x, nloc, nx); b.st[0] = nloc; b.st[1] = nx; }
        const unsigned old = xb_add(&bar[XB_XSUB(b.x)], 1u);
        const unsigned gen = old / nloc;
        if (old + 1u == (gen + 1u) * nloc) {
            __builtin_amdgcn_fence(__ATOMIC_RELEASE, "agent");
            asm volatile("s_waitcnt vmcnt(0)" ::: "memory");
            const unsigned og = xb_add(&bar[XB_TOP], 1u);
            const unsigned tg = og / nx;
            if (og + 1u == (tg + 1u) * nx) xb_add(&bar[XB_TOPGEN], 1u);
            else XB_SPIN(xb_ld(&bar[XB_TOPGEN]) == tg, bar);
            __builtin_amdgcn_fence(__ATOMIC_ACQUIRE, "agent");
            xb_add(&bar[XB_XGEN(b.x)], 1u);
            asm volatile("s_waitcnt vmcnt(0)" ::: "memory");
        } else {
            XB_SPIN(xb_ld(&bar[XB_XGEN(b.x)]) == gen, bar);
            __builtin_amdgcn_fence(__ATOMIC_ACQUIRE, "agent");
            asm volatile("s_waitcnt vmcnt(0)" ::: "memory");
        }
    }
    __syncthreads();
}

struct Frame {
    LAS unsigned char* lds;
    volatile LAS unsigned* MISC;
    int tid, lane, wave;
    int vcu, G;
    const float* const* in;
    float* out; unsigned char* ws;
};
__device__ __forceinline__ float wave_sum(float v) {
#pragma unroll
    for (int o = 1; o < 64; o <<= 1) v += __shfl_xor(v, o);
    return v;
}
__device__ __forceinline__ float row16_sum(float v) {
    v += __builtin_bit_cast(float, __builtin_amdgcn_update_dpp(0, __builtin_bit_cast(int, v), 0xB1, 0xF, 0xF, true));
    v += __builtin_bit_cast(float, __builtin_amdgcn_update_dpp(0, __builtin_bit_cast(int, v), 0x4E, 0xF, 0xF, true));
    v += __builtin_bit_cast(float, __builtin_amdgcn_update_dpp(0, __builtin_bit_cast(int, v), 0x141, 0xF, 0xF, true));
    v += __builtin_bit_cast(float, __builtin_amdgcn_update_dpp(0, __builtin_bit_cast(int, v), 0x140, 0xF, 0xF, true));
    return v;
}
struct MatDesc { const float* W; const float* gain; bf16* WT; int K, N, row_off; float scale; int item_end, perm; };
constexpr int N_MAT = 25, DESC_OFF = 135168;
__device__ __forceinline__ void p0_transpose_item(const float* W, const float* gain, float scale, int K, int N, bf16* WT, int row_off, int perm, LAS float* scr, int item, int lane) {
    const int nblk = N / 64, kb = item / nblk, nb = item % nblk, k0 = 64 * kb, n0 = 64 * nb;
    const int d0 = !perm ? n0 : (n0 < FF ? (n0 >> 7) * 256 + (n0 & 127) : ((n0 - FF) >> 7) * 256 + 128 + ((n0 - FF) & 127));
    const int lr = lane >> 4, lc = (lane & 15) * 4;
    f32x4 w[16];
#pragma unroll
    for (int i = 0; i < 16; ++i) w[i] = __builtin_nontemporal_load((const GAS f32x4*)(W + (size_t)(k0 + 4 * i + lr) * N + n0 + lc));
#pragma unroll
    for (int i = 0; i < 16; ++i) { const int kk = 4 * i + lr; const float g = gain ? gain[k0 + kk] * scale : scale;
        LAS float* d = scr + kk * 65 + lc; d[0] = w[i].x * g; d[1] = w[i].y * g; d[2] = w[i].z * g; d[3] = w[i].w * g; }
    LDS_WAIT(); asm volatile("" ::: "memory");
    const int c = lane >> 3, nl = lane & 7;
#pragma unroll
    for (int j = 0; j < 8; ++j) { const int n = nl + 8 * j; const LAS float* s = scr + (8 * c) * 65 + n;
        v4u o; o.x = pk2(s[0 * 65], s[1 * 65]); o.y = pk2(s[2 * 65], s[3 * 65]); o.z = pk2(s[4 * 65], s[5 * 65]); o.w = pk2(s[6 * 65], s[7 * 65]);
        *(GAS v4u*)(WT + (size_t)(row_off + d0 + n) * K + k0 + 8 * c) = o; }
    LDS_WAIT(); asm volatile("" ::: "memory");
}
#define SET_DESC(idx, Wp, gp, WTp, Kv, Nv, ro, sc) SET_DESCP(idx, Wp, gp, WTp, Kv, Nv, ro, sc, 0)
#define SET_DESCP(idx, Wp, gp, WTp, Kv, Nv, ro, sc, pm_) do { LAS MatDesc* d_ = desc + (idx); d_->W = (Wp); d_->gain = (gp); d_->WT = (WTp); d_->K = (Kv); d_->N = (Nv); d_->row_off = (ro); d_->scale = (sc); \
    tot_ += ((Kv) / 64) * ((Nv) / 64); d_->item_end = tot_; d_->perm = (pm_); } while (0)

__device__ __forceinline__ void norm_rows(Frame& F, int mode, int nparts, const float* xp, const float* xs, const float* gain, const float* w_if, const float* b_if) {
    float* X = (float*)(F.ws + WS_X); bf16* HB = (bf16*)(F.ws + WS_HB); float* GATES = (float*)(F.ws + WS_GATES);
    const int gw = F.vcu * NWAVES + F.wave, NGW = F.G * NWAVES, lane = F.lane;
    for (int m = gw; m < M; m += NGW) {
        const float* src = (mode & 1) ? (m < MP ? xp + (size_t)m * D : xs + (size_t)(m - MP) * D) : X + (size_t)m * D;
        const GAS f32x4* xr = (const GAS f32x4*)src + lane;
        f32x4 v[8]; float ss = 0.f;
#pragma unroll
        for (int j = 0; j < 8; ++j) v[j] = xr[64 * j];
        __builtin_amdgcn_sched_barrier(0);
#pragma unroll
        for (int j = 0; j < 8; ++j) ss += (v[j].x * v[j].x + v[j].y * v[j].y) + (v[j].z * v[j].z + v[j].w * v[j].w);
        if ((mode & 8) && m >= MP) {
            const GAS f32x4* pr = (const GAS f32x4*)((const float*)(F.ws + WS_PART) + (size_t)(m - MP) * D) + lane;
            for (int p = 0; p < nparts; ++p) {
#pragma unroll
                for (int j = 0; j < 8; ++j) v[j] += pr[(size_t)p * (MS * D / 4) + 64 * j]; }
            ss = 0.f; GAS f32x4* xo = (GAS f32x4*)(X + (size_t)m * D) + lane;
#pragma unroll
            for (int j = 0; j < 8; ++j) { xo[64 * j] = v[j]; ss += (v[j].x * v[j].x + v[j].y * v[j].y) + (v[j].z * v[j].z + v[j].w * v[j].w); }
        }
        const float wave_sum_keep = wave_sum(ss);
        const float rstd = 1.0f / sqrtf(wave_sum_keep * (1.0f / D) + EPS);
        if ((mode & 1) && !(mode & 32)) { GAS f32x4* xo = (GAS f32x4*)(X + (size_t)m * D) + lane;
#pragma unroll
            for (int j = 0; j < 8; ++j) xo[64 * j] = v[j]; }
        if (mode & 2) { GAS f32x4* yo = (GAS f32x4*)(F.out + (size_t)m * D) + lane; const GAS f32x4* g4 = (const GAS f32x4*)gain + lane;
            f32x4 gq[8];
#pragma unroll
            for (int j = 0; j < 8; ++j) gq[j] = g4[64 * j];
#pragma unroll
            for (int j = 0; j < 8; ++j) yo[64 * j] = v[j] * rstd * gq[j]; }
        else { GAS v2u* ho = (GAS v2u*)(HB + (size_t)m * D) + lane; const float sc_ = (mode & 16) ? 1.0f : rstd;
#pragma unroll
            for (int j = 0; j < 8; ++j) { v2u w; w.x = pk2(v[j].x * sc_, v[j].y * sc_); w.y = pk2(v[j].z * sc_, v[j].w * sc_); ho[64 * j] = w; }
            if ((mode & 16) && lane < 32) ((float*)(F.ws + WS_SSQ))[(size_t)m * 32 + lane] = lane == 0 ? wave_sum_keep : 0.f; }
    }
}

__device__ __forceinline__ float hgrn_lb(int j, const float* lbp, int c) { return j == 0 ? 0.f : fmaxf(sigm(lbp[2048 + c] - lbp[c]), 0.f); }
constexpr int RTAB_OFF = 136448, RTAB_SLOTS = 6;
template <class Sched> __device__ __forceinline__ void fill_rstd_table16(Frame& F, const Sched& S) {
    const float* OSSQ = (const float*)(F.ws + WS_OSSQ); LAS float* tab = (LAS float*)(F.lds + RTAB_OFF);
    pg8::Unit u;
    for (int i = 0; i < RTAB_SLOTS && S.next(i, u); ++i) {
        const int r = F.tid >> 1, hf = F.tid & 1; const float* p = OSSQ + ((size_t)u.pm * 256 + r) * 16 + hf * 8;
        const f32x4 a = *(const GAS f32x4*)p, b = *(const GAS f32x4*)(p + 4);
        float s = ((a.x + a.y) + (a.z + a.w)) + ((b.x + b.y) + (b.z + b.w));
        s += __shfl_xor(s, 1);
        if (hf == 0) tab[i * 256 + r] = 1.0f / sqrtf(s * (1.0f / D) + EPS);
    }
    __syncthreads();
}
template <class Sched> __device__ __forceinline__ void fill_rstd_table(Frame& F, const Sched& S) {
    const float* SSQ = (const float*)(F.ws + WS_SSQ); LAS float* tab = (LAS float*)(F.lds + RTAB_OFF);
    const int r = F.tid >> 1, hf = F.tid & 1;
    f32x4 q[RTAB_SLOTS][4]; bool ok[RTAB_SLOTS];
#pragma unroll
    for (int i = 0; i < RTAB_SLOTS; ++i) { pg8::Unit u; ok[i] = S.next(i, u); const int pm = ok[i] ? u.pm : 0;
        const float* p = SSQ + ((size_t)pm * 256 + r) * 32 + hf * 16;
#pragma unroll
        for (int k = 0; k < 4; ++k) q[i][k] = *(const GAS f32x4*)(p + 4 * k); }
    __builtin_amdgcn_sched_barrier(0);
#pragma unroll
    for (int i = 0; i < RTAB_SLOTS; ++i) {
        const f32x4 a = q[i][0], b = q[i][1], c = q[i][2], d = q[i][3];
        float s = (((a.x + a.y) + (a.z + a.w)) + ((b.x + b.y) + (b.z + b.w))) + (((c.x + c.y) + (c.z + c.w)) + ((d.x + d.y) + (d.z + d.w)));
        s += __shfl_xor(s, 1);
        if (ok[i] && hf == 0) tab[i * 256 + r] = 1.0f / sqrtf(s * (1.0f / D) + EPS);
    }
    __syncthreads();
}
template <int NK> __device__ __forceinline__ void part_sum16(const float* PARTf, size_t eoff, size_t stride, f32x4 (&ps)[4]) {
    const bf16* pp = (const bf16*)PARTf + eoff; v4u a[NK], b[NK];
#pragma unroll
    for (int k = 0; k < NK; ++k) { a[k] = *(const GAS v4u*)(pp + (size_t)k * stride); b[k] = *(const GAS v4u*)(pp + (size_t)k * stride + 8); }
#pragma unroll
    for (int q = 0; q < 4; ++q) ps[q] = (f32x4){0.f, 0.f, 0.f, 0.f};
#pragma unroll
    for (int k = 0; k < NK; ++k) {
        ps[0] += (f32x4){__builtin_bit_cast(float, a[k].x << 16), __builtin_bit_cast(float, a[k].x & 0xffff0000u), __builtin_bit_cast(float, a[k].y << 16), __builtin_bit_cast(float, a[k].y & 0xffff0000u)};
        ps[1] += (f32x4){__builtin_bit_cast(float, a[k].z << 16), __builtin_bit_cast(float, a[k].z & 0xffff0000u), __builtin_bit_cast(float, a[k].w << 16), __builtin_bit_cast(float, a[k].w & 0xffff0000u)};
        ps[2] += (f32x4){__builtin_bit_cast(float, b[k].x << 16), __builtin_bit_cast(float, b[k].x & 0xffff0000u), __builtin_bit_cast(float, b[k].y << 16), __builtin_bit_cast(float, b[k].y & 0xffff0000u)};
        ps[3] += (f32x4){__builtin_bit_cast(float, b[k].z << 16), __builtin_bit_cast(float, b[k].z & 0xffff0000u), __builtin_bit_cast(float, b[k].w << 16), __builtin_bit_cast(float, b[k].w & 0xffff0000u)}; }
}
template <int NK> __device__ __forceinline__ void sample_reduce(Frame& F, const pg8::SplitOrder& S, unsigned* cnt, const float* res_s  , const float* oss  ) {
    constexpr int nK = NK;
    float* X = (float*)(F.ws + WS_X); bf16* XB = (bf16*)(F.ws + WS_HB); float* SSQ = (float*)(F.ws + WS_SSQ); const float* PART = (const float*)(F.ws + WS_PART);
    pg8::Unit u;
    if (!S.next(0, u)) return;
    asm volatile("s_waitcnt vmcnt(0)" ::: "memory"); __syncthreads();
    if (F.tid == 0) {
        __builtin_amdgcn_fence(__ATOMIC_RELEASE, "agent"); asm volatile("s_waitcnt vmcnt(0)" ::: "memory");
        for (int i = 0; S.next(i, u); ++i) (void)__hip_atomic_fetch_add(cnt + (u.pm * 8 + u.pn) * 64, 1u, __ATOMIC_RELAXED, __HIP_MEMORY_SCOPE_AGENT);
    }
    const int RS = (256 + nK - 1) / nK;
    for (int i = 0; S.next(i, u); ++i) {
        if (F.tid == 0) {
            unsigned* c = cnt + (u.pm * 8 + u.pn) * 64; unsigned sp = 0;
            while (__hip_atomic_load(c, __ATOMIC_RELAXED, __HIP_MEMORY_SCOPE_AGENT) < (unsigned)nK) { __builtin_amdgcn_s_sleep(1); if (++sp > (1u << 22)) break; }
            __builtin_amdgcn_fence(__ATOMIC_ACQUIRE, "agent"); asm volatile("s_waitcnt vmcnt(0)" ::: "memory");
        }
        __syncthreads();
        const int r0 = u.ks * RS, r1 = (r0 + RS) < 256 ? (r0 + RS) : 256;
        for (int rb = r0; rb < r1; rb += 32) {
            const int rl = rb + (F.tid >> 4); const int cc = (F.tid & 15) * 16;
            float s = 0.f;
            if (rl < r1) {
                const size_t srow = (size_t)u.pm * 256 + rl; const size_t off = srow * D + u.pn * 256 + cc;
                f32x4 x[4], ps[4]; float rsc = 1.0f;
                if (oss) { const float* op_ = oss + ((size_t)MP + srow) * 16; const f32x4 a_ = *(const GAS f32x4*)op_, b_ = *(const GAS f32x4*)(op_ + 4), c_ = *(const GAS f32x4*)(op_ + 8), d_ = *(const GAS f32x4*)(op_ + 12);
                    const float t_ = (((a_.x + a_.y) + (a_.z + a_.w)) + ((b_.x + b_.y) + (b_.z + b_.w))) + (((c_.x + c_.y) + (c_.z + c_.w)) + ((d_.x + d_.y) + (d_.z + d_.w))); rsc = 1.0f / sqrtf(t_ * (1.0f / D) + EPS); }
#pragma unroll
                for (int q = 0; q < 4; ++q) x[q] = *(const GAS f32x4*)(res_s + off + 4 * q);
                part_sum16<NK>(PART, off, (size_t)MS * D, ps);
#pragma unroll
                for (int q = 0; q < 4; ++q) x[q] += ps[q] * rsc;
#pragma unroll
                for (int q = 0; q < 4; ++q) { *(GAS f32x4*)(X + (size_t)MP * D + off + 4 * q) = x[q];
                    v2u w; w.x = pk2(x[q].x, x[q].y); w.y = pk2(x[q].z, x[q].w); *(GAS v2u*)(XB + (size_t)MP * D + off + 4 * q) = w;
                    s += (x[q].x * x[q].x + x[q].y * x[q].y) + (x[q].z * x[q].z + x[q].w * x[q].w); }
            }
            s = row16_sum(s);
            if (rl < r1 && (F.tid & 15) == 0) { float* sq = SSQ + ((size_t)MP + (size_t)u.pm * 256 + rl) * 32 + u.pn * 4; *(GAS f32x4*)sq = (f32x4){s, 0.f, 0.f, 0.f}; }
        }
    }
}
__device__ __forceinline__ void sample_reduce_rows(Frame& F, int nK) {
    float* X = (float*)(F.ws + WS_X); bf16* XB = (bf16*)(F.ws + WS_HB); float* SSQ = (float*)(F.ws + WS_SSQ); const float* PART = (const float*)(F.ws + WS_PART);
    const int gw = F.vcu * NWAVES + F.wave, NGW = F.G * NWAVES, lane = F.lane;
    for (int r = gw; r < MS; r += NGW) {
        f32x4 v[8]; float ss = 0.f;
#pragma unroll
        for (int j = 0; j < 8; ++j) v[j] = ((const GAS f32x4*)(X + (size_t)(MP + r) * D) + lane)[64 * j];
        for (int k = 0; k < nK; ++k) {
#pragma unroll
            for (int j = 0; j < 8; ++j) v[j] += ((const GAS f32x4*)(PART + (size_t)k * MS * D + (size_t)r * D) + lane)[64 * j]; }
#pragma unroll
        for (int j = 0; j < 8; ++j) { ((GAS f32x4*)(X + (size_t)(MP + r) * D) + lane)[64 * j] = v[j];
            v2u w; w.x = pk2(v[j].x, v[j].y); w.y = pk2(v[j].z, v[j].w); ((GAS v2u*)(XB + (size_t)(MP + r) * D) + lane)[64 * j] = w;
            ss += (v[j].x * v[j].x + v[j].y * v[j].y) + (v[j].z * v[j].z + v[j].w * v[j].w); }
        ss = wave_sum(ss);
        if (lane < 32) SSQ[(size_t)(MP + r) * 32 + lane] = lane == 0 ? ss : 0.f;
    }
}
template <int NK> __device__ __forceinline__ void sample_reduce_proj(Frame& F, const pg8::SplitOrder& S, unsigned* cnt, int Ncols, const float* bias) {
    constexpr int nK = NK;
    float* PROJ = (float*)(F.ws + WS_PROJ); const float* SSQ = (const float*)(F.ws + WS_SSQ); const float* PART = (const float*)(F.ws + WS_SCR);
    pg8::Unit u;
    if (!S.next(0, u)) return;
    asm volatile("s_waitcnt vmcnt(0)" ::: "memory"); __syncthreads();
    if (F.tid == 0) {
        __builtin_amdgcn_fence(__ATOMIC_RELEASE, "agent"); asm volatile("s_waitcnt vmcnt(0)" ::: "memory");
        for (int i = 0; S.next(i, u); ++i) (void)__hip_atomic_fetch_add(cnt + (u.pm * S.nN + u.pn) * 64, 1u, __ATOMIC_RELAXED, __HIP_MEMORY_SCOPE_AGENT);
    }
    const int RS = (256 + nK - 1) / nK;
    for (int i = 0; S.next(i, u); ++i) {
        if (F.tid == 0) {
            unsigned* c = cnt + (u.pm * S.nN + u.pn) * 64; unsigned sp = 0;
            while (__hip_atomic_load(c, __ATOMIC_RELAXED, __HIP_MEMORY_SCOPE_AGENT) < (unsigned)nK) { __builtin_amdgcn_s_sleep(1); if (++sp > (1u << 22)) break; }
            __builtin_amdgcn_fence(__ATOMIC_ACQUIRE, "agent"); asm volatile("s_waitcnt vmcnt(0)" ::: "memory");
        }
        __syncthreads();
        const int r0 = u.ks * RS, r1 = (r0 + RS) < 256 ? (r0 + RS) : 256;
        for (int rb = r0; rb < r1; rb += 32) {
            const int rl = rb + (F.tid >> 4); const int cc = (F.tid & 15) * 16;
            if (rl < r1) {
                const size_t srow = (size_t)u.pm * 256 + rl; const size_t col = (size_t)u.pn * 256 + cc;
                const float* sq = SSQ + ((size_t)MP + srow) * 32; float t_ = 0.f;
#pragma unroll
                for (int q = 0; q < 8; ++q) { const f32x4 a_ = *(const GAS f32x4*)(sq + 4 * q); t_ += (a_.x + a_.y) + (a_.z + a_.w); }
                const float rsc = 1.0f / sqrtf(t_ * (1.0f / D) + EPS);
                f32x4 ps[4], bq[4];
#pragma unroll
                for (int q = 0; q < 4; ++q) bq[q] = bias ? *(const GAS f32x4*)(bias + col + 4 * q) : (f32x4){0.f, 0.f, 0.f, 0.f};
                part_sum16<NK>(PART, (size_t)srow * Ncols + col, (size_t)MS * Ncols, ps);
#pragma unroll
                for (int q = 0; q < 4; ++q) { const f32x4 o = ps[q] * rsc + bq[q];
                    *(GAS f32x4*)(PROJ + ((size_t)MP + srow) * Ncols + col + 4 * q) = o; }
            }
        }
    }
}
typedef short bf16x8 __attribute__((ext_vector_type(8)));
typedef unsigned long long u64;
__device__ __forceinline__ bf16x8 mk_bf16x8(u64 lo, u64 hi) { typedef u64 u64x2 __attribute__((ext_vector_type(2))); u64x2 t; t.x = lo; t.y = hi; return __builtin_bit_cast(bf16x8, t); }
__device__ __forceinline__ bf16x8 pack8(const f32x4 a, const f32x4 b) { v4u w; w.x = pk2(a.x, a.y); w.y = pk2(a.z, a.w); w.z = pk2(b.x, b.y); w.w = pk2(b.z, b.w); return __builtin_bit_cast(bf16x8, w); }
#define MFMA16(a, b, c) __builtin_amdgcn_mfma_f32_16x16x32_bf16((a), (b), (c), 0, 0, 0)
__device__ __forceinline__ void hgrn_scan_mfma(Frame& F, int j, const float* lbp, const float* onorm, int item) {
    const float* proj = (const float*)(F.ws + WS_PROJ); bf16* OB = (bf16*)(F.ws + WS_OB); float* OSSQ = (float*)(F.ws + WS_OSSQ);
    LAS unsigned char* L = F.lds;
    const int tid = F.tid, lane = F.lane, w = F.wave;
    constexpr int CH = 32, NCH = SEQ / CH, QT = 0, KT = 8704, KH = 17408, VT = 27648, GG = 37888, PBUF = 38400, TOT = 76800;
    const int b = item >> 4, h = item & 15;
    const size_t row0 = (size_t)b * SEQ;
    const unsigned upk = (unsigned)(((w & 1) << 6) | lane);
    const int tq = w >> 1, pk = ((w & 1) << 6) | lane;
    const int lr = lane & 15, g = lane >> 4;
    const float lb = hgrn_lb(j, lbp, h * 128 + pk), omlb = 1.f - lb;
    const float on_ = onorm[h * 128 + 16 * w + lr];
    float gpre[8];
    constexpr int OSSL = 80896;
    float kv[8], qv[8], lc[8], vv[8], rf[8], rq[8], rv[8];
    f32x4 S[8];
#pragma unroll
    for (int i = 0; i < 8; ++i) S[i] = (f32x4){0.f, 0.f, 0.f, 0.f};
#define HG2_LOAD(c) do { _Pragma("unroll") for (int i = 0; i < 8; ++i) { const float* p_ = proj + (row0 + (c) * CH + 8 * tq + i) * 8192 + h * 128; rq[i] = p_[upk]; rf[i] = p_[2048u + upk]; rv[i] = p_[4096u + upk]; } } while (0)
#define HG2_P1(c) do { float run_ = 0.f; _Pragma("unroll") for (int i = 0; i < 8; ++i) { const float e_ = __expf(fminf(-rf[i], 80.f)), r_ = __builtin_amdgcn_rcpf(1.0f + e_); \
            kv[i] = omlb * e_ * r_; run_ += __builtin_amdgcn_logf(lb + omlb * r_); lc[i] = run_;     qv[i] = rq[i] * __builtin_amdgcn_rcpf(1.0f + __expf(fminf(-rq[i], 80.f))); vv[i] = rv[i]; } \
            *(LAS float*)(L + TOT + (((c) & 1) * 512 + tq * 128 + pk) * 4) = run_; } while (0)
#define HG2_P2(c) do { LAS unsigned char* P_ = L + ((c) & 1) * PBUF; const LAS float* T_ = (const LAS float*)(L + TOT + ((c) & 1) * 2048); \
            const float t0_ = T_[pk], t1_ = T_[128 + pk], t2_ = T_[256 + pk], t3_ = T_[384 + pk]; \
            const float off_ = tq == 0 ? 0.f : tq == 1 ? t0_ : tq == 2 ? t0_ + t1_ : t0_ + t1_ + t2_, bL_ = (t0_ + t1_) + (t2_ + t3_), gL_ = __builtin_amdgcn_exp2f(bL_); \
            float kh_[8]; _Pragma("unroll") for (int i = 0; i < 8; ++i) { const float b_ = off_ + lc[i]; \
                { const float x_ = qv[i] * __builtin_amdgcn_exp2f(b_); *(LAS unsigned short*)(P_ + QT + (8 * tq + i) * 272 + pk * 2) = (unsigned short)pk2(x_, x_); } \
                { const float x_ = kv[i] * __builtin_amdgcn_exp2f(fminf(-b_, 115.4f)); *(LAS unsigned short*)(P_ + KT + (8 * tq + i) * 272 + pk * 2) = (unsigned short)pk2(x_, x_); kh_[i] = x_ * gL_; } } \
            { v4u o_; o_.x = pk2(kh_[0], kh_[1]); o_.y = pk2(kh_[2], kh_[3]); o_.z = pk2(kh_[4], kh_[5]); o_.w = pk2(kh_[6], kh_[7]); *(LAS v4u*)(P_ + KH + pk * 80 + tq * 16) = o_; } \
            { v4u o_; o_.x = pk2(vv[0], vv[1]); o_.y = pk2(vv[2], vv[3]); o_.z = pk2(vv[4], vv[5]); o_.w = pk2(vv[6], vv[7]); *(LAS v4u*)(P_ + VT + pk * 80 + tq * 16) = o_; } \
            if (tq == 0) *(LAS float*)(P_ + GG + pk * 4) = gL_; } while (0)
#define HG2_M(n) do         { \
            const LAS unsigned char* P = L + (n & 1) * PBUF; \
            f32x4 at00 = (f32x4){0.f, 0.f, 0.f, 0.f}, at01 = at00, at11 = at00, o0 = at00, o1 = at00; \
_Pragma("unroll") \
            for (int kk = 0; kk < 4; ++kk) { \
                const bf16x8 a0 = *(const LAS bf16x8*)(P + KT + lr * 272 + kk * 64 + g * 16), a1 = *(const LAS bf16x8*)(P + KT + (16 + lr) * 272 + kk * 64 + g * 16); \
                const bf16x8 b0 = *(const LAS bf16x8*)(P + QT + lr * 272 + kk * 64 + g * 16), b1 = *(const LAS bf16x8*)(P + QT + (16 + lr) * 272 + kk * 64 + g * 16); \
                at00 = MFMA16(a0, b0, at00); at01 = MFMA16(a0, b1, at01); at11 = MFMA16(a1, b1, at11); \
                const bf16x8 sb = pack8(S[2 * kk], S[2 * kk + 1]); \
                const bf16x8 qa0 = mk_bf16x8(*(const LAS u64*)(P + QT + lr * 272 + kk * 64 + g * 8), *(const LAS u64*)(P + QT + lr * 272 + kk * 64 + 32 + g * 8)); \
                const bf16x8 qa1 = mk_bf16x8(*(const LAS u64*)(P + QT + (16 + lr) * 272 + kk * 64 + g * 8), *(const LAS u64*)(P + QT + (16 + lr) * 272 + kk * 64 + 32 + g * 8)); \
                o0 = MFMA16(qa0, sb, o0); o1 = MFMA16(qa1, sb, o1); \
            } \
_Pragma("unroll") \
            for (int r = 0; r < 4; ++r) { const bool keep = (4 * g + r) <= lr; at00[r] = keep ? at00[r] : 0.f; at11[r] = keep ? at11[r] : 0.f; } \
            const f32x4 zero4 = (f32x4){0.f, 0.f, 0.f, 0.f}; \
            const bf16x8 pa0 = pack8(at00, zero4), pa1 = pack8(at01, at11); \
            const int vcol = 16 * w + lr; \
            const bf16x8 vb = mk_bf16x8(*(const LAS u64*)(P + VT + vcol * 80 + g * 8), *(const LAS u64*)(P + VT + vcol * 80 + 32 + g * 8)); \
            o0 = MFMA16(pa0, vb, o0); o1 = MFMA16(pa1, vb, o1); \
            { const float* gp = proj + (row0 + n * CH + 4 * g) * 8192 + 6144 + h * 128 + vcol; bf16* ob = OB + (row0 + n * CH + 4 * g) * D + h * 128 + vcol; \
              LAS float* osl = (LAS float*)(L + OSSL) + (n & 1) * 256; \
_Pragma("unroll") \
              for (int r = 0; r < 4; ++r) { const float g0 = gpre[r], g1 = gpre[4 + r]; \
                const float y0 = o0[r] * on_ * __builtin_amdgcn_rcpf(1.0f + __expf(-g0)), y1 = o1[r] * on_ * __builtin_amdgcn_rcpf(1.0f + __expf(-g1)); \
                ob[(size_t)r * D] = (bf16)pk2(y0, y0); ob[(size_t)(16 + r) * D] = (bf16)pk2(y1, y1); \
                const float q0 = row16_sum(o0[r] * o0[r]), q1 = row16_sum(o1[r] * o1[r]); \
                if (lr == 0) { osl[(4 * g + r) * 8 + w] = q0; osl[(16 + 4 * g + r) * 8 + w] = q1; } } \
              if (n + 1 < NCH) { _Pragma("unroll") for (int r = 0; r < 4; ++r) { gpre[r] = gp[(size_t)(CH + r) * 8192]; gpre[4 + r] = gp[(size_t)(CH + 16 + r) * 8192]; } } } \
            const bf16x8 vn = *(const LAS bf16x8*)(P + VT + vcol * 80 + g * 16); \
_Pragma("unroll") \
            for (int kt = 0; kt < 8; ++kt) { \
                const f32x4 gk = *(const LAS f32x4*)(P + GG + (16 * kt + 4 * g) * 4); \
                const bf16x8 ka = *(const LAS bf16x8*)(P + KH + (16 * kt + lr) * 80 + g * 16); \
                S[kt] = MFMA16(ka, vn, S[kt] * gk); \
            } \
        } while (0)
    { const float* gp0 = proj + (row0 + 4 * g) * 8192 + 6144 + h * 128 + 16 * w + lr;
#pragma unroll
      for (int r = 0; r < 4; ++r) { gpre[r] = gp0[(size_t)r * 8192]; gpre[4 + r] = gp0[(size_t)(16 + r) * 8192]; } }
    __syncthreads();
    HG2_LOAD(0); HG2_P1(0); __syncthreads();
    HG2_P2(0); HG2_LOAD(1); HG2_P1(1); HG2_LOAD(2); __syncthreads();
    for (int n = 0; n < NCH; ++n) {
        if (SCAN_FIRST(w)) { __builtin_amdgcn_s_setprio(SCAN_PRIO); HG2_M(n); __builtin_amdgcn_s_setprio(0); }
        if (n >= 1 && tid < 32) { const LAS float* osl = (const LAS float*)(L + OSSL) + ((n - 1) & 1) * 256 + tid * 8; const f32x4 a_ = *(const LAS f32x4*)osl, b_ = *(const LAS f32x4*)(osl + 4);
            OSSQ[(row0 + (n - 1) * CH + tid) * 16 + h] = ((a_.x + a_.y) + (a_.z + a_.w)) + ((b_.x + b_.y) + (b_.z + b_.w)); }
        if (n + 1 < NCH) HG2_P2(n + 1);
        if (n + 2 < NCH) HG2_P1(n + 2);
        if (n + 3 < NCH) HG2_LOAD(n + 3);
        if (!SCAN_FIRST(w)) { __builtin_amdgcn_s_setprio(SCAN_PRIO); HG2_M(n); __builtin_amdgcn_s_setprio(0); }
        __syncthreads();
    }
#undef HG2_M
    if (tid < 32) { const LAS float* osl = (const LAS float*)(L + OSSL) + ((NCH - 1) & 1) * 256 + tid * 8; const f32x4 a_ = *(const LAS f32x4*)osl, b_ = *(const LAS f32x4*)(osl + 4);
        OSSQ[(row0 + (NCH - 1) * CH + tid) * 16 + h] = ((a_.x + a_.y) + (a_.z + a_.w)) + ((b_.x + b_.y) + (b_.z + b_.w)); }
    float* So = F.out + O_SP + ((size_t)(j * NB + b) * 16 + h) * 16384 + 16 * w + lr;
#pragma unroll
    for (int kt = 0; kt < 8; ++kt)
#pragma unroll
        for (int r = 0; r < 4; ++r) So[(size_t)(16 * kt + 4 * g + r) * 128] = S[kt][r];
#undef HG2_LOAD
#undef HG2_P1
#undef HG2_P2
}
__device__ __forceinline__ void hgrn_sample(Frame& F, int j, const float* lbp, const float* onorm, const float* S_in, int it0, int itstep) {
    const float* proj = (const float*)(F.ws + WS_PROJ); bf16* OB = (bf16*)(F.ws + WS_OB); float* OSSQ = (float*)(F.ws + WS_OSSQ);
    LAS float* L = (LAS float*)F.lds;
    const int tid = F.tid;
    {
        constexpr int SF = 0, SK = 512, SQ = 1024, SV = 1536, RED = 2048;
        const int v4 = tid & 31, kb = tid >> 5;
        for (int it = it0; it < DB * 16; it += itstep) {
            const int b = it >> 4, h = it & 15;
            __syncthreads();
            const float* S0 = S_in + ((size_t)(j * DB + b) * 16 + h) * 16384;
            f32x4 S[8];
#pragma unroll
            for (int i = 0; i < 8; ++i) S[i] = *(const GAS f32x4*)(S0 + (kb + 16 * i) * 128 + v4 * 4);
            { const int tok = tid >> 7, c = tid & 127; const size_t row = MP + b * DSQ + tok;
              const float fp = proj[row * 8192 + 2048 + h * 128 + c], qr = proj[row * 8192 + h * 128 + c], vr = proj[row * 8192 + 4096 + h * 128 + c];
              const float lb = hgrn_lb(j, lbp, h * 128 + c);
              L[SF + tid] = lb + (1.f - lb) * sigm(fp); L[SK + tid] = (1.f - lb) * sigm(-fp); L[SQ + tid] = qr * sigm(qr); L[SV + tid] = vr; }
            __syncthreads();
#pragma unroll
            for (int tok = 0; tok < DSQ; ++tok) {
                const f32x4 vv = *(const LAS f32x4*)(L + SV + tok * 128 + v4 * 4);
                f32x4 o = (f32x4){0.f, 0.f, 0.f, 0.f};
#pragma unroll
                for (int i = 0; i < 8; ++i) { const int k = kb + 16 * i; const float fk = L[SF + tok * 128 + k], kk = L[SK + tok * 128 + k], qq = L[SQ + tok * 128 + k];
                    S[i] = S[i] * fk + vv * kk; o += S[i] * qq; }
                *(LAS f32x4*)(L + RED + ((tok * 16 + kb) * 32 + v4) * 4) = o;
            }
            __syncthreads();
            { const int tok = tid >> 7, v = tid & 127; float s = 0.f;
#pragma unroll
              for (int k2 = 0; k2 < 16; ++k2) s += L[RED + (tok * 16 + k2) * 128 + v];
              const size_t row = MP + b * DSQ + tok; const float gg = proj[row * 8192 + 6144 + h * 128 + v];
              const float y = s * onorm[h * 128 + v] * __builtin_amdgcn_rcpf(1.0f + __expf(-gg)); OB[row * D + h * 128 + v] = (bf16)pk2(y, y);
              const float q = wave_sum(s * s); if (F.lane == 0) L[SF + F.wave] = q; }
            __syncthreads();
            if (tid < DSQ) OSSQ[(size_t)(MP + b * DSQ + tid) * 16 + h] = L[SF + 2 * tid] + L[SF + 2 * tid + 1];
            float* So = F.out + O_SS + ((size_t)(j * DB + b) * 16 + h) * 16384;
#pragma unroll
            for (int i = 0; i < 8; ++i) *(GAS f32x4*)(So + (kb + 16 * i) * 128 + v4 * 4) = S[i];
        }
    }
}
__device__ __forceinline__ void hgrn_scan(Frame& F, int j, const float* lbp, const float* onorm, const float* S_in, int part = 3) {
    const int bx = blockIdx.x, G = F.G;
    if (G > 64) { if (bx < 64) { if (part & 1) hgrn_scan_mfma(F, j, lbp, onorm, bx); } else if (part & 2) hgrn_sample(F, j, lbp, onorm, S_in, bx - 64, G - 64); }
    else { for (int it = bx; it < 64; it += G) hgrn_scan_mfma(F, j, lbp, onorm, it); hgrn_sample(F, j, lbp, onorm, S_in, bx, G); }
}
__device__ __forceinline__ void hgrn_post(Frame& F, const float* onorm) {
    const float* proj = (const float*)(F.ws + WS_PROJ); const float* scr = (const float*)(F.ws + WS_SCR); bf16* OB = (bf16*)(F.ws + WS_OB);
    const int gw = F.vcu * NWAVES + F.wave, NGW = F.G * NWAVES, lane = F.lane;
    for (int m = gw; m < M; m += NGW) {
        const GAS f32x4* xr = (const GAS f32x4*)(scr + (size_t)m * D) + lane; const GAS f32x4* gr = (const GAS f32x4*)(proj + (size_t)m * 8192 + 6144) + lane; const GAS f32x4* nr = (const GAS f32x4*)onorm + lane;
        f32x4 v[8]; float ss = 0.f;
#pragma unroll
        for (int j = 0; j < 8; ++j) { v[j] = xr[64 * j]; ss += (v[j].x * v[j].x + v[j].y * v[j].y) + (v[j].z * v[j].z + v[j].w * v[j].w); }
        const float rstd = 1.0f / sqrtf(wave_sum(ss) * (1.0f / D) + EPS);
        GAS v2u* ho = (GAS v2u*)(OB + (size_t)m * D) + lane;
#pragma unroll
        for (int j = 0; j < 8; ++j) { const f32x4 g = gr[64 * j], nn = nr[64 * j]; f32x4 o;
#pragma unroll
            for (int e = 0; e < 4; ++e) o[e] = v[j][e] * rstd * nn[e] * sigm(g[e]);
            v2u w; w.x = pk2(o.x, o.y); w.y = pk2(o.z, o.w); ho[64 * j] = w; }
    }
}
__device__ __forceinline__ void mlstm_scan_mfma(Frame& F, int item) {
    const float* proj = (const float*)(F.ws + WS_PROJ); float* scr = (float*)(F.ws + WS_SCR); const float* GATES = (const float*)(F.ws + WS_GATES); float* DENM = (float*)(F.ws + WS_DENM);
    LAS unsigned char* L = F.lds;
    const int tid = F.tid, lane = F.lane, w = F.wave;
    constexpr int CH = 32, NCH = SEQ / CH, PW = 6144, QT = 0, KT = 8704, KH = 17408, VT = 27648, PBUF = 37888, SCAL = 75776, SCSZ = 640;
    const int b = item >> 4, h = (item >> 1) & 7, vh = item & 1;
    const size_t row0 = (size_t)b * SEQ;
    const unsigned upk = (unsigned)(((w & 1) << 6) | lane);
    const int tq = w >> 1, pk = ((w & 1) << 6) | lane;
    const int lr = lane & 15, g = lane >> 4;
    const bool nwave = (vh == 0 && w == 7);
    float rk[8], rq[8], rv[8], rig = 0.f, rlf = 0.f, m_prev = 0.f;
    f32x4 C[8], N[8];
#pragma unroll
    for (int i = 0; i < 8; ++i) { C[i] = (f32x4){0.f, 0.f, 0.f, 0.f}; N[i] = (f32x4){0.f, 0.f, 0.f, 0.f}; }
    const bf16x8 ones = (lr == 0) ? (bf16x8){0x3F80, 0x3F80, 0x3F80, 0x3F80, 0x3F80, 0x3F80, 0x3F80, 0x3F80} : (bf16x8){0, 0, 0, 0, 0, 0, 0, 0};
#define ML2_LOAD(c) do { _Pragma("unroll") for (int i = 0; i < 8; ++i) { const float* p_ = proj + (row0 + (c) * CH + 8 * tq + i) * PW + h * 128; rq[i] = p_[upk]; rk[i] = p_[1024u + upk]; rv[i] = p_[(unsigned)(2048 + h * 128 + vh * 128) + upk]; } \
            } while (0)
#define ML2_GLOAD(c) do { if (w == 0 && lane < 32) { const size_t rg_ = row0 + (c) * CH + lane; rig = GATES[rg_ * 16 + h]; rlf = GATES[rg_ * 16 + 8 + h]; } } while (0)
#define ML2_P1(c) do { if (w == 0) { float bt_ = rlf; _Pragma("unroll") for (int d_ = 1; d_ < 32; d_ <<= 1) { const float t_ = __shfl_up(bt_, d_); if (lane >= d_) bt_ += t_; } \
                const float u_ = rig - bt_; float pm_ = u_; _Pragma("unroll") for (int d_ = 1; d_ < 32; d_ <<= 1) { const float t_ = __shfl_up(pm_, d_); if (lane >= d_) pm_ = fmaxf(pm_, t_); } \
                const float mt_ = fmaxf(bt_ + m_prev, bt_ + pm_); const float bL_ = __shfl(bt_, 31), mL_ = __shfl(mt_, 31); \
                LAS float* S_ = (LAS float*)(L + SCAL + ((c) & 3) * SCSZ); \
                if (lane < 32) { S_[lane] = u_; S_[32 + lane] = bt_ - mt_; S_[64 + lane] = __expf(bt_ + m_prev - mt_); S_[96 + lane] = __expf(u_ + bL_ - mL_); \
                    if (vh == 0) DENM[(row0 + (c) * CH + lane) * 16 + 8 + h] = mt_; } \
                if (lane == 0) S_[128] = __expf(bL_ + m_prev - mL_); \
                m_prev = mL_; } } while (0)
#define ML2_P2(c) do { LAS unsigned char* P_ = L + ((c) & 1) * PBUF; const LAS float* S_ = (const LAS float*)(L + SCAL + ((c) & 3) * SCSZ); \
            float kh_[8]; _Pragma("unroll") for (int i = 0; i < 8; ++i) { \
                *(LAS unsigned short*)(P_ + QT + (8 * tq + i) * 272 + pk * 2) = (unsigned short)pk2(rq[i], rq[i]); \
                *(LAS unsigned short*)(P_ + KT + (8 * tq + i) * 272 + pk * 2) = (unsigned short)pk2(rk[i], rk[i]); \
                kh_[i] = rk[i] * S_[96 + 8 * tq + i]; } \
            { v4u o_; o_.x = pk2(kh_[0], kh_[1]); o_.y = pk2(kh_[2], kh_[3]); o_.z = pk2(kh_[4], kh_[5]); o_.w = pk2(kh_[6], kh_[7]); *(LAS v4u*)(P_ + KH + pk * 80 + tq * 16) = o_; } \
            { v4u o_; o_.x = pk2(rv[0], rv[1]); o_.y = pk2(rv[2], rv[3]); o_.z = pk2(rv[4], rv[5]); o_.w = pk2(rv[6], rv[7]); *(LAS v4u*)(P_ + VT + pk * 80 + tq * 16) = o_; } } while (0)
#define ML2_TILE(St, vb_, vn_, o0_, o1_) do { \
            _Pragma("unroll") for (int kk = 0; kk < 4; ++kk) { const bf16x8 sb_ = pack8(St[2 * kk], St[2 * kk + 1]); \
                const bf16x8 qa0_ = mk_bf16x8(*(const LAS u64*)(P + QT + lr * 272 + kk * 64 + g * 8), *(const LAS u64*)(P + QT + lr * 272 + kk * 64 + 32 + g * 8)); \
                const bf16x8 qa1_ = mk_bf16x8(*(const LAS u64*)(P + QT + (16 + lr) * 272 + kk * 64 + g * 8), *(const LAS u64*)(P + QT + (16 + lr) * 272 + kk * 64 + 32 + g * 8)); \
                o0_ = MFMA16(qa0_, sb_, o0_); o1_ = MFMA16(qa1_, sb_, o1_); } \
            o0_ = o0_ * sc0; o1_ = o1_ * sc1; \
            o0_ = MFMA16(pa0, vb_, o0_); o1_ = MFMA16(pa1, vb_, o1_); __builtin_amdgcn_sched_barrier(0); \
            _Pragma("unroll") for (int kt = 0; kt < 8; ++kt) { const bf16x8 ka_ = *(const LAS bf16x8*)(P + KH + (16 * kt + lr) * 80 + g * 16); St[kt] = MFMA16(ka_, vn_, St[kt] * scst); } } while (0)
#define ML2_M(n) do { const LAS unsigned char* P = L + ((n) & 1) * PBUF; const LAS float* SC_ = (const LAS float*)(L + SCAL + ((n) & 3) * SCSZ); \
            f32x4 at00 = (f32x4){0.f, 0.f, 0.f, 0.f}, at01 = at00, at11 = at00; \
            _Pragma("unroll") for (int kk = 0; kk < 4; ++kk) { \
                const bf16x8 a0 = *(const LAS bf16x8*)(P + KT + lr * 272 + kk * 64 + g * 16), a1 = *(const LAS bf16x8*)(P + KT + (16 + lr) * 272 + kk * 64 + g * 16); \
                const bf16x8 b0 = *(const LAS bf16x8*)(P + QT + lr * 272 + kk * 64 + g * 16), b1 = *(const LAS bf16x8*)(P + QT + (16 + lr) * 272 + kk * 64 + g * 16); \
                at00 = MFMA16(a0, b0, at00); at01 = MFMA16(a0, b1, at01); at11 = MFMA16(a1, b1, at11); } \
            { const f32x4 u0 = *(const LAS f32x4*)(SC_ + 4 * g), u1 = *(const LAS f32x4*)(SC_ + 16 + 4 * g); const float w0 = SC_[32 + lr], w1 = SC_[48 + lr]; \
              _Pragma("unroll") for (int r = 0; r < 4; ++r) { const bool keep = (4 * g + r) <= lr; \
                at00[r] = keep ? at00[r] * __expf(u0[r] + w0) : 0.f; at01[r] = at01[r] * __expf(u0[r] + w1); at11[r] = keep ? at11[r] * __expf(u1[r] + w1) : 0.f; } } \
            const f32x4 zero4 = (f32x4){0.f, 0.f, 0.f, 0.f}; \
            const bf16x8 pa0 = pack8(at00, zero4), pa1 = pack8(at01, at11); __builtin_amdgcn_sched_barrier(0); \
            const f32x4 sc0 = *(const LAS f32x4*)(SC_ + 64 + 4 * g), sc1 = *(const LAS f32x4*)(SC_ + 80 + 4 * g); const float scst = SC_[128]; \
            const int vcol = 16 * w + lr; \
            { const bf16x8 vb = mk_bf16x8(*(const LAS u64*)(P + VT + vcol * 80 + g * 8), *(const LAS u64*)(P + VT + vcol * 80 + 32 + g * 8)); \
              const bf16x8 vn = *(const LAS bf16x8*)(P + VT + vcol * 80 + g * 16); \
              f32x4 o0 = zero4, o1 = zero4; \
              ML2_TILE(C, vb, vn, o0, o1); \
              float* op = scr + (row0 + (n) * CH + 4 * g) * D + h * 256 + vh * 128 + vcol; \
              _Pragma("unroll") for (int r = 0; r < 4; ++r) { op[(size_t)r * D] = o0[r]; op[(size_t)(16 + r) * D] = o1[r]; } } \
            __builtin_amdgcn_sched_barrier(0); \
            if (nwave) { f32x4 o0 = zero4, o1 = zero4; \
              ML2_TILE(N, ones, ones, o0, o1); \
              if (lr == 0) { float* dp = DENM + (row0 + (n) * CH + 4 * g) * 16 + h; \
                _Pragma("unroll") for (int r = 0; r < 4; ++r) { dp[(size_t)r * 16] = o0[r]; dp[(size_t)(16 + r) * 16] = o1[r]; } } } } while (0)
    __syncthreads();
    ML2_GLOAD(0); ML2_P1(0); ML2_GLOAD(1); ML2_LOAD(0); __syncthreads();
    ML2_P2(0); ML2_LOAD(1); ML2_P1(1); ML2_GLOAD(2); __syncthreads();
    for (int n = 0; n < NCH; ++n) {
        if (SCAN_FIRST(w)) { __builtin_amdgcn_s_setprio(SCAN_PRIO); ML2_M(n); __builtin_amdgcn_s_setprio(0); }
        if (n + 1 < NCH) { ML2_P2(n + 1); }
        if (n + 2 < NCH) { ML2_LOAD(n + 2); ML2_P1(n + 2); }
        if (n + 3 < NCH) { ML2_GLOAD(n + 3); }
        if (!SCAN_FIRST(w)) { __builtin_amdgcn_s_setprio(SCAN_PRIO); ML2_M(n); __builtin_amdgcn_s_setprio(0); }
        __syncthreads();
    }
#undef ML2_GLOAD
    float* Co = F.out + O_CP + ((size_t)(b * 8 + h) * 128) * 256 + vh * 128 + 16 * w + lr;
#pragma unroll
    for (int kt = 0; kt < 8; ++kt)
#pragma unroll
        for (int r = 0; r < 4; ++r) Co[(size_t)(16 * kt + 4 * g + r) * 256] = C[kt][r];
    if (nwave && lr == 0) {
#pragma unroll
        for (int kt = 0; kt < 8; ++kt)
#pragma unroll
            for (int r = 0; r < 4; ++r) F.out[O_NP + (size_t)(b * 8 + h) * 128 + 16 * kt + 4 * g + r] = N[kt][r]; }
    if (vh == 0 && w == 0 && lane == 0) F.out[O_MP + b * 8 + h] = m_prev;
#undef ML2_LOAD
#undef ML2_P1
#undef ML2_P2
#undef ML2_TILE
#undef ML2_M
}
__device__ __forceinline__ void mlstm_sample(Frame& F, const float* C_in, const float* n_in, const float* m_in, int it0, int itstep) {
    const float* proj = (const float*)(F.ws + WS_PROJ); float* scr = (float*)(F.ws + WS_SCR); const float* GATES = (const float*)(F.ws + WS_GATES); float* DENM = (float*)(F.ws + WS_DENM);
    LAS float* L = (LAS float*)F.lds;
    const int tid = F.tid, lane = F.lane, wave = F.wave;
    constexpr int PW = 6144;
    {
        constexpr int SK = 0, SQ = 512, SV = 1024, SG = 2048, DD = 2064, EM = 2072, RED = 2080;
        const int v4 = tid & 63, kb = tid >> 6;
        for (int it = it0; it < DB * 8; it += itstep) {
            const int b = it >> 3, h = it & 7;
            __syncthreads();
            const float* C0 = C_in + ((size_t)(b * 8 + h) * 128) * 256;
            f32x4 C[16];
#pragma unroll
            for (int i = 0; i < 16; ++i) C[i] = *(const GAS f32x4*)(C0 + (kb + 8 * i) * 256 + v4 * 4);
            float nn = (tid < 128) ? n_in[(size_t)(b * 8 + h) * 128 + tid] : 0.f;
            float m = m_in[b * 8 + h];
            { const int tok = tid >> 7, c = tid & 127; const size_t row = MP + b * DSQ + tok;
              L[SK + tid] = proj[row * PW + 1024 + h * 128 + c]; L[SQ + tid] = proj[row * PW + h * 128 + c];
#pragma unroll
              for (int r = 0; r < 2; ++r) { const int idx = tid + 512 * r, tk = idx >> 8, cc = idx & 255; L[SV + idx] = proj[(size_t)(MP + b * DSQ + tk) * PW + 2048 + h * 256 + cc]; }
              if (tid < 4) { L[SG + tid] = GATES[(size_t)(MP + b * DSQ + tid) * 16 + h]; L[SG + 4 + tid] = GATES[(size_t)(MP + b * DSQ + tid) * 16 + 8 + h]; } }
            __syncthreads();
#pragma unroll
            for (int tok = 0; tok < DSQ; ++tok) {
                const float ig = L[SG + tok], lf = L[SG + 4 + tok];
                const float mn = fmaxf(lf + m, ig), a = __expf(lf + m - mn), bb = __expf(ig - mn); m = mn;
                const f32x4 vv = *(const LAS f32x4*)(L + SV + tok * 256 + v4 * 4);
                f32x4 o = (f32x4){0.f, 0.f, 0.f, 0.f};
#pragma unroll
                for (int i = 0; i < 16; ++i) { const int k = kb + 8 * i; const float kk = bb * L[SK + tok * 128 + k], qq = L[SQ + tok * 128 + k];
                    C[i] = C[i] * a + vv * kk; o += C[i] * qq; }
                *(LAS f32x4*)(L + RED + ((tok * 8 + kb) * 64 + v4) * 4) = o;
                if (tid < 128) { nn = a * nn + bb * L[SK + tok * 128 + tid]; const float p = wave_sum(nn * L[SQ + tok * 128 + tid]); if (lane == 0) L[DD + tok * 2 + wave] = p; }
                if (tid == 0) L[EM + tok] = __expf(-m);
            }
            __syncthreads();
#pragma unroll
            for (int r = 0; r < 2; ++r) { const int idx = tid + 512 * r, tok = idx >> 8, v = idx & 255; float s = 0.f;
#pragma unroll
                for (int k2 = 0; k2 < 8; ++k2) s += L[RED + (tok * 8 + k2) * 256 + v];
                const float den = L[DD + tok * 2] + L[DD + tok * 2 + 1];
                scr[(size_t)(MP + b * DSQ + tok) * D + h * 256 + v] = s / fmaxf(fabsf(den), L[EM + tok]); }
            float* Co = F.out + O_CS + ((size_t)(b * 8 + h) * 128) * 256;
#pragma unroll
            for (int i = 0; i < 16; ++i) *(GAS f32x4*)(Co + (kb + 8 * i) * 256 + v4 * 4) = C[i];
            if (tid < 128) F.out[O_NS + (size_t)(b * 8 + h) * 128 + tid] = nn;
            if (tid == 0) F.out[O_MS + b * 8 + h] = m;
            if (tid < DSQ) { DENM[(size_t)(MP + b * DSQ + tid) * 16 + h] = 1.0f; DENM[(size_t)(MP + b * DSQ + tid) * 16 + 8 + h] = 0.0f; }
        }
    }
}
__device__ __forceinline__ void mlstm_scan(Frame& F, const float* C_in, const float* n_in, const float* m_in) {
    const int bx = blockIdx.x, G = F.G;
    if (G > 64) { if (bx < 64) mlstm_scan_mfma(F, bx); else mlstm_sample(F, C_in, n_in, m_in, bx - 64, G - 64); }
    else { for (int it = bx; it < 64; it += G) mlstm_scan_mfma(F, it); mlstm_sample(F, C_in, n_in, m_in, bx, G); }
}
__device__ __forceinline__ void mlstm_post(Frame& F, const float* hnorm) {
    const float* proj = (const float*)(F.ws + WS_PROJ); const float* scr = (const float*)(F.ws + WS_SCR); bf16* OB = (bf16*)(F.ws + WS_OB); const float* DENM = (const float*)(F.ws + WS_DENM);
    const int gw = F.vcu * NWAVES + F.wave, NGW = F.G * NWAVES, lane = F.lane;
    for (int m = gw; m < M; m += NGW) {
        const GAS f32x4* xr = (const GAS f32x4*)(scr + (size_t)m * D) + lane; const GAS f32x4* gr = (const GAS f32x4*)(proj + (size_t)m * 6144 + 4096) + lane; const GAS f32x4* nr = (const GAS f32x4*)hnorm + lane;
        GAS v2u* ho = (GAS v2u*)(OB + (size_t)m * D) + lane;
        const float dm = DENM[(size_t)m * 16 + (lane & 15)];
        f32x4 xv[8], gv[8], nv[8];
#pragma unroll
        for (int j = 0; j < 8; ++j) { xv[j] = xr[64 * j]; gv[j] = gr[64 * j]; nv[j] = nr[64 * j]; }
        float ss[8];
#pragma unroll
        for (int j = 0; j < 8; ++j) {
            const float den_ = __builtin_bit_cast(float, __builtin_amdgcn_readlane(__builtin_bit_cast(int, dm), j)), mt_ = __builtin_bit_cast(float, __builtin_amdgcn_readlane(__builtin_bit_cast(int, dm), 8 + j));
            const float dn = 1.0f / fmaxf(fabsf(den_), __expf(-mt_));
            xv[j] = xv[j] * dn; ss[j] = (xv[j].x * xv[j].x + xv[j].y * xv[j].y) + (xv[j].z * xv[j].z + xv[j].w * xv[j].w); }
#pragma unroll
        for (int o = 1; o < 64; o <<= 1) {
#pragma unroll
            for (int j = 0; j < 8; ++j) ss[j] += __shfl_xor(ss[j], o); }
#pragma unroll
        for (int j = 0; j < 8; ++j) {
            const float rstd = 1.0f / sqrtf(ss[j] * (1.0f / 256.0f) + EPS);
            const f32x4 v = xv[j], g = gv[j], nn = nv[j]; f32x4 o;
#pragma unroll
            for (int e = 0; e < 4; ++e) o[e] = v[e] * rstd * nn[e] * sigm(g[e]);
            v2u w; w.x = pk2(o.x, o.y); w.y = pk2(o.z, o.w); ho[64 * j] = w; }
    }
}

__device__ __forceinline__ float gelu_erf(float v) {
    const float av = fabsf(v), t = __builtin_amdgcn_rcpf(av * 0.2316418882f + 1.0f);
    float q = t * 0.5307027145f + (-0.7265760135f); q = q * t + 0.7107068705f; q = q * t + (-0.142248368f); q = q * t + 0.127414796f; q = q * t;
    const float m = v * (q * __builtin_amdgcn_exp2f((v * v) * (-0.72134752044f)));
    return v < 0.f ? m : v - m;
}
__device__ __forceinline__ void gmlp_a(Frame& F, const float* vg, const float* vb) {
    float* proj = (float*)(F.ws + WS_PROJ); float* scr = (float*)(F.ws + WS_SCR);
    const int gw = F.vcu * NWAVES + F.wave, NGW = F.G * NWAVES, lane = F.lane;
    for (int m = gw; m < M; m += NGW) {
        const GAS f32x4* zr = (const GAS f32x4*)(proj + (size_t)m * 4096 + 2048) + lane;
        f32x4 v[8]; float s = 0.f;
#pragma unroll
        for (int j = 0; j < 8; ++j) { const f32x4 z = zr[64 * j];
#pragma unroll
            for (int e = 0; e < 4; ++e) v[j][e] = gelu_erf(z[e]);
            s += (v[j].x + v[j].y) + (v[j].z + v[j].w); }
        const float mean = wave_sum(s) * (1.0f / D); float s2 = 0.f;
#pragma unroll
        for (int j = 0; j < 8; ++j) { v[j] = v[j] - mean; s2 += (v[j].x * v[j].x + v[j].y * v[j].y) + (v[j].z * v[j].z + v[j].w * v[j].w); }
        const float rstd = 1.0f / sqrtf(wave_sum(s2) * (1.0f / D) + EPS);
        GAS v2u* so = (GAS v2u*)((bf16*)scr + (size_t)m * D) + lane; const GAS f32x4* g4 = (const GAS f32x4*)vg + lane; const GAS f32x4* b4 = (const GAS f32x4*)vb + lane;
        f32x4 gq[8], bq[8];
#pragma unroll
        for (int j = 0; j < 8; ++j) { gq[j] = g4[64 * j]; bq[j] = b4[64 * j]; }
#pragma unroll
        for (int j = 0; j < 8; ++j) { const f32x4 o = v[j] * rstd * gq[j] + bq[j];
            if (m < MP) { v2u w_; w_.x = pk2(o.x, o.y); w_.y = pk2(o.z, o.w); so[64 * j] = w_; }
            else ((GAS f32x4*)(F.out + O_VS + (size_t)(m - MP) * D) + lane)[64 * j] = o; }
    }
}
__device__ __forceinline__ void gmlp_b(Frame& F, const float* w_s, const float* b_s) {
    const float* proj = (const float*)(F.ws + WS_PROJ); const float* scr = (const float*)(F.ws + WS_SCR); bf16* OB = (bf16*)(F.ws + WS_OB);
    LAS unsigned char* L = F.lds;
    const int tid = F.tid, lane = F.lane, w = F.wave, lr = lane & 15, g4 = lane >> 4;
    constexpr int WB_ = 0, VT_ = 34816, RS = 272;
    for (int it = F.vcu; it < NB * 16 * 16; it += F.G) {
        const int g = it & 15, n = (it >> 4) & 15, b = it >> 8;
        const size_t row0 = (size_t)b * SEQ + n * 128;
        __syncthreads();
        f32x4 wvv[8];
#pragma unroll
        for (int i = 0; i < 8; ++i) { const int idx = tid + 512 * i, tr = idx >> 5, s4 = idx & 31; wvv[i] = *(const GAS f32x4*)(w_s + (size_t)g * 16384 + tr * 128 + s4 * 4); }
#pragma unroll
        for (int i = 0; i < 8; ++i) { const int idx = tid + 512 * i, tr = idx >> 5, s4 = idx & 31;
            const f32x4 wv = wvv[i]; f32x4 m;
#pragma unroll
            for (int e = 0; e < 4; ++e) m[e] = (s4 * 4 + e <= tr) ? wv[e] : 0.f;
            v2u o; o.x = pk2(m.x, m.y); o.y = pk2(m.z, m.w); *(LAS v2u*)(L + WB_ + tr * RS + s4 * 8) = o; }
        { const int d = tid & 127, sq = tid >> 7;
#pragma unroll
          for (int k8 = 0; k8 < 4; ++k8) { unsigned x[8];
#pragma unroll
            for (int e = 0; e < 8; ++e) x[e] = ((const bf16*)scr)[(row0 + 32 * sq + 8 * k8 + e) * D + g * 128 + d];
            v4u o; o.x = x[0] | (x[1] << 16); o.y = x[2] | (x[3] << 16); o.z = x[4] | (x[5] << 16); o.w = x[6] | (x[7] << 16);
            *(LAS v4u*)(L + VT_ + d * RS + (32 * sq + 8 * k8) * 2) = o; } }
        __syncthreads();
        f32x4 acc[8];
#pragma unroll
        for (int di = 0; di < 8; ++di) acc[di] = (f32x4){0.f, 0.f, 0.f, 0.f};
        const int nks = (16 * w + 15) / 32 + 1;
        for (int ks = 0; ks < nks; ++ks) {
            const bf16x8 a = *(const LAS bf16x8*)(L + WB_ + (16 * w + lr) * RS + ks * 64 + g4 * 16);
#pragma unroll
            for (int di = 0; di < 8; ++di) { const bf16x8 bb = *(const LAS bf16x8*)(L + VT_ + (16 * di + lr) * RS + ks * 64 + g4 * 16); acc[di] = MFMA16(a, bb, acc[di]); }
        }
        float uu[4][8], bsr[4];
#pragma unroll
        for (int r = 0; r < 4; ++r) { const int tt = 16 * w + 4 * g4 + r; bsr[r] = b_s[g * 128 + tt];
#pragma unroll
            for (int di = 0; di < 8; ++di) uu[r][di] = proj[(row0 + tt) * 4096 + g * 128 + 16 * di + lr]; }
#pragma unroll
        for (int r = 0; r < 4; ++r) { const int tt = 16 * w + 4 * g4 + r; const size_t row = row0 + tt;
#pragma unroll
            for (int di = 0; di < 8; ++di) { const int d = 16 * di + lr; const float o = (acc[di][r] + bsr[r]) * gelu_erf(uu[r][di]);
                OB[row * D + g * 128 + d] = (bf16)pk2(o, o); } }
    }
    for (int it = F.vcu * NTHR + tid; it < MS * (D / 4); it += F.G * NTHR) {
        const int r = it >> 9, c4 = it & 511, b = r >> 2, t = r & 3, c = c4 * 4, g = c >> 7;
        f32x4 mix; { const float bs = b_s[g * 128 + t]; mix = (f32x4){bs, bs, bs, bs}; }
        { f32x4 vr[DSQ]; float ws_[DSQ];
#pragma unroll
          for (int s = 0; s < DSQ; ++s) { vr[s] = *(const GAS f32x4*)(F.out + O_VS + (size_t)(b * DSQ + s) * D + c); ws_[s] = w_s[(size_t)g * 16384 + t * 128 + s]; }
#pragma unroll
          for (int s = 0; s < DSQ; ++s) if (s <= t) mix += vr[s] * ws_[s]; }
        const f32x4 uz = *(const GAS f32x4*)(proj + (size_t)(MP + r) * 4096 + c); const f32x4 u = (f32x4){gelu_erf(uz.x), gelu_erf(uz.y), gelu_erf(uz.z), gelu_erf(uz.w)}; const f32x4 o = mix * u;
        v2u w; w.x = pk2(o.x, o.y); w.y = pk2(o.z, o.w); *(GAS v2u*)(OB + (size_t)(MP + r) * D + c) = w;
    }
}

__device__ __forceinline__ void bf8_to_f(const v4u w, float (&x)[8]) {
    x[0] = __builtin_bit_cast(float, w.x << 16); x[1] = __builtin_bit_cast(float, w.x & 0xffff0000u); x[2] = __builtin_bit_cast(float, w.y << 16); x[3] = __builtin_bit_cast(float, w.y & 0xffff0000u);
    x[4] = __builtin_bit_cast(float, w.z << 16); x[5] = __builtin_bit_cast(float, w.z & 0xffff0000u); x[6] = __builtin_bit_cast(float, w.w << 16); x[7] = __builtin_bit_cast(float, w.w & 0xffff0000u);
}
__device__ __forceinline__ void ld8f(const float* p, float (&x)[8]) { const f32x4 a = *(const GAS f32x4*)p, b = *(const GAS f32x4*)(p + 4); x[0] = a.x; x[1] = a.y; x[2] = a.z; x[3] = a.w; x[4] = b.x; x[5] = b.y; x[6] = b.z; x[7] = b.w; }
__device__ __forceinline__ void st8f(float* p, const float (&x)[8]) { *(GAS f32x4*)p = (f32x4){x[0], x[1], x[2], x[3]}; *(GAS f32x4*)(p + 4) = (f32x4){x[4], x[5], x[6], x[7]}; }
__device__ __forceinline__ void conv_fix(Frame& F, int layer, const float* cw, const float* cb, const float* st_in) {
    const float* SIDE = (const float*)(F.ws + WS_PROJ); const float* UPS = (const float*)(F.ws + WS_PROJ + 32 * MiB); bf16* ACT = (bf16*)(F.ws + WS_ACT);
    constexpr int NCH = FF / 8;
    for (int it = F.vcu * NTHR + F.tid; it < (MP / 64) * NCH; it += F.G * NTHR) {
        const int ch = it % NCH, blk = it / NCH, c = ch * 8;
        float wa[3][8], wg[3][8], ba[8], bg[8];
#pragma unroll
        for (int j = 0; j < 3; ++j) { ld8f(cw + (size_t)j * F2 + c, wa[j]); ld8f(cw + (size_t)j * F2 + FF + c, wg[j]); }
        ld8f(cb + c, ba); ld8f(cb + FF + c, bg);
        float a2[8], a1[8], g2[8], g1[8], x0a[8], x0g[8], x1a[8], x1g[8];
        if ((blk & 31) != 0) { const float* sp = SIDE + ((size_t)(blk - 1) * 4) * F2; ld8f(sp + c, a2); ld8f(sp + FF + c, g2); ld8f(sp + F2 + c, a1); ld8f(sp + F2 + FF + c, g1); }
        else {
#pragma unroll
            for (int e = 0; e < 8; ++e) { a2[e] = 0.f; a1[e] = 0.f; g2[e] = 0.f; g1[e] = 0.f; } }
        { const float* sp = SIDE + ((size_t)blk * 4 + 2) * F2; ld8f(sp + c, x0a); ld8f(sp + FF + c, x0g); ld8f(sp + F2 + c, x1a); ld8f(sp + F2 + FF + c, x1g); }
        float o0[8], o1[8];
#pragma unroll
        for (int e = 0; e < 8; ++e) {
            const float ya0 = ba[e] + wa[0][e] * a2[e] + wa[1][e] * a1[e] + wa[2][e] * x0a[e], yg0 = bg[e] + wg[0][e] * g2[e] + wg[1][e] * g1[e] + wg[2][e] * x0g[e];
            const float ya1 = ba[e] + wa[0][e] * a1[e] + wa[1][e] * x0a[e] + wa[2][e] * x1a[e], yg1 = bg[e] + wg[0][e] * g1[e] + wg[1][e] * x0g[e] + wg[2][e] * x1g[e];
            o0[e] = ya0 * (yg0 * sigm(yg0)); o1[e] = ya1 * (yg1 * sigm(yg1)); }
        v4u w; w.x = pk2(o0[0], o0[1]); w.y = pk2(o0[2], o0[3]); w.z = pk2(o0[4], o0[5]); w.w = pk2(o0[6], o0[7]);
        *(GAS v4u*)(ACT + (size_t)(blk * 64) * FF + c) = w;
        w.x = pk2(o1[0], o1[1]); w.y = pk2(o1[2], o1[3]); w.z = pk2(o1[4], o1[5]); w.w = pk2(o1[6], o1[7]);
        *(GAS v4u*)(ACT + (size_t)(blk * 64 + 1) * FF + c) = w;
    }
    for (int it = F.vcu * NTHR + F.tid; it < DB * NCH; it += F.G * NTHR) {
        const int ch = it % NCH, b = it / NCH, c = ch * 8;
        float wa[3][8], wg[3][8], ba[8], bg[8];
#pragma unroll
        for (int j = 0; j < 3; ++j) { ld8f(cw + (size_t)j * F2 + c, wa[j]); ld8f(cw + (size_t)j * F2 + FF + c, wg[j]); }
        ld8f(cb + c, ba); ld8f(cb + FF + c, bg);
        float a2[8], a1[8], g2[8], g1[8];
        const float* sp = st_in + ((size_t)(layer * DB + b) * 2) * F2;
        ld8f(sp + c, a2); ld8f(sp + FF + c, g2); ld8f(sp + F2 + c, a1); ld8f(sp + F2 + FF + c, g1);
#pragma unroll
        for (int t = 0; t < DSQ; ++t) {
            const size_t rl = (size_t)b * DSQ + t; float xa[8], xg[8];
            ld8f(UPS + rl * F2 + c, xa); ld8f(UPS + rl * F2 + FF + c, xg);
            float o[8];
#pragma unroll
            for (int e = 0; e < 8; ++e) { const float ya = ba[e] + wa[0][e] * a2[e] + wa[1][e] * a1[e] + wa[2][e] * xa[e], yg = bg[e] + wg[0][e] * g2[e] + wg[1][e] * g1[e] + wg[2][e] * xg[e];
                o[e] = ya * (yg * sigm(yg)); a2[e] = a1[e]; a1[e] = xa[e]; g2[e] = g1[e]; g1[e] = xg[e]; }
            v4u w; w.x = pk2(o[0], o[1]); w.y = pk2(o[2], o[3]); w.z = pk2(o[4], o[5]); w.w = pk2(o[6], o[7]);
            *(GAS v4u*)(ACT + (MP + rl) * FF + c) = w;
            if (t >= 2) { float* po = F.out + O_CVS + ((size_t)(layer * DB + b) * 2 + (t - 2)) * F2; st8f(po + c, xa); st8f(po + FF + c, xg); }
        }
    }
}
__device__ __forceinline__ void conv_ffn(Frame& F, int layer, const float* cw, const float* cb, const float* st_in) {
    const bf16* UP = (const bf16*)(F.ws + WS_PROJ); bf16* ACT = (bf16*)(F.ws + WS_ACT);
    constexpr int RB = 16, NCH = FF / 8;
    for (int it = F.vcu * NTHR + F.tid; it < (MP / RB) * NCH; it += F.G * NTHR) {
        const int ch = it % NCH, rb = it / NCH, c = ch * 8; const int r0 = rb * RB;
        float wa[3][8], wg[3][8], ba[8], bg[8];
#pragma unroll
        for (int j = 0; j < 3; ++j) { ld8f(cw + (size_t)j * F2 + c, wa[j]); ld8f(cw + (size_t)j * F2 + FF + c, wg[j]); }
        ld8f(cb + c, ba); ld8f(cb + FF + c, bg);
        float a2[8], a1[8], g2[8], g1[8];
        if ((r0 & (SEQ - 1)) != 0) { bf8_to_f(*(const GAS v4u*)(UP + (size_t)(r0 - 2) * F2 + c), a2); bf8_to_f(*(const GAS v4u*)(UP + (size_t)(r0 - 1) * F2 + c), a1);
                                     bf8_to_f(*(const GAS v4u*)(UP + (size_t)(r0 - 2) * F2 + FF + c), g2); bf8_to_f(*(const GAS v4u*)(UP + (size_t)(r0 - 1) * F2 + FF + c), g1); }
        else {
#pragma unroll
            for (int e = 0; e < 8; ++e) { a2[e] = 0.f; a1[e] = 0.f; g2[e] = 0.f; g1[e] = 0.f; } }
#pragma unroll 4
        for (int rr = 0; rr < RB; ++rr) {
            const int r = r0 + rr; float xa[8], xg[8];
            bf8_to_f(*(const GAS v4u*)(UP + (size_t)r * F2 + c), xa); bf8_to_f(*(const GAS v4u*)(UP + (size_t)r * F2 + FF + c), xg);
            float o[8];
#pragma unroll
            for (int e = 0; e < 8; ++e) { const float ya = ba[e] + wa[0][e] * a2[e] + wa[1][e] * a1[e] + wa[2][e] * xa[e], yg = bg[e] + wg[0][e] * g2[e] + wg[1][e] * g1[e] + wg[2][e] * xg[e];
                o[e] = ya * (yg * sigm(yg)); a2[e] = a1[e]; a1[e] = xa[e]; g2[e] = g1[e]; g1[e] = xg[e]; }
            v4u w; w.x = pk2(o[0], o[1]); w.y = pk2(o[2], o[3]); w.z = pk2(o[4], o[5]); w.w = pk2(o[6], o[7]);
            *(GAS v4u*)(ACT + (size_t)r * FF + c) = w;
            const int tin = r & (SEQ - 1);
            if (tin >= SEQ - 2) { float* po = F.out + O_CVP + ((size_t)(layer * NB + (r >> 11)) * 2 + (tin - (SEQ - 2))) * F2; st8f(po + c, xa); st8f(po + FF + c, xg); }
        }
    }
    for (int it = F.vcu * NTHR + F.tid; it < DB * NCH; it += F.G * NTHR) {
        const int ch = it % NCH, b = it / NCH, c = ch * 8;
        float wa[3][8], wg[3][8], ba[8], bg[8];
#pragma unroll
        for (int j = 0; j < 3; ++j) { ld8f(cw + (size_t)j * F2 + c, wa[j]); ld8f(cw + (size_t)j * F2 + FF + c, wg[j]); }
        ld8f(cb + c, ba); ld8f(cb + FF + c, bg);
        float a2[8], a1[8], g2[8], g1[8];
        const float* sp = st_in + ((size_t)(layer * DB + b) * 2) * F2;
        ld8f(sp + c, a2); ld8f(sp + FF + c, g2); ld8f(sp + F2 + c, a1); ld8f(sp + F2 + FF + c, g1);
#pragma unroll
        for (int t = 0; t < DSQ; ++t) {
            const size_t r = MP + b * DSQ + t; float xa[8], xg[8];
            bf8_to_f(*(const GAS v4u*)(UP + r * F2 + c), xa); bf8_to_f(*(const GAS v4u*)(UP + r * F2 + FF + c), xg);
            float o[8];
#pragma unroll
            for (int e = 0; e < 8; ++e) { const float ya = ba[e] + wa[0][e] * a2[e] + wa[1][e] * a1[e] + wa[2][e] * xa[e], yg = bg[e] + wg[0][e] * g2[e] + wg[1][e] * g1[e] + wg[2][e] * xg[e];
                o[e] = ya * (yg * sigm(yg)); a2[e] = a1[e]; a1[e] = xa[e]; g2[e] = g1[e]; g1[e] = xg[e]; }
            v4u w; w.x = pk2(o[0], o[1]); w.y = pk2(o[2], o[3]); w.z = pk2(o[4], o[5]); w.w = pk2(o[6], o[7]);
            *(GAS v4u*)(ACT + r * FF + c) = w;
            if (t >= 2) { float* po = F.out + O_CVS + ((size_t)(layer * DB + b) * 2 + (t - 2)) * F2; st8f(po + c, xa); st8f(po + FF + c, xg); }
        }
    }
}

#ifndef EN_P0
#define EN_P0 1
#endif
#ifndef EN_GIN
#define EN_GIN 1
#endif
#ifndef EN_MIXA
#define EN_MIXA 1
#endif
#ifndef EN_MIXB
#define EN_MIXB 1
#endif
#ifndef EN_GOUT
#define EN_GOUT 1
#endif
#ifndef EN_NORM
#define EN_NORM 1
#endif
#ifndef EN_GUP
#define EN_GUP 1
#endif
#ifndef EN_CONV
#define EN_CONV 1
#endif
#ifndef EN_GDOWN
#define EN_GDOWN 1
#endif
#ifndef REP_P0
#define REP_P0 1
#endif
#ifndef REP_GIN
#define REP_GIN 1
#endif
#ifndef REP_MIXA
#define REP_MIXA 1
#endif
#ifndef REP_MIXB
#define REP_MIXB 1
#endif
#ifndef REP_NORM
#define REP_NORM 1
#endif
#ifndef REP_GUP
#define REP_GUP 1
#endif
#ifndef REP_CONV
#define REP_CONV 1
#endif
#ifndef REP_GOUT
#define REP_GOUT 1
#endif
#ifndef REP_GDOWN
#define REP_GDOWN 1
#endif
constexpr int NPHASE = 37;
#ifndef MK_N_LAUNCHES
#define MK_N_LAUNCHES 1
#endif
#define FFN_DESC(li_) do { SET_DESCP(di, INP(32) + (size_t)(li_) * D * F2, INP(8) + (li_) * D, WB + WE_UP + (size_t)(li_) * WE_UP_STRIDE, D, F2, 0, 1.0f, 1); ++di; \
        SET_DESC(di, INP(35) + (size_t)(li_) * FF * D, (const float*)nullptr, WB + WE_DOWN + (size_t)(li_) * WE_DOWN_STRIDE, FF, D, 0, 1.0f); ++di; } while (0)
#define HGRN_DESC(jj_) do { const int li__ = (jj_) * 3; const float* gn = INP(7) + li__ * D; bf16* wi = WB + ((jj_) ? WE_IN3 : WE_IN0); bf16* wo = WB + ((jj_) ? WE_OUT3 : WE_OUT0); const size_t so = (size_t)(jj_) * D * D; \
        SET_DESC(di, INP(10) + so, gn, wi, D, D, 0, 1.0f); ++di; SET_DESC(di, INP(11) + so, gn, wi, D, D, 2048, 1.0f); ++di; \
        SET_DESC(di, INP(12) + so, gn, wi, D, D, 4096, 1.0f); ++di; SET_DESC(di, INP(13) + so, gn, wi, D, D, 6144, 1.0f); ++di; \
        SET_DESC(di, INP(16) + so, (const float*)nullptr, wo, D, D, 0, 1.0f); ++di; } while (0)
#define BUILD_DESC() do { if (F.tid == 0) { int tot_ = 0; int di = 0; \
        HGRN_DESC(0); FFN_DESC(0); \
        { const float* gn = INP(7) + 1 * D; bf16* wi = (bf16*)(args.ws + WS_WIN1); \
          SET_DESC(di, INP(17), gn, wi, D, 1024, 0, 1.0f); ++di; SET_DESC(di, INP(18), gn, wi, D, 1024, 1024, 0.08838834764831845f); ++di; \
          SET_DESC(di, INP(19), gn, wi, D, 2048, 2048, 1.0f); ++di; SET_DESC(di, INP(20), gn, wi, D, 2048, 4096, 1.0f); ++di; \
          SET_DESC(di, INP(24), (const float*)nullptr, WB + WE_OUT1, D, D, 0, 1.0f); ++di; } FFN_DESC(1); \
        { const float* gn = INP(7) + 2 * D; \
          SET_DESC(di, INP(25), gn, WB + WE_IN2, D, 4096, 0, 1.0f); ++di; SET_DESC(di, INP(31), (const float*)nullptr, WB + WE_OUT2, D, D, 0, 1.0f); ++di; } FFN_DESC(2); \
        HGRN_DESC(1); FFN_DESC(3); } } while (0)
#define CONVERT_FR(d_lo, d_hi, n0_, n1_, den_, widx, nw) do { LAS float* scr_ = (LAS float*)(F.lds + F.wave * 16640); \
        const int itA_ = (d_lo) ? desc[(d_lo) - 1].item_end : 0, itB_ = desc[(d_hi) - 1].item_end; \
        const int it0_ = itA_ + (int)((long)(itB_ - itA_) * (n0_) / (den_)), it1_ = itA_ + (int)((long)(itB_ - itA_) * (n1_) / (den_)); \
        for (int it = it0_ + (widx); it < it1_; it += (nw)) { int d = (d_lo); while (d < (d_hi) - 1 && desc[d].item_end <= it) ++d; \
            const int first = d ? desc[d - 1].item_end : 0; \
            p0_transpose_item(desc[d].W, desc[d].gain, desc[d].scale, desc[d].K, desc[d].N, desc[d].WT, desc[d].row_off, desc[d].perm, scr_, it - first, F.lane); } } while (0)
#define CONVERT(d_lo, d_hi, widx, nw) CONVERT_FR(d_lo, d_hi, 0, 1, 1, widx, nw)
constexpr int INTAB_OFF = 142592;
__device__ __forceinline__ const float* lds_ptr(LAS unsigned char* p) { const unsigned long long v = *(LAS unsigned long long*)p;
    const unsigned lo_ = __builtin_amdgcn_readfirstlane((unsigned)v), hi_ = __builtin_amdgcn_readfirstlane((unsigned)(v >> 32)); return (const float*)(((unsigned long long)hi_ << 32) | lo_); }
struct Args { const float* in[36]; float* out; unsigned char* ws; int ph_lo, ph_hi, li, pad; };
__global__ void __launch_bounds__(NTHR, 2) mk_fwd(Args args) {
    extern __shared__ __attribute__((aligned(16))) unsigned char lds[];
    Frame F;
    F.lds = (LAS unsigned char*)lds;
    F.MISC = (volatile LAS unsigned*)(F.lds + MISC_OFF);
    F.tid = threadIdx.x; F.lane = F.tid & 63; F.wave = __builtin_amdgcn_readfirstlane(F.tid >> 6);
    F.G = gridDim.x; { const int bx = blockIdx.x; F.vcu = (F.G % 8 == 0) ? (bx % 8) * (F.G / 8) + bx / 8 : bx; }
    F.out = args.out; F.ws = args.ws;
    for (int u = F.tid; u < (LDS_BYTES - LDSCTL_OFF) / 4; u += NTHR) ((LAS unsigned*)(F.lds + LDSCTL_OFF))[u] = 0u;
    __syncthreads();
    if (F.tid < 36) ((LAS unsigned long long*)(F.lds + INTAB_OFF))[F.tid] = (unsigned long long)args.in[F.tid];
    __syncthreads();
#define INP(k) lds_ptr(F.lds + INTAB_OFF + 8 * (k))
    const int lo = args.ph_lo, hi = args.ph_hi;
    bf16* WB = (bf16*)(args.ws + WS_W);
    LAS MatDesc* desc = (LAS MatDesc*)(F.lds + DESC_OFF);
    BUILD_DESC();
    unsigned* barw = (unsigned*)(args.ws + WS_CTL) + CW_BAR + args.li * XCD_BAR_WORDS;
    XcdBarrier bar; bar.bar = barw; bar.x = 0; bar.st = nullptr;
    if (hi - lo > 1) bar = xcd_barrier_post(barw, F.MISC + 8);
#define IN(k) (lo <= (k) && (k) < hi)
#define FRESH() do { int t_ = threadIdx.x; asm volatile("" : "+v"(t_)); F.tid = t_; F.lane = t_ & 63; F.wave = __builtin_amdgcn_readfirstlane(t_ >> 6); } while (0)
#if defined(DBG_CONV_RAW)
#define CONV_FN conv_ffn
#else
#define CONV_FN conv_fix
#endif
#ifndef PROBE_NOSTORE
#define PROBE_NOSTORE 0
#endif
#ifndef PROBE_NOML
#define PROBE_NOML 0
#endif
#ifndef PROBE_PART
#define PROBE_PART 3
#endif
#ifndef REP_BAR
#define REP_BAR 1
#endif
#if defined(PROBE_K2)
#define K2_RERUN(gg, Mm, Nn) do { xcd_barrier(bar); _Pragma("unroll 1") for (int rr_ = 0; rr_ < PROBE_K2; ++rr_) { FRESH(); pg8::StaticOrder Sx; Sx.init((Mm), (Nn), F.G, (int)blockIdx.x); int one_ = 1; asm volatile("" : "+s"(one_)); pg8::EpiBf16<0> Ex{(pg8::bf16_t*)(args.ws + WS_SCR), 256, one_}; \
        pg8::gemm_phase<pg8::EpiBf16<0>, pg8::StaticOrder, PG8_ALIGN, PG8_SP2>(F.lds, (gg), Sx, Ex); } xcd_barrier(bar); } while (0)
#else
#define K2_RERUN(gg, Mm, Nn) do { } while (0)
#endif
#define SEAM(k) do { if (IN(k) && IN((k) + 1)) { _Pragma("unroll 1") for (int rb_ = 0; rb_ < REP_BAR; ++rb_) xcd_barrier(bar); } } while (0)
    float* X = (float*)(args.ws + WS_X); bf16* HB = (bf16*)(args.ws + WS_HB); float* PROJ = (float*)(args.ws + WS_PROJ); bf16* UP = (bf16*)(args.ws + WS_PROJ);
    bf16* OB = (bf16*)(args.ws + WS_OB); bf16* ACT = (bf16*)(args.ws + WS_ACT); float* PART = (float*)(args.ws + WS_PART); float* SSQ = (float*)(args.ws + WS_SSQ);
    unsigned* CNT = (unsigned*)(args.ws + WS_CTL) + CW_CNT;

    if (EN_P0 && IN(0)) {
        FRESH();
        __syncthreads();
        {
            const int dhi = F.G > 64 ? 7 : N_MAT;
            CONVERT(0, dhi, F.vcu * NWAVES + F.wave, F.G * NWAVES);
        }
        { bf16* wi = (bf16*)(args.ws + WS_WIN1); const float* gn = INP(7) + 1 * D; const float* wif = INP(21);
          for (int idx = F.vcu * NTHR + F.tid; idx < 256 * (D / 2); idx += F.G * NTHR) { const int r = idx / (D / 2), k2 = (idx % (D / 2)) * 2;
              unsigned w = 0u; if (r < 16) w = pk2(wif[(size_t)k2 * 16 + r] * gn[k2], wif[(size_t)(k2 + 1) * 16 + r] * gn[k2 + 1]);
              *(GAS unsigned*)(wi + (size_t)(6144 + r) * D + k2) = w; } }
        norm_rows(F, 1 | 16 | 32, 0, INP(0), INP(1), nullptr, nullptr, nullptr);
        SEAM(0);
    }
    for (int i = 0; i < 4; ++i) {
        const int kind = i % 3, base = 1 + 9 * i, j = i / 3;
        const size_t we_in = i == 0 ? WE_IN0 : i == 1 ? WE_IN1 : i == 2 ? WE_IN2 : WE_IN3, we_out = i == 0 ? WE_OUT0 : i == 1 ? WE_OUT1 : i == 2 ? WE_OUT2 : WE_OUT3;
        const int Nin = kind == 0 ? 8192 : kind == 1 ? 6144 : 4096;
        if (EN_GIN && IN(base + 0)) {
            FRESH();
            const int Ng = kind == 1 ? 6400 : Nin;
            const bool split = (kind != 1) && (F.G >= 256);
            const bf16* Wt = kind == 1 ? (const bf16*)(args.ws + WS_WIN1) : WB + we_in;
            pg8::Gemm g{HB, Wt, split ? MP : M, Ng, D, D}; pg8::StaticOrder S; S.init(split ? MP : M, Ng, F.G, (int)blockIdx.x);
            fill_rstd_table(F, S);
            { pg8::EpiF32 E{PROJ, Nin, kind == 2 ? INP(26) : (const float*)nullptr, 0, (const LAS float*)(F.lds + RTAB_OFF),
                    kind == 1 ? 24 : -1, (float*)(args.ws + WS_GATES), INP(22)};
            pg8::gemm_phase<pg8::EpiF32, pg8::StaticOrder, PG8_ALIGN, PG8_SP2>(F.lds, g, S, E); }
            if (split) { pg8::Gemm g2{HB + (size_t)MP * D, Wt, MS, Ng, 512, D}; pg8::SplitOrder S2; S2.init(MS, Ng, 4, 512, F.G, (int)blockIdx.x);
                pg8::EpiPart E2{(float*)(args.ws + WS_SCR), Ng, (size_t)MS * Ng};
                pg8::gemm_phase<pg8::EpiPart, pg8::SplitOrder, PG8_ALIGN, PG8_SP2>(F.lds, g2, S2, E2);
                sample_reduce_proj<4>(F, S2, CNT + 8192 + (size_t)i * 64 * 64, Ng, kind == 2 ? INP(26) : (const float*)nullptr); }
            if (i == 1 && F.G > 64) {
                const int rem = (M / 256) * (Ng / 256) % F.G, bx = (int)blockIdx.x;
                if (rem != 0 && bx >= rem) { __syncthreads(); CONVERT_FR(18, N_MAT, 0, 9, 20, (bx - rem) * NWAVES + F.wave, (F.G - rem) * NWAVES); }
                else if (rem == 0) { __syncthreads(); CONVERT_FR(18, N_MAT, 0, 9, 20, F.vcu * NWAVES + F.wave, F.G * NWAVES); }
            }
            SEAM(base + 0);
        }
        if (EN_MIXA && IN(base + 1)) {
            FRESH();
            if (kind == 0) { { FRESH(); hgrn_scan(F, j, INP(14), INP(15) + j * D, INP(2), 3); }
                if (i == 0 && F.G > 64 && blockIdx.x >= 64) { __syncthreads();
                    CONVERT(7, 14, ((int)blockIdx.x - 64) * NWAVES + F.wave, (F.G - 64) * NWAVES); } }
            else if (kind == 1) { { FRESH(); mlstm_scan(F, INP(3), INP(4), INP(5)); }
                if (F.G > 64 && blockIdx.x >= 64) { __syncthreads();
                    CONVERT(14, 18, ((int)blockIdx.x - 64) * NWAVES + F.wave, (F.G - 64) * NWAVES); CONVERT_FR(18, N_MAT, 9, 20, 20, ((int)blockIdx.x - 64) * NWAVES + F.wave, (F.G - 64) * NWAVES); } }
            else gmlp_a(F, INP(27), INP(28));
            SEAM(base + 1);
        }
        if (EN_MIXB && kind != 0 && IN(base + 2)) {
            FRESH();
            {
            if (kind == 1) mlstm_post(F, INP(23));
            else gmlp_b(F, INP(29), INP(30)); }
            SEAM(base + 2);
        }
        if (EN_GOUT && IN(base + 3)) {
            FRESH();
            { pg8::Gemm g{OB, WB + we_out, MP, D, D, D}; pg8::StaticOrder S; S.init(MP, D, F.G, (int)blockIdx.x);
              if (kind == 0) fill_rstd_table16(F, S);
              { pg8::EpiResid E{i == 0 ? INP(0) : (const float*)X, X, D, HB, SSQ, kind == 0 ? (const LAS float*)(F.lds + RTAB_OFF) : (const LAS float*)nullptr};
              pg8::gemm_phase<pg8::EpiResid, pg8::StaticOrder, PG8_ALIGN, PG8_SP2>(F.lds, g, S, E); } K2_RERUN(g, MP, D); }
            { pg8::Gemm g{OB + (size_t)MP * D, WB + we_out, MS, D, 256, D}; pg8::SplitOrder S; S.init(MS, D, 8, 256, F.G, (int)blockIdx.x);
              pg8::EpiPart E{PART, D, (size_t)MS * D};
              pg8::gemm_phase<pg8::EpiPart, pg8::SplitOrder, PG8_ALIGN, PG8_SP2>(F.lds, g, S, E);
#if !defined(DBG_REDUCE_PHASE)
              sample_reduce<8>(F, S, CNT + (size_t)(2 * i) * 16 * 64, i == 0 ? INP(1) : (const float*)(X + (size_t)MP * D), kind == 0 ? (const float*)(args.ws + WS_OSSQ) : (const float*)nullptr);
#endif
            }
            SEAM(base + 3);
#if defined(DBG_REDUCE_PHASE)
            FRESH(); sample_reduce_rows(F, 4); xcd_barrier(bar);
#endif
        }
        if (EN_GUP && IN(base + 5)) {
            FRESH();
            pg8::Gemm g{HB, WB + WE_UP + (size_t)i * WE_UP_STRIDE, M, F2, D, D}; pg8::StaticOrder S; S.init(M, F2, F.G, (int)blockIdx.x);
            fill_rstd_table(F, S);
            { pg8::EpiConv E{ACT, PROJ, PROJ + 8 * MiB, args.out + O_CVP + (size_t)i * NB * 2 * F2, INP(33) + (size_t)i * 3 * F2, INP(34) + (size_t)i * F2, FF, MP / 256, (const LAS float*)(F.lds + RTAB_OFF), (LAS float*)(F.lds + RING_BYTES)};
              pg8::gemm_phase<pg8::EpiConv, pg8::StaticOrder, PG8_ALIGN, PG8_SP2>(F.lds, g, S, E); }
            SEAM(base + 5);
        }
        if (EN_CONV && IN(base + 6)) { FRESH(); CONV_FN(F, i, INP(33) + (size_t)i * 3 * F2, INP(34) + (size_t)i * F2, INP(6)); SEAM(base + 6); }
        if (EN_GDOWN && IN(base + 7)) {
            FRESH();
            { pg8::Gemm g{ACT, WB + WE_DOWN + (size_t)i * WE_DOWN_STRIDE, MP, D, FF, FF}; pg8::StaticOrder S; S.init(MP, D, F.G, (int)blockIdx.x);
              { pg8::EpiResid E{X, X, D, i == 3 ? (bf16*)nullptr : HB, SSQ, (const LAS float*)nullptr};
              pg8::gemm_phase<pg8::EpiResid, pg8::StaticOrder, PG8_ALIGN, PG8_SP2>(F.lds, g, S, E); } }
            { pg8::Gemm g{ACT + (size_t)MP * FF, WB + WE_DOWN + (size_t)i * WE_DOWN_STRIDE, MS, D, 512, FF}; pg8::SplitOrder S; S.init(MS, D, 11, 512, F.G, (int)blockIdx.x);
              pg8::EpiPart E{PART, D, (size_t)MS * D};
              pg8::gemm_phase<pg8::EpiPart, pg8::SplitOrder, PG8_ALIGN, PG8_SP2>(F.lds, g, S, E);
#if !defined(DBG_REDUCE_PHASE)
              sample_reduce<11>(F, S, CNT + (size_t)(2 * i + 1) * 16 * 64, (const float*)(X + (size_t)MP * D), (const float*)nullptr);
#endif
            }
            SEAM(base + 7);
#if defined(DBG_REDUCE_PHASE)
            FRESH(); sample_reduce_rows(F, 11); xcd_barrier(bar);
#endif
        }
        if (EN_NORM && i == 3 && IN(base + 8)) { FRESH(); norm_rows(F, 2, 0, nullptr, nullptr, INP(9), nullptr, nullptr); }
    }
#undef IN
#undef SEAM
}

extern "C" void kernel_launch(void* const* d_in, const int* in_sizes, int n_in, void* d_out, int out_size, void* d_ws, size_t ws_size, hipStream_t stream) {
    static int grid = 0;
    if (grid == 0) {
        if (n_in != 36 || (size_t)out_size != O_END || ws_size < WS_END) { fprintf(stderr, "kernel_launch: unexpected shapes: n_in %d out %d ws %zu (need %zu)\n", n_in, out_size, ws_size, (size_t)WS_END); grid = -1; return; }
        int dev = 0, cus = 0;
        if (hipGetDevice(&dev) != hipSuccess || hipDeviceGetAttribute(&cus, hipDeviceAttributeMultiprocessorCount, dev) != hipSuccess) { grid = -1; return; }
        if (hipFuncSetAttribute((const void*)mk_fwd, hipFuncAttributeMaxDynamicSharedMemorySize, LDS_BYTES) != hipSuccess) { fprintf(stderr, "kernel_launch: hipFuncSetAttribute failed\n"); grid = -1; return; }
        int per_cu = 0;
        if (hipOccupancyMaxActiveBlocksPerMultiprocessor(&per_cu, (const void*)mk_fwd, NTHR, LDS_BYTES) != hipSuccess || per_cu < 1) { fprintf(stderr, "kernel_launch: occupancy query says %d blocks per CU\n", per_cu); }
        (void)hipGetLastError();
        grid = cus;
    }
    if (grid < 0) return;
    (void)hipMemsetAsync((char*)d_ws + WS_CTL, 0, CTL_ZERO_BYTES, stream);
    Args a{};
    for (int i = 0; i < 36; ++i) a.in[i] = (const float*)d_in[i];
    a.out = (float*)d_out; a.ws = (unsigned char*)d_ws; a.pad = 0;
#if MK_N_LAUNCHES == 1
    a.ph_lo = 0; a.ph_hi = NPHASE; a.li = 0;
    hipLaunchKernelGGL(mk_fwd, dim3(grid), dim3(NTHR), LDS_BYTES, stream, a);
#else
    for (int p = 0; p < NPHASE; ++p) { a.ph_lo = p; a.ph_hi = p + 1; a.li = p;
        hipLaunchKernelGGL(mk_fwd, dim3(grid), dim3(NTHR), LDS_BYTES, stream, a); }
#endif
}
```

```cpp
#include <hip/hip_runtime.h>
#include <cstdio>
#include <cstdint>
#ifndef PG8_WGM
#define PG8_WGM 4
#endif
namespace pg8 {
#define PG8_LAS __attribute__((address_space(3)))
typedef unsigned short bf16_t;
typedef short bf16x8 __attribute__((ext_vector_type(8)));
typedef float f32x4 __attribute__((ext_vector_type(4)));
typedef unsigned u32x4 __attribute__((ext_vector_type(4)));
constexpr int BM = 256, BK = 64, HALF = 128, HTB = HALF * BK * 2  , STAGE_BYTES = 8 * HTB, NXCD = 8, WGM = PG8_WGM;

__host__ __device__ __forceinline__ int lds_byte(int r, int c) { const int st = (r >> 4) * 2 + (c >> 5), rr = r & 15, cc = c & 31, ob = rr * 64 + cc * 2; return st * 1024 + (ob ^ (((ob >> 9) & 1) << 5)); }
__host__ __device__ __forceinline__ void stage_rc(int b, int& R, int& C) { const int st = b / 1024, sb = b % 1024, swz = sb ^ (((sb >> 9) & 1) << 5); R = (st >> 1) * 16 + swz / 64; C = (st & 1) * 32 + (swz % 64) / 2; }
__host__ __device__ __forceinline__ int perm32(int rho) { const int n = rho >> 4, i = rho & 15; return 8 * (i >> 2) + 4 * n + (i & 3); }

struct Unit { int pm, pn, kofs, ks, slot; };
struct Gemm { const bf16_t* A; const bf16_t* Bt; int M, N, K, ld; };

struct StaticOrder {
    int nM, nN, nwg, G, c;
    __host__ __device__ void init(int M, int N, int G_, int c_) { nM = M / BM; nN = N / BM; nwg = nM * nN; G = G_; c = c_; }
    __host__ __device__ bool next(int i, Unit& u) const {
        const long L = (long)i * G + c; if (L >= nwg) return false;
        int wgid = (int)L; { const int q = nwg / NXCD, r = nwg % NXCD, xcd = wgid % NXCD, off = wgid / NXCD; wgid = (xcd < r ? xcd * (q + 1) : r * (q + 1) + (xcd - r) * q) + off; }
        const int nig = WGM * nN, gid = wgid / nig, fm = gid * WGM, gsz = (nM - fm) < WGM ? (nM - fm) : WGM;
        u.pm = fm + ((wgid % nig) % gsz); u.pn = (wgid % nig) / gsz; u.kofs = 0; u.ks = 0; u.slot = i; return true;
    }
    __device__ __forceinline__ void a_ready(const Unit&) const {}
    __device__ __forceinline__ void done(const Unit&) const {}
};
struct SplitOrder {
    int nN, nK, Ksub, nunits, G, c;
    __host__ __device__ void init(int Mrows, int N, int nK_, int Ksub_, int G_, int c_) { nN = N / BM; nK = nK_; Ksub = Ksub_; nunits = (Mrows / BM) * nN * nK; G = G_; c = c_; }
    __host__ __device__ bool next(int i, Unit& u) const {
        const int L = i * G + c; if (L >= nunits) return false;
        u.ks = L % nK; const int r = L / nK; u.pn = r % nN; u.pm = r / nN; u.kofs = u.ks * Ksub; u.slot = i; return true;
    }
    __device__ __forceinline__ void a_ready(const Unit&) const {}
    __device__ __forceinline__ void done(const Unit&) const {}
};
__device__ __forceinline__ unsigned cvt_pk_bf16(float lo, float hi) { unsigned r; asm volatile("v_cvt_pk_bf16_f32 %0, %1, %2" : "=v"(r) : "v"(lo), "v"(hi)); return r; }
typedef float f32x2c __attribute__((ext_vector_type(2))); typedef __bf16 bf16x2c __attribute__((ext_vector_type(2)));
__device__ __forceinline__ unsigned pk2_(float lo, float hi) { f32x2c v; v.x = lo; v.y = hi; return __builtin_bit_cast(unsigned, __builtin_convertvector(v, bf16x2c)); }
__device__ __forceinline__ void rows_rstd(const float* SSQ, const Unit& u, int wr, int fr, int fq, float inv_d, float eps, float (&rs)[2][4]) {
#pragma unroll
    for (int ai = 0; ai < 2; ++ai)
#pragma unroll
        for (int m = 0; m < 4; ++m) { const float* p = SSQ + (size_t)(u.pm * BM + ai * HALF + wr * 64 + m * 16 + fr) * 32 + fq * 8;
            const f32x4 a = *(const f32x4*)p, b = *(const f32x4*)(p + 4); float s = ((a[0] + a[1]) + (a[2] + a[3])) + ((b[0] + b[1]) + (b[2] + b[3]));
            s += __shfl_xor(s, 16); s += __shfl_xor(s, 32); rs[ai][m] = 1.0f / sqrtf(s * inv_d + eps); }
}
__device__ __forceinline__ void rows_rstd_lds(const PG8_LAS float* tab, const Unit& u, int wr, int fr, float (&rs)[2][4]) {
#pragma unroll
    for (int ai = 0; ai < 2; ++ai)
#pragma unroll
        for (int m = 0; m < 4; ++m) rs[ai][m] = tab[u.slot * 256 + ai * HALF + wr * 64 + m * 16 + fr];
}
template <int ACT> struct EpiBf16 {
    static constexpr bool PERM = true, AFTER_DRAIN = false;
    bf16_t* O; int ldc; int skip;
    __device__ __forceinline__ void operator()(const f32x4 (&acc)[2][2][4][2], const Unit& u, int wr, int wc, int fr, int fq) const {
        if (skip) return;
        const int row0 = u.pm * BM + wr * 64 + fr; const int col0 = u.pn * BM + wc * 32 + 8 * fq;
#pragma unroll
        for (int ai = 0; ai < 2; ++ai)
#pragma unroll
            for (int m = 0; m < 4; ++m) { bf16_t* rowp = O + (size_t)(row0 + ai * HALF + m * 16) * ldc + col0;
#pragma unroll
                for (int bj = 0; bj < 2; ++bj) { const f32x4 v0 = acc[ai][bj][m][0], v1 = acc[ai][bj][m][1];
                    u32x4 w; w.x = cvt_pk_bf16(v0[0], v0[1]); w.y = cvt_pk_bf16(v0[2], v0[3]); w.z = cvt_pk_bf16(v1[0], v1[1]); w.w = cvt_pk_bf16(v1[2], v1[3]);
                    *(u32x4*)(rowp + bj * HALF) = w; } }
    }
};
struct EpiF32 {
    static constexpr bool PERM = false, AFTER_DRAIN = false;
    float* C; int ldc; const float* bias; int skip; const PG8_LAS float* rtab;
    int gate_pn; float* GATES; const float* b_if;
    __device__ __forceinline__ void operator()(const f32x4 (&acc)[2][2][4][2], const Unit& u, int wr, int wc, int fr, int fq) const {
        if (skip) return;
        float rs[2][4]; rows_rstd_lds(rtab, u, wr, fr, rs);
        const int row0 = u.pm * BM + wr * 64 + fr, col0 = u.pn * BM + wc * 32 + 4 * fq;
        if (u.pn == gate_pn) {
            if (wc == 0) { const f32x4 bb = *(const f32x4*)(b_if + 4 * fq);
#pragma unroll
                for (int ai = 0; ai < 2; ++ai)
#pragma unroll
                    for (int m = 0; m < 4; ++m) { f32x4 o;
#pragma unroll
                        for (int e = 0; e < 4; ++e) { const float pre = acc[ai][0][m][0][e] * rs[ai][m] + bb[e]; const float gate = 15.0f - 30.0f * __builtin_amdgcn_rcpf(1.0f + __expf(pre * (2.0f / 15.0f)));     o[e] = fq < 2 ? gate : -__logf(1.0f + __expf(-gate)); }
                        *(f32x4*)(GATES + (size_t)(row0 + ai * HALF + m * 16) * 16 + 4 * fq) = o; } }
            return;
        }
        f32x4 bv[2][2];
#pragma unroll
        for (int bj = 0; bj < 2; ++bj)
#pragma unroll
            for (int n = 0; n < 2; ++n) bv[bj][n] = bias ? *(const f32x4*)(bias + col0 + bj * HALF + n * 16) : (f32x4){0.f, 0.f, 0.f, 0.f};
#pragma unroll
        for (int ai = 0; ai < 2; ++ai)
#pragma unroll
            for (int m = 0; m < 4; ++m) { float* rowp = C + (size_t)(row0 + ai * HALF + m * 16) * ldc + col0;
#pragma unroll
                for (int bj = 0; bj < 2; ++bj)
#pragma unroll
                    for (int n = 0; n < 2; ++n) *(f32x4*)(rowp + bj * HALF + n * 16) = acc[ai][bj][m][n] * rs[ai][m] + bv[bj][n]; }
    }
};
#if defined(EPI_NT)
#define EPI_ST(T, p, v) __builtin_nontemporal_store((v), (T*)(p))
#else
#define EPI_ST(T, p, v) (*(T*)(p) = (v))
#endif
struct EpiResid {
    static constexpr bool PERM = false, AFTER_DRAIN = false;
    const float* res; float* out; int ldc; bf16_t* XB; float* SSQ; const PG8_LAS float* rtab;
    __device__ __forceinline__ void operator()(const f32x4 (&acc)[2][2][4][2], const Unit& u, int wr, int wc, int fr, int fq) const {
        typedef unsigned u32x2 __attribute__((ext_vector_type(2)));
        const int row0 = u.pm * BM + wr * 64 + fr, col0 = u.pn * BM + wc * 32 + 4 * fq;
#pragma unroll
        for (int ai = 0; ai < 2; ++ai) {
            f32x4 r[4][2][2];
#pragma unroll
            for (int m = 0; m < 4; ++m) { const size_t off = (size_t)(row0 + ai * HALF + m * 16) * ldc + col0;
#pragma unroll
                for (int bj = 0; bj < 2; ++bj)
#pragma unroll
                    for (int n = 0; n < 2; ++n) r[m][bj][n] = *(const f32x4*)(res + off + bj * HALF + n * 16); }
#pragma unroll
            for (int m = 0; m < 4; ++m) { const size_t off = (size_t)(row0 + ai * HALF + m * 16) * ldc + col0;
                const float rsc = rtab ? rtab[u.slot * 256 + ai * HALF + wr * 64 + m * 16 + fr] : 1.0f; float s = 0.f;
#pragma unroll
                for (int bj = 0; bj < 2; ++bj)
#pragma unroll
                    for (int n = 0; n < 2; ++n) { const f32x4 x = acc[ai][bj][m][n] * rsc + r[m][bj][n]; EPI_ST(f32x4, out + off + bj * HALF + n * 16, x);
                        if (XB) { u32x2 w; w.x = pk2_(x[0], x[1]); w.y = pk2_(x[2], x[3]); EPI_ST(u32x2, XB + off + bj * HALF + n * 16, w); }
                        s += (x[0] * x[0] + x[1] * x[1]) + (x[2] * x[2] + x[3] * x[3]); }
                if (XB) { s += __shfl_xor(s, 16); s += __shfl_xor(s, 32);
                    if (fq == 0) SSQ[(size_t)(row0 + ai * HALF + m * 16) * 32 + u.pn * 4 + wc] = s; } }
            asm volatile("" ::: "memory");
        }
    }
};
#if !defined(PART_F32) && !defined(PART_BF16)
#define PART_BF16 1
#endif
struct EpiPart {
    static constexpr bool PERM = false, AFTER_DRAIN = false;
    float* P; int ldc; size_t slab;
    __device__ __forceinline__ void operator()(const f32x4 (&acc)[2][2][4][2], const Unit& u, int wr, int wc, int fr, int fq) const {
        const int row0 = u.pm * BM + wr * 64 + fr, col0 = u.pn * BM + wc * 32 + 4 * fq;
#if defined(PART_BF16)
        typedef unsigned u32x2 __attribute__((ext_vector_type(2)));
        bf16_t* base = (bf16_t*)P + (size_t)u.ks * slab;
#pragma unroll
        for (int ai = 0; ai < 2; ++ai)
#pragma unroll
            for (int m = 0; m < 4; ++m) { bf16_t* rowp = base + (size_t)(row0 + ai * HALF + m * 16) * ldc + col0;
#pragma unroll
                for (int bj = 0; bj < 2; ++bj)
#pragma unroll
                    for (int n = 0; n < 2; ++n) { const f32x4 v = acc[ai][bj][m][n]; u32x2 w; w.x = pk2_(v[0], v[1]); w.y = pk2_(v[2], v[3]); *(u32x2*)(rowp + bj * HALF + n * 16) = w; } }
#else
        float* base = P + (size_t)u.ks * slab;
#pragma unroll
        for (int ai = 0; ai < 2; ++ai)
#pragma unroll
            for (int m = 0; m < 4; ++m) { float* rowp = base + (size_t)(row0 + ai * HALF + m * 16) * ldc + col0;
#pragma unroll
                for (int bj = 0; bj < 2; ++bj)
#pragma unroll
                    for (int n = 0; n < 2; ++n) *(f32x4*)(rowp + bj * HALF + n * 16) = acc[ai][bj][m][n]; }
#endif
    }
};

#ifndef DPP_R1
#define DPP_R1 0x121
#define DPP_R2 0x122
#endif
__device__ __forceinline__ f32x4 dpp_ror4(const f32x4 v, const int which) {
    f32x4 r;
#if defined(DBG_SHFL)
    { const int ln = __lane_id(); const int src = (ln & ~15) | ((ln - which) & 15);
#pragma unroll
      for (int e = 0; e < 4; ++e) r[e] = __shfl(v[e], src);
      return r; }
#endif
#pragma unroll
    for (int e = 0; e < 4; ++e) { const int x = __builtin_bit_cast(int, v[e]);
        r[e] = __builtin_bit_cast(float, which == 1 ? __builtin_amdgcn_update_dpp(0, x, DPP_R1, 0xF, 0xF, false) : __builtin_amdgcn_update_dpp(0, x, DPP_R2, 0xF, 0xF, false)); }
    return r;
}
template <int CTRL> __device__ __forceinline__ f32x4 dpp_mov4(const f32x4 v) {
    f32x4 r;
#pragma unroll
    for (int e = 0; e < 4; ++e) { int x = __builtin_bit_cast(int, v[e]); asm volatile("" : "+v"(x)); int y = __builtin_amdgcn_update_dpp(0, x, CTRL, 0xF, 0xF, true); asm volatile("" : "+v"(y)); r[e] = __builtin_bit_cast(float, y); }
    return r;
}
struct EpiConv {
    static constexpr bool PERM = true, AFTER_DRAIN = false;
    bf16_t* ACT; float* SIDE; float* UPS; float* cvp; const float* cw; const float* cb; int FFd, mp_tiles; const PG8_LAS float* rtab; PG8_LAS float* cwl;
    __device__ __forceinline__ void operator()(f32x4 (&acc)[2][2][4][2], const Unit& u, int wr, int wc, int fr, int fq) const {
        const int F2d = 2 * FFd;
        { float rs[2][4]; rows_rstd_lds(rtab, u, wr, fr, rs);
#pragma unroll
          for (int ai = 0; ai < 2; ++ai)
#pragma unroll
            for (int bj = 0; bj < 2; ++bj)
#pragma unroll
                for (int m = 0; m < 4; ++m)
#pragma unroll
                    for (int n = 0; n < 2; ++n) acc[ai][bj][m][n] = acc[ai][bj][m][n] * rs[ai][m]; }
        const int c0 = u.pn * 128 + wc * 32 + 8 * fq;
#if defined(DBG_CONV_RAW)
        { bf16_t* UPB = (bf16_t*)SIDE; const int row0 = u.pm * BM + wr * 64 + fr;
#pragma unroll
          for (int ai = 0; ai < 2; ++ai)
#pragma unroll
            for (int m = 0; m < 4; ++m) { bf16_t* rp = UPB + (size_t)(row0 + ai * HALF + m * 16) * F2d + c0;
                u32x4 wA, wG; wA.x = pk2_(acc[ai][0][m][0][0], acc[ai][0][m][0][1]); wA.y = pk2_(acc[ai][0][m][0][2], acc[ai][0][m][0][3]); wA.z = pk2_(acc[ai][0][m][1][0], acc[ai][0][m][1][1]); wA.w = pk2_(acc[ai][0][m][1][2], acc[ai][0][m][1][3]);
                wG.x = pk2_(acc[ai][1][m][0][0], acc[ai][1][m][0][1]); wG.y = pk2_(acc[ai][1][m][0][2], acc[ai][1][m][0][3]); wG.z = pk2_(acc[ai][1][m][1][0], acc[ai][1][m][1][1]); wG.w = pk2_(acc[ai][1][m][1][2], acc[ai][1][m][1][3]);
                *(u32x4*)rp = wA; *(u32x4*)(rp + FFd) = wG; }
          return; }
#endif
        if (u.pm >= mp_tiles) {
            const int rloc0 = (u.pm - mp_tiles) * BM + wr * 64 + fr;
#pragma unroll
            for (int ai = 0; ai < 2; ++ai)
#pragma unroll
                for (int m = 0; m < 4; ++m) { float* rp = UPS + (size_t)(rloc0 + ai * HALF + m * 16) * F2d + c0;
#pragma unroll
                    for (int n = 0; n < 2; ++n) { *(f32x4*)(rp + 4 * n) = acc[ai][0][m][n]; *(f32x4*)(rp + FFd + 4 * n) = acc[ai][1][m][n]; } }
            return;
        }
#if !defined(CONV_W_GLOBAL)
        { typedef float f32x2_ __attribute__((ext_vector_type(2)));
          const int t2 = (((wr * 4 + wc) * 64) + fq * 16 + fr) * 2, a = t2 >> 7, col = t2 & 127;
          const float* src = ((a & 3) == 3 ? cb : cw + (size_t)(a & 3) * F2d) + (a >> 2) * FFd + u.pn * 128 + col;
          const f32x2_ v = *(const f32x2_*)src; *(PG8_LAS f32x2_*)(cwl + t2) = v; }
        asm volatile("s_waitcnt lgkmcnt(0)" ::: "memory"); __builtin_amdgcn_s_barrier(); asm volatile("" ::: "memory");
#endif
#pragma unroll
        for (int n = 0; n < 2; ++n) {
            const int c = c0 + 4 * n;
#if !defined(CONV_W_GLOBAL)
            const PG8_LAS float* wl = cwl + wc * 32 + 8 * fq + 4 * n;
            const f32x4 wa0 = *(const PG8_LAS f32x4*)(wl), wa1 = *(const PG8_LAS f32x4*)(wl + 128), wa2 = *(const PG8_LAS f32x4*)(wl + 256), ba = *(const PG8_LAS f32x4*)(wl + 384);
            const f32x4 wg0 = *(const PG8_LAS f32x4*)(wl + 512), wg1 = *(const PG8_LAS f32x4*)(wl + 640), wg2 = *(const PG8_LAS f32x4*)(wl + 768), bg = *(const PG8_LAS f32x4*)(wl + 896);
#else
            const f32x4 wa0 = *(const f32x4*)(cw + c), wa1 = *(const f32x4*)(cw + F2d + c), wa2 = *(const f32x4*)(cw + 2 * F2d + c), ba = *(const f32x4*)(cb + c);
            const f32x4 wg0 = *(const f32x4*)(cw + FFd + c), wg1 = *(const f32x4*)(cw + F2d + FFd + c), wg2 = *(const f32x4*)(cw + 2 * F2d + FFd + c), bg = *(const f32x4*)(cb + FFd + c);
#endif
#pragma unroll
            for (int ai = 0; ai < 2; ++ai) {
                const int blk = u.pm * 4 + ai * 2 + wr;
#pragma unroll
                for (int m = 0; m < 4; ++m) {
                    const f32x4 xa = acc[ai][0][m][n], xg = acc[ai][1][m][n];
                    const f32x4 pa = acc[ai][0][m > 0 ? m - 1 : 0][n], pg = acc[ai][1][m > 0 ? m - 1 : 0][n];
                    const int ln_ = __lane_id(), s1_ = ((ln_ & ~15) | ((ln_ - 1) & 15)) << 2, s2_ = ((ln_ & ~15) | ((ln_ - 2) & 15)) << 2;
                    f32x4 a1c, a2c, g1c, g2c;
#pragma unroll
                    for (int e = 0; e < 4; ++e) {
#if !defined(CONV_BPERMUTE)
                        a1c[e] = __builtin_bit_cast(float, __builtin_amdgcn_update_dpp(0, __builtin_bit_cast(int, fr == 15 ? pa[e] : xa[e]), 0x121, 0xF, 0xF, true));
                        a2c[e] = __builtin_bit_cast(float, __builtin_amdgcn_update_dpp(0, __builtin_bit_cast(int, fr >= 14 ? pa[e] : xa[e]), 0x122, 0xF, 0xF, true));
                        g1c[e] = __builtin_bit_cast(float, __builtin_amdgcn_update_dpp(0, __builtin_bit_cast(int, fr == 15 ? pg[e] : xg[e]), 0x121, 0xF, 0xF, true));
                        g2c[e] = __builtin_bit_cast(float, __builtin_amdgcn_update_dpp(0, __builtin_bit_cast(int, fr >= 14 ? pg[e] : xg[e]), 0x122, 0xF, 0xF, true)); }
#else
                        a1c[e] = __builtin_bit_cast(float, __builtin_amdgcn_ds_bpermute(s1_, __builtin_bit_cast(int, fr == 15 ? pa[e] : xa[e])));
                        a2c[e] = __builtin_bit_cast(float, __builtin_amdgcn_ds_bpermute(s2_, __builtin_bit_cast(int, fr >= 14 ? pa[e] : xa[e])));
                        g1c[e] = __builtin_bit_cast(float, __builtin_amdgcn_ds_bpermute(s1_, __builtin_bit_cast(int, fr == 15 ? pg[e] : xg[e])));
                        g2c[e] = __builtin_bit_cast(float, __builtin_amdgcn_ds_bpermute(s2_, __builtin_bit_cast(int, fr >= 14 ? pg[e] : xg[e]))); }
#endif
                    const f32x4 a1p = a1c, a2p = a2c, g1p = g1c, g2p = g2c;
                    f32x4 o;
#pragma unroll
                    for (int e = 0; e < 4; ++e) {
                        const float a1 = fr == 0 ? a1p[e] : a1c[e], a2 = fr < 2 ? a2p[e] : a2c[e], g1 = fr == 0 ? g1p[e] : g1c[e], g2 = fr < 2 ? g2p[e] : g2c[e];
                        const float ya = ba[e] + wa0[e] * a2 + wa1[e] * a1 + wa2[e] * xa[e], yg = bg[e] + wg0[e] * g2 + wg1[e] * g1 + wg2[e] * xg[e];
                        o[e] = ya * yg * __builtin_amdgcn_rcpf(1.0f + __expf(-yg)); }
                    const int lt = ai * HALF + wr * 64 + m * 16 + fr;
                    if (!(m == 0 && fr < 2)) { typedef unsigned u32x2 __attribute__((ext_vector_type(2))); u32x2 w; w.x = pk2_(o[0], o[1]); w.y = pk2_(o[2], o[3]);
                        *(u32x2*)(ACT + (size_t)(u.pm * BM + lt) * FFd + c) = w; }
                    if (m == 0 && fr < 2) { float* sp = SIDE + ((size_t)blk * 4 + 2 + fr) * F2d + c; *(f32x4*)sp = xa; *(f32x4*)(sp + FFd) = xg; }
                    if (m == 3 && fr >= 14) { float* sp = SIDE + ((size_t)blk * 4 + (fr - 14)) * F2d + c; *(f32x4*)sp = xa; *(f32x4*)(sp + FFd) = xg;
                        if ((u.pm & 7) == 7 && ai == 1 && wr == 1) { float* po = cvp + ((size_t)(u.pm >> 3) * 2 + (fr - 14)) * F2d + c; *(f32x4*)po = xa; *(f32x4*)(po + FFd) = xg; } }
                }
            }
        }
    }
};

template <class Epi, class Sched, bool ALIGN_EPI = false, bool SP2 = false>
__device__ __forceinline__ void gemm_phase(PG8_LAS unsigned char* lds, const Gemm g, const Sched& S, const Epi& E) {
    int tid_ = threadIdx.x; asm volatile("" : "+v"(tid_));
    const int tid = tid_, wid = __builtin_amdgcn_readfirstlane(tid >> 6), lane = tid & 63, wr = wid >> 2, wc = wid & 3, fr = lane & 15, fq = lane >> 4;
    const int K = g.K, nt = K / BK, LD = g.ld;
    unsigned voffA[2], voffB[2];
#pragma unroll
    for (int i = 0; i < 2; ++i) { int R, C; stage_rc(tid * 16 + i * 8192, R, C); const int Rb = Epi::PERM ? ((R & ~31) + perm32(R & 31)) : R;
        voffA[i] = (unsigned)(R * LD + C) * 2u; voffB[i] = (unsigned)(Rb * LD + C) * 2u; }
    const size_t kstep = (size_t)(BK * 2);
    const size_t hstep = (size_t)HALF * LD * 2;
    const size_t tstep = 2 * hstep;
    const unsigned ldsw = (unsigned)wid * 1024u;
    const int aoff = lds_byte(wr * 64 + fr, fq * 8), boff = lds_byte(wc * 32 + fr, fq * 8);
#define PG8_SA(b, h) (((b) * 2 + (h)) * HTB)
#define PG8_SB(b, h) ((4 + (b) * 2 + (h)) * HTB)
#define PG8_STAGE(bufoff, gbase, voff) do { _Pragma("unroll") for (int _i = 0; _i < 2; ++_i) \
        __builtin_amdgcn_global_load_lds((const unsigned*)((const char*)(gbase) + (voff)[_i]), (PG8_LAS unsigned*)(lds + (bufoff) + ldsw + _i * 8192), 16, 0, 0); } while (0)
#define PG8_LDA(dst, b, h) do { _Pragma("unroll") for (int m = 0; m < 4; ++m) _Pragma("unroll") for (int k = 0; k < 2; ++k) dst[m][k] = *(const PG8_LAS bf16x8*)(lds + PG8_SA(b, h) + aoff + m * 2048 + k * 1024); } while (0)
#define PG8_LDB(dst, b, h) do { _Pragma("unroll") for (int n = 0; n < 2; ++n) _Pragma("unroll") for (int k = 0; k < 2; ++k) dst[n][k] = *(const PG8_LAS bf16x8*)(lds + PG8_SB(b, h) + boff + n * 2048 + k * 1024); } while (0)
#define PG8_MMA(ai, bj, At, Bt) do { __builtin_amdgcn_s_setprio(1); _Pragma("unroll") for (int m = 0; m < 4; ++m) _Pragma("unroll") for (int n = 0; n < 2; ++n) _Pragma("unroll") for (int k = 0; k < 2; ++k) \
        acc[ai][bj][m][n] = __builtin_amdgcn_mfma_f32_16x16x32_bf16(Bt[n][k], At[m][k], acc[ai][bj][m][n], 0, 0, 0); __builtin_amdgcn_s_setprio(0); } while (0)
#define PG8_WAIT_V(n) asm volatile("s_waitcnt vmcnt(" #n ")" ::: "memory")
#define PG8_WAIT_L(n) asm volatile("s_waitcnt lgkmcnt(" #n ")" ::: "memory")
#define PG8_BAR __builtin_amdgcn_s_barrier()
#define PG8_SCHED __builtin_amdgcn_sched_barrier(0)
    Unit cur, nxt; int ui = 0;
    if (!S.next(0, cur)) return;
    f32x4 acc[2][2][4][2];
#pragma unroll
    for (int a = 0; a < 2; ++a)
#pragma unroll
        for (int b = 0; b < 2; ++b)
#pragma unroll
            for (int m = 0; m < 4; ++m)
#pragma unroll
                for (int n = 0; n < 2; ++n) acc[a][b][m][n] = (f32x4){0.f, 0.f, 0.f, 0.f};
    bf16x8 At[4][2], B0[2][2], B1[2][2];
    const char* cA = (const char*)g.A + (size_t)cur.pm * tstep + (size_t)cur.kofs * 2; const char* cB = (const char*)g.Bt + (size_t)cur.pn * tstep + (size_t)cur.kofs * 2;
    S.a_ready(cur);
    if constexpr (SP2) {
        PG8_STAGE(PG8_SB(0, 0), cB, voffB); PG8_STAGE(PG8_SB(0, 1), cB + hstep, voffB); PG8_STAGE(PG8_SA(0, 0), cA, voffA); PG8_STAGE(PG8_SA(0, 1), cA + hstep, voffA);
        if (wr == 1) PG8_BAR;
        PG8_WAIT_V(2); PG8_BAR;
        PG8_STAGE(PG8_SB(1, 0), cB + kstep, voffB); PG8_STAGE(PG8_SA(1, 0), cA + kstep, voffA); PG8_STAGE(PG8_SB(1, 1), cB + hstep + kstep, voffB);
        PG8_WAIT_V(6); PG8_BAR;
    } else {
        PG8_STAGE(PG8_SB(0, 0), cB, voffB); PG8_STAGE(PG8_SA(0, 0), cA, voffA); PG8_STAGE(PG8_SB(0, 1), cB + hstep, voffB); PG8_STAGE(PG8_SA(0, 1), cA + hstep, voffA);
        if (wr == 1) PG8_BAR;
        PG8_WAIT_V(4); PG8_BAR;
        PG8_STAGE(PG8_SB(1, 0), cB + kstep, voffB); PG8_STAGE(PG8_SA(1, 0), cA + kstep, voffA); PG8_STAGE(PG8_SB(1, 1), cB + hstep + kstep, voffB);
        PG8_WAIT_V(6); PG8_BAR;
    }
    for (;;) {
        const bool has_next = S.next(ui + 1, nxt);
        const char* nA = has_next ? (const char*)g.A + (size_t)nxt.pm * tstep + (size_t)nxt.kofs * 2 : cA; const char* nB = has_next ? (const char*)g.Bt + (size_t)nxt.pn * tstep + (size_t)nxt.kofs * 2 : cB;
        for (int t = 0; t < nt; t += 2) {
            const bool last = (t == nt - 2);
            const char* a1 = cA + (size_t)(t + 1) * kstep;
            const char* a2 = last ? nA : cA + (size_t)(t + 2) * kstep; const char* b2 = last ? nB : cB + (size_t)(t + 2) * kstep;
            const char* a3 = a2 + kstep; const char* b3 = b2 + kstep;
            if (last && has_next) S.a_ready(nxt);
            if constexpr (SP2) {
            PG8_LDB(B0, 0, 0); PG8_LDB(B1, 0, 1); PG8_SCHED; PG8_LDA(At, 0, 0); PG8_STAGE(PG8_SA(1, 1), a1 + hstep, voffA);
            PG8_WAIT_V(8); PG8_WAIT_L(0); PG8_BAR; PG8_MMA(0, 0, At, B0); PG8_MMA(0, 1, At, B1); PG8_BAR; PG8_SCHED;
            PG8_LDA(At, 0, 1); PG8_STAGE(PG8_SB(0, 0), b2, voffB); PG8_STAGE(PG8_SB(0, 1), b2 + hstep, voffB); PG8_STAGE(PG8_SA(0, 0), a2, voffA);
            PG8_WAIT_V(8); PG8_WAIT_L(0); PG8_BAR; PG8_MMA(1, 0, At, B0); PG8_MMA(1, 1, At, B1); PG8_BAR; PG8_SCHED;
            PG8_LDB(B0, 1, 0); PG8_LDB(B1, 1, 1); PG8_SCHED; PG8_LDA(At, 1, 0); PG8_STAGE(PG8_SA(0, 1), a2 + hstep, voffA);
            PG8_WAIT_V(8); PG8_WAIT_L(0); PG8_BAR; PG8_MMA(0, 0, At, B0); PG8_MMA(0, 1, At, B1); PG8_BAR; PG8_SCHED;
            PG8_LDA(At, 1, 1); PG8_STAGE(PG8_SB(1, 0), b3, voffB); PG8_STAGE(PG8_SB(1, 1), b3 + hstep, voffB); PG8_STAGE(PG8_SA(1, 0), a3, voffA);
            PG8_WAIT_V(8); PG8_WAIT_L(0); PG8_BAR; PG8_MMA(1, 0, At, B0); PG8_MMA(1, 1, At, B1); PG8_BAR; PG8_SCHED;
            } else {
            PG8_LDB(B0, 0, 0); PG8_SCHED; PG8_LDA(At, 0, 0); PG8_STAGE(PG8_SA(1, 1), a1 + hstep, voffA);
            PG8_WAIT_L(8); PG8_BAR; PG8_WAIT_L(0); PG8_MMA(0, 0, At, B0); PG8_BAR; PG8_SCHED;
            PG8_LDB(B1, 0, 1); PG8_STAGE(PG8_SB(0, 0), b2, voffB);
            PG8_BAR; PG8_WAIT_L(0); PG8_MMA(0, 1, At, B1); PG8_BAR;
            PG8_LDA(At, 0, 1); PG8_STAGE(PG8_SA(0, 0), a2, voffA);
            PG8_BAR; PG8_WAIT_L(0); PG8_MMA(1, 0, At, B0); PG8_BAR; PG8_SCHED;
            PG8_STAGE(PG8_SB(0, 1), b2 + hstep, voffB);
            PG8_WAIT_V(6); PG8_BAR; PG8_MMA(1, 1, At, B1); PG8_BAR;
            PG8_LDB(B0, 1, 0); PG8_SCHED; PG8_LDA(At, 1, 0); PG8_STAGE(PG8_SA(0, 1), a2 + hstep, voffA);
            PG8_WAIT_L(8); PG8_BAR; PG8_WAIT_L(0); PG8_MMA(0, 0, At, B0); PG8_BAR; PG8_SCHED;
            PG8_LDB(B1, 1, 1); PG8_STAGE(PG8_SB(1, 0), b3, voffB);
            PG8_BAR; PG8_WAIT_L(0); PG8_MMA(0, 1, At, B1); PG8_BAR;
            PG8_LDA(At, 1, 1); PG8_STAGE(PG8_SA(1, 0), a3, voffA);
            PG8_BAR; PG8_WAIT_L(0); PG8_MMA(1, 0, At, B0); PG8_BAR; PG8_SCHED;
            PG8_STAGE(PG8_SB(1, 1), b3 + hstep, voffB);
            PG8_WAIT_V(6); PG8_BAR; PG8_MMA(1, 1, At, B1); PG8_BAR;
            }
        }
        if constexpr (ALIGN_EPI) { if (wr == 0) PG8_BAR; }
        if constexpr (!Epi::AFTER_DRAIN) { E(acc, cur, wr, wc, fr, fq); S.done(cur); }
        if (!has_next) break;
#pragma unroll
        for (int a = 0; a < 2; ++a)
#pragma unroll
            for (int b = 0; b < 2; ++b)
#pragma unroll
                for (int m = 0; m < 4; ++m)
#pragma unroll
                    for (int n = 0; n < 2; ++n) acc[a][b][m][n] = (f32x4){0.f, 0.f, 0.f, 0.f};
        cur = nxt; cA = nA; cB = nB; ++ui;
        if constexpr (ALIGN_EPI) { if (wr == 1) PG8_BAR; }
    }
    PG8_WAIT_V(0);
    if constexpr (!ALIGN_EPI) { if (wr == 0) PG8_BAR; }
    PG8_BAR;
    if constexpr (Epi::AFTER_DRAIN) { E.fused(acc, cur, wr, wc, fr, fq, lds, wid, lane); S.done(cur); }
#undef PG8_SA
#undef PG8_SB
#undef PG8_STAGE
#undef PG8_LDA
#undef PG8_LDB
#undef PG8_MMA
#undef PG8_WAIT_V
#undef PG8_WAIT_L
#undef PG8_BAR
#undef PG8_SCHED
}
}

#ifndef PG8_SP2
#define PG8_SP2 true
#endif
#ifndef PG8_ALIGN
#define PG8_ALIGN true
#endif

#ifndef SCAN_SPLIT
#define SCAN_SPLIT 4
#endif
#ifndef SCAN_FIRST
#define SCAN_FIRST(w) ((w) >= SCAN_SPLIT)
#endif
#ifndef SCAN_PRIO_POST
#define SCAN_PRIO_POST 1
#endif
#ifndef SCAN_PRIO
#define SCAN_PRIO 1
#endif
constexpr int NWAVES = 8, NTHR = 512;
constexpr int D = 2048, MP = 8192, MS = 512, M = MP + MS, FF = 5632, F2 = 11264;
constexpr int SEQ = 2048, NB = 4, DB = 128, DSQ = 4;
constexpr float EPS = 1e-6f, GATE_CAP = 15.0f;
constexpr size_t O_YP = 0, O_YS = 16777216, O_SP = 17825792, O_SS = 19922944, O_CP = 87031808, O_CS = 88080384, O_NP = 121634816, O_NS = 121638912,
                 O_MP = 121769984, O_MS = 121770016, O_VS = 121771040, O_CVP = 122819616, O_CVS = 123180064, O_END = 134714400;
constexpr size_t MiB = 1u << 20;
constexpr size_t WS_CTL = 0, CTL_ZERO_BYTES = 1 * MiB;
constexpr size_t WS_W = 1 * MiB;
constexpr size_t WS_X = 401 * MiB;
constexpr size_t WS_HB = 469 * MiB;
constexpr size_t WS_PROJ = 503 * MiB;
constexpr size_t WS_OB = 775 * MiB;
constexpr size_t WS_ACT = 809 * MiB;
constexpr size_t WS_SCR = 903 * MiB;
constexpr size_t WS_GATES = 971 * MiB;
constexpr size_t WS_PART = 972 * MiB;
constexpr size_t WS_DENM = 1016 * MiB;
constexpr size_t WS_SSQ = 1017 * MiB;
constexpr size_t WS_OSSQ = 1018 * MiB + 256 * 1024;
constexpr size_t WS_WIN1 = 1019 * MiB;
constexpr size_t WS_END = 1045 * MiB;
constexpr size_t WE_IN0 = 0, WE_OUT0 = 16777216, WE_IN1 = 20971520, WE_OUT1 = 33554432, WE_IN2 = 37748736, WE_OUT2 = 46137344, WE_IN3 = 50331648, WE_OUT3 = 67108864,
                 WE_UP = 71303168, WE_UP_STRIDE = 23068672, WE_DOWN = 163577856, WE_DOWN_STRIDE = 11534336;
constexpr int CW_BAR = 4096, CW_CNT = 200000;
constexpr int RING_BYTES = 131072, LDSCTL_OFF = 146432, MISC_OFF = LDSCTL_OFF + 320, LDS_BYTES = 147456;

#define GAS __attribute__((address_space(1)))
#define LAS __attribute__((address_space(3)))
typedef unsigned short bf16;
typedef unsigned v4u __attribute__((ext_vector_type(4)));
typedef unsigned v2u __attribute__((ext_vector_type(2)));
typedef float f32x4 __attribute__((ext_vector_type(4)));
typedef GAS unsigned gu32;
#define LDS_WAIT() asm volatile("s_waitcnt lgkmcnt(0)" ::: "memory")
#define VM_WAIT() asm volatile("s_waitcnt vmcnt(0)" ::: "memory")
__device__ __forceinline__ unsigned f2bf(float f) { unsigned u = __builtin_bit_cast(unsigned, f); return (u + 0x7fffu + ((u >> 16) & 1u)) >> 16; }
typedef float f32x2_t __attribute__((ext_vector_type(2)));
typedef __bf16 bf16x2_t __attribute__((ext_vector_type(2)));
__device__ __forceinline__ unsigned pk2(float lo, float hi) { f32x2_t v; v.x = lo; v.y = hi; return __builtin_bit_cast(unsigned, __builtin_convertvector(v, bf16x2_t)); }
__device__ __forceinline__ float bf2f(unsigned short b) { return __builtin_bit_cast(float, ((unsigned)b) << 16); }
__device__ __forceinline__ float sigm(float x) { return __builtin_amdgcn_rcpf(1.0f + __expf(-x)); }

#define XB_TMO      128
#define XB_XCNT(j)  (256  + 64 * (j))
#define XB_XSUB(j)  (1280 + 64 * (j))
#define XB_XGEN(j)  (2304 + 64 * (j))
#define XB_TOP      3328
#define XB_TOPGEN   3392
#define XCD_BAR_WORDS 3456
#define XB_SPIN_CAP (1u << 18)
__device__ __forceinline__ unsigned xb_ld(unsigned* p)              { return __hip_atomic_load(p, __ATOMIC_RELAXED, __HIP_MEMORY_SCOPE_AGENT); }
__device__ __forceinline__ unsigned xb_add(unsigned* p, unsigned v) { return __hip_atomic_fetch_add(p, v, __ATOMIC_RELAXED, __HIP_MEMORY_SCOPE_AGENT); }
__device__ __forceinline__ unsigned xb_xcc_id() { return (unsigned)__builtin_amdgcn_s_getreg((3 << 11) | 20) & 0xFu; }
#define XB_SPIN(cond, bar) do { unsigned _sp = 0; while (cond) { __builtin_amdgcn_s_sleep(1); \
    if ((++_sp & 255u) == 0u) { if (xb_ld(&(bar)[XB_TMO])) break; if (_sp > XB_SPIN_CAP) { atomicAdd(&(bar)[XB_TMO], 1u); break; } } } } while (0)
struct XcdBarrier { unsigned* bar; unsigned x; volatile LAS unsigned* st; };
__device__ __forceinline__ XcdBarrier xcd_barrier_post(unsigned* bar, volatile LAS unsigned* st) {
    XcdBarrier b; b.bar = bar; b.x = xb_xcc_id(); b.st = st;
    if (threadIdx.x == 0) (void)xb_add(&bar[XB_XCNT(b.x)], 1u);
    return b;
}
__device__ __forceinline__ void xcd_barrier_complete(unsigned* bar, unsigned x, unsigned& nloc, unsigned& nx) {
    const unsigned G = gridDim.x * gridDim.y * gridDim.z;
    unsigned sum, cnt, mine, sp = 0u;
    for (;;) {
        sum = 0u; cnt = 0u; mine = 0u;
#pragma unroll
        for (unsigned j = 0; j < 16; ++j) { const unsigned c = xb_ld(&bar[XB_XCNT(j)]); sum += c; cnt += (c > 0u) ? 1u : 0u; mine = (j == x) ? c : mine; }
        if (sum == G) break;
        __builtin_amdgcn_s_sleep(1);
        if ((++sp & 255u) == 0u) { if (xb_ld(&bar[XB_TMO])) break; if (sp > XB_SPIN_CAP) { atomicAdd(&bar[XB_TMO], 1u); break; } }
    }
    nloc = mine > 0u ? mine : 1u; nx = cnt > 0u ? cnt : 1u;
}
__device__ __forceinline__ void xcd_barrier(const XcdBarrier& b) {
    asm volatile("s_waitcnt vmcnt(0)" ::: "memory");
    __syncthreads();
    if (threadIdx.x == 0) {
        unsigned* bar = b.bar;
        __builtin_amdgcn_s_waitcnt(0);
        unsigned nloc = b.st[0], nx = b.st[1];
        if (nloc == 0u) { xcd_barrier_complete(bar, b.x, nloc, nx); b.st[0] = nloc; b.st[1] = nx; }
        const unsigned old = xb_add(&bar[XB_XSUB(b.x)], 1u);
        const unsigned gen = old / nloc;
        if (old + 1u == (gen + 1u) * nloc) {
            __builtin_amdgcn_fence(__ATOMIC_RELEASE, "agent");
            asm volatile("s_waitcnt vmcnt(0)" ::: "memory");
            const unsigned og = xb_add(&bar[XB_TOP], 1u);
            const unsigned tg = og / nx;
            if (og + 1u == (tg + 1u) * nx) xb_add(&bar[XB_TOPGEN], 1u);
            else XB_SPIN(xb_ld(&bar[XB_TOPGEN]) == tg, bar);
            __builtin_amdgcn_fence(__ATOMIC_ACQUIRE, "agent");
            xb_add(&bar[XB_XGEN(b.x)], 1u);
            asm volatile("s_waitcnt vmcnt(0)" ::: "memory");
        } else {
            XB_SPIN(xb_ld(&bar[XB_XGEN(b.x)]) == gen, bar);
            __builtin_amdgcn_fence(__ATOMIC_ACQUIRE, "agent");
            asm volatile("s_waitcnt vmcnt(0)" ::: "memory");
        }
    }
    __syncthreads();
}

struct Frame {
    LAS unsigned char* lds;
    volatile LAS unsigned* MISC;
    int tid, lane, wave;
    int vcu, G;
    const float* const* in;
    float* out; unsigned char* ws;
};
__device__ __forceinline__ float wave_sum(float v) {
#pragma unroll
    for (int o = 1; o < 64; o <<= 1) v += __shfl_xor(v, o);
    return v;
}
__device__ __forceinline__ float row16_sum(float v) {
    v += __builtin_bit_cast(float, __builtin_amdgcn_update_dpp(0, __builtin_bit_cast(int, v), 0xB1, 0xF, 0xF, true));
    v += __builtin_bit_cast(float, __builtin_amdgcn_update_dpp(0, __builtin_bit_cast(int, v), 0x4E, 0xF, 0xF, true));
    v += __builtin_bit_cast(float, __builtin_amdgcn_update_dpp(0, __builtin_bit_cast(int, v), 0x141, 0xF, 0xF, true));
    v += __builtin_bit_cast(float, __builtin_amdgcn_update_dpp(0, __builtin_bit_cast(int, v), 0x140, 0xF, 0xF, true));
    return v;
}
struct MatDesc { const float* W; const float* gain; bf16* WT; int K, N, row_off; float scale; int item_end, perm; };
constexpr int N_MAT = 25, DESC_OFF = 135168;
__device__ __forceinline__ void p0_transpose_item(const float* W, const float* gain, float scale, int K, int N, bf16* WT, int row_off, int perm, LAS float* scr, int item, int lane) {
    const int nblk = N / 64, kb = item / nblk, nb = item % nblk, k0 = 64 * kb, n0 = 64 * nb;
    const int d0 = !perm ? n0 : (n0 < FF ? (n0 >> 7) * 256 + (n0 & 127) : ((n0 - FF) >> 7) * 256 + 128 + ((n0 - FF) & 127));
    const int lr = lane >> 4, lc = (lane & 15) * 4;
    f32x4 w[16];
#pragma unroll
    for (int i = 0; i < 16; ++i) w[i] = __builtin_nontemporal_load((const GAS f32x4*)(W + (size_t)(k0 + 4 * i + lr) * N + n0 + lc));
#pragma unroll
    for (int i = 0; i < 16; ++i) { const int kk = 4 * i + lr; const float g = gain ? gain[k0 + kk] * scale : scale;
        LAS float* d = scr + kk * 65 + lc; d[0] = w[i].x * g; d[1] = w[i].y * g; d[2] = w[i].z * g; d[3] = w[i].w * g; }
    LDS_WAIT(); asm volatile("" ::: "memory");
    const int c = lane >> 3, nl = lane & 7;
#pragma unroll
    for (int j = 0; j < 8; ++j) { const int n = nl + 8 * j; const LAS float* s = scr + (8 * c) * 65 + n;
        v4u o; o.x = pk2(s[0 * 65], s[1 * 65]); o.y = pk2(s[2 * 65], s[3 * 65]); o.z = pk2(s[4 * 65], s[5 * 65]); o.w = pk2(s[6 * 65], s[7 * 65]);
        *(GAS v4u*)(WT + (size_t)(row_off + d0 + n) * K + k0 + 8 * c) = o; }
    LDS_WAIT(); asm volatile("" ::: "memory");
}
#define SET_DESC(idx, Wp, gp, WTp, Kv, Nv, ro, sc) SET_DESCP(idx, Wp, gp, WTp, Kv, Nv, ro, sc, 0)
#define SET_DESCP(idx, Wp, gp, WTp, Kv, Nv, ro, sc, pm_) do { LAS MatDesc* d_ = desc + (idx); d_->W = (Wp); d_->gain = (gp); d_->WT = (WTp); d_->K = (Kv); d_->N = (Nv); d_->row_off = (ro); d_->scale = (sc); \
    tot_ += ((Kv) / 64) * ((Nv) / 64); d_->item_end = tot_; d_->perm = (pm_); } while (0)

__device__ __forceinline__ void norm_rows(Frame& F, int mode, int nparts, const float* xp, const float* xs, const float* gain, const float* w_if, const float* b_if) {
    float* X = (float*)(F.ws + WS_X); bf16* HB = (bf16*)(F.ws + WS_HB); float* GATES = (float*)(F.ws + WS_GATES);
    const int gw = F.vcu * NWAVES + F.wave, NGW = F.G * NWAVES, lane = F.lane;
    for (int m = gw; m < M; m += NGW) {
        const float* src = (mode & 1) ? (m < MP ? xp + (size_t)m * D : xs + (size_t)(m - MP) * D) : X + (size_t)m * D;
        const GAS f32x4* xr = (const GAS f32x4*)src + lane;
        f32x4 v[8]; float ss = 0.f;
#pragma unroll
        for (int j = 0; j < 8; ++j) v[j] = xr[64 * j];
        __builtin_amdgcn_sched_barrier(0);
#pragma unroll
        for (int j = 0; j < 8; ++j) ss += (v[j].x * v[j].x + v[j].y * v[j].y) + (v[j].z * v[j].z + v[j].w * v[j].w);
        if ((mode & 8) && m >= MP) {
            const GAS f32x4* pr = (const GAS f32x4*)((const float*)(F.ws + WS_PART) + (size_t)(m - MP) * D) + lane;
            for (int p = 0; p < nparts; ++p) {
#pragma unroll
                for (int j = 0; j < 8; ++j) v[j] += pr[(size_t)p * (MS * D / 4) + 64 * j]; }
            ss = 0.f; GAS f32x4* xo = (GAS f32x4*)(X + (size_t)m * D) + lane;
#pragma unroll
            for (int j = 0; j < 8; ++j) { xo[64 * j] = v[j]; ss += (v[j].x * v[j].x + v[j].y * v[j].y) + (v[j].z * v[j].z + v[j].w * v[j].w); }
        }
        const float wave_sum_keep = wave_sum(ss);
        const float rstd = 1.0f / sqrtf(wave_sum_keep * (1.0f / D) + EPS);
        if ((mode & 1) && !(mode & 32)) { GAS f32x4* xo = (GAS f32x4*)(X + (size_t)m * D) + lane;
#pragma unroll
            for (int j = 0; j < 8; ++j) xo[64 * j] = v[j]; }
        if (mode & 2) { GAS f32x4* yo = (GAS f32x4*)(F.out + (size_t)m * D) + lane; const GAS f32x4* g4 = (const GAS f32x4*)gain + lane;
            f32x4 gq[8];
#pragma unroll
            for (int j = 0; j < 8; ++j) gq[j] = g4[64 * j];
#pragma unroll
            for (int j = 0; j < 8; ++j) yo[64 * j] = v[j] * rstd * gq[j]; }
        else { GAS v2u* ho = (GAS v2u*)(HB + (size_t)m * D) + lane; const float sc_ = (mode & 16) ? 1.0f : rstd;
#pragma unroll
            for (int j = 0; j < 8; ++j) { v2u w; w.x = pk2(v[j].x * sc_, v[j].y * sc_); w.y = pk2(v[j].z * sc_, v[j].w * sc_); ho[64 * j] = w; }
            if ((mode & 16) && lane < 32) ((float*)(F.ws + WS_SSQ))[(size_t)m * 32 + lane] = lane == 0 ? wave_sum_keep : 0.f; }
    }
}

__device__ __forceinline__ float hgrn_lb(int j, const float* lbp, int c) { return j == 0 ? 0.f : fmaxf(sigm(lbp[2048 + c] - lbp[c]), 0.f); }
constexpr int RTAB_OFF = 136448, RTAB_SLOTS = 6;
template <class Sched> __device__ __forceinline__ void fill_rstd_table16(Frame& F, const Sched& S) {
    const float* OSSQ = (const float*)(F.ws + WS_OSSQ); LAS float* tab = (LAS float*)(F.lds + RTAB_OFF);
    pg8::Unit u;
    for (int i = 0; i < RTAB_SLOTS && S.next(i, u); ++i) {
        const int r = F.tid >> 1, hf = F.tid & 1; const float* p = OSSQ + ((size_t)u.pm * 256 + r) * 16 + hf * 8;
        const f32x4 a = *(const GAS f32x4*)p, b = *(const GAS f32x4*)(p + 4);
        float s = ((a.x + a.y) + (a.z + a.w)) + ((b.x + b.y) + (b.z + b.w));
        s += __shfl_xor(s, 1);
        if (hf == 0) tab[i * 256 + r] = 1.0f / sqrtf(s * (1.0f / D) + EPS);
    }
    __syncthreads();
}
template <class Sched> __device__ __forceinline__ void fill_rstd_table(Frame& F, const Sched& S) {
    const float* SSQ = (const float*)(F.ws + WS_SSQ); LAS float* tab = (LAS float*)(F.lds + RTAB_OFF);
    const int r = F.tid >> 1, hf = F.tid & 1;
    f32x4 q[RTAB_SLOTS][4]; bool ok[RTAB_SLOTS];
#pragma unroll
    for (int i = 0; i < RTAB_SLOTS; ++i) { pg8::Unit u; ok[i] = S.next(i, u); const int pm = ok[i] ? u.pm : 0;
        const float* p = SSQ + ((size_t)pm * 256 + r) * 32 + hf * 16;
#pragma unroll
        for (int k = 0; k < 4; ++k) q[i][k] = *(const GAS f32x4*)(p + 4 * k); }
    __builtin_amdgcn_sched_barrier(0);
#pragma unroll
    for (int i = 0; i < RTAB_SLOTS; ++i) {
        const f32x4 a = q[i][0], b = q[i][1], c = q[i][2], d = q[i][3];
        float s = (((a.x + a.y) + (a.z + a.w)) + ((b.x + b.y) + (b.z + b.w))) + (((c.x + c.y) + (c.z + c.w)) + ((d.x + d.y) + (d.z + d.w)));
        s += __shfl_xor(s, 1);
        if (ok[i] && hf == 0) tab[i * 256 + r] = 1.0f / sqrtf(s * (1.0f / D) + EPS);
    }
    __syncthreads();
}
template <int NK> __device__ __forceinline__ void part_sum16(const float* PARTf, size_t eoff, size_t stride, f32x4 (&ps)[4]) {
    const bf16* pp = (const bf16*)PARTf + eoff; v4u a[NK], b[NK];
#pragma unroll
    for (int k = 0; k < NK; ++k) { a[k] = *(const GAS v4u*)(pp + (size_t)k * stride); b[k] = *(const GAS v4u*)(pp + (size_t)k * stride + 8); }
#pragma unroll
    for (int q = 0; q < 4; ++q) ps[q] = (f32x4){0.f, 0.f, 0.f, 0.f};
#pragma unroll
    for (int k = 0; k < NK; ++k) {
        ps[0] += (f32x4){__builtin_bit_cast(float, a[k].x << 16), __builtin_bit_cast(float, a[k].x & 0xffff0000u), __builtin_bit_cast(float, a[k].y << 16), __builtin_bit_cast(float, a[k].y & 0xffff0000u)};
        ps[1] += (f32x4){__builtin_bit_cast(float, a[k].z << 16), __builtin_bit_cast(float, a[k].z & 0xffff0000u), __builtin_bit_cast(float, a[k].w << 16), __builtin_bit_cast(float, a[k].w & 0xffff0000u)};
        ps[2] += (f32x4){__builtin_bit_cast(float, b[k].x << 16), __builtin_bit_cast(float, b[k].x & 0xffff0000u), __builtin_bit_cast(float, b[k].y << 16), __builtin_bit_cast(float, b[k].y & 0xffff0000u)};
        ps[3] += (f32x4){__builtin_bit_cast(float, b[k].z << 16), __builtin_bit_cast(float, b[k].z & 0xffff0000u), __builtin_bit_cast(float, b[k].w << 16), __builtin_bit_cast(float, b[k].w & 0xffff0000u)}; }
}
template <int NK> __device__ __forceinline__ void sample_reduce(Frame& F, const pg8::SplitOrder& S, unsigned* cnt, const float* res_s  , const float* oss  ) {
    constexpr int nK = NK;
    float* X = (float*)(F.ws + WS_X); bf16* XB = (bf16*)(F.ws + WS_HB); float* SSQ = (float*)(F.ws + WS_SSQ); const float* PART = (const float*)(F.ws + WS_PART);
    pg8::Unit u;
    if (!S.next(0, u)) return;
    asm volatile("s_waitcnt vmcnt(0)" ::: "memory"); __syncthreads();
    if (F.tid == 0) {
        __builtin_amdgcn_fence(__ATOMIC_RELEASE, "agent"); asm volatile("s_waitcnt vmcnt(0)" ::: "memory");
        for (int i = 0; S.next(i, u); ++i) (void)__hip_atomic_fetch_add(cnt + (u.pm * 8 + u.pn) * 64, 1u, __ATOMIC_RELAXED, __HIP_MEMORY_SCOPE_AGENT);
    }
    const int RS = (256 + nK - 1) / nK;
    for (int i = 0; S.next(i, u); ++i) {
        if (F.tid == 0) {
            unsigned* c = cnt + (u.pm * 8 + u.pn) * 64; unsigned sp = 0;
            while (__hip_atomic_load(c, __ATOMIC_RELAXED, __HIP_MEMORY_SCOPE_AGENT) < (unsigned)nK) { __builtin_amdgcn_s_sleep(1); if (++sp > (1u << 22)) break; }
            __builtin_amdgcn_fence(__ATOMIC_ACQUIRE, "agent"); asm volatile("s_waitcnt vmcnt(0)" ::: "memory");
        }
        __syncthreads();
        const int r0 = u.ks * RS, r1 = (r0 + RS) < 256 ? (r0 + RS) : 256;
        for (int rb = r0; rb < r1; rb += 32) {
            const int rl = rb + (F.tid >> 4); const int cc = (F.tid & 15) * 16;
            float s = 0.f;
            if (rl < r1) {
                const size_t srow = (size_t)u.pm * 256 + rl; const size_t off = srow * D + u.pn * 256 + cc;
                f32x4 x[4], ps[4]; float rsc = 1.0f;
                if (oss) { const float* op_ = oss + ((size_t)MP + srow) * 16; const f32x4 a_ = *(const GAS f32x4*)op_, b_ = *(const GAS f32x4*)(op_ + 4), c_ = *(const GAS f32x4*)(op_ + 8), d_ = *(const GAS f32x4*)(op_ + 12);
                    const float t_ = (((a_.x + a_.y) + (a_.z + a_.w)) + ((b_.x + b_.y) + (b_.z + b_.w))) + (((c_.x + c_.y) + (c_.z + c_.w)) + ((d_.x + d_.y) + (d_.z + d_.w))); rsc = 1.0f / sqrtf(t_ * (1.0f / D) + EPS); }
#pragma unroll
                for (int q = 0; q < 4; ++q) x[q] = *(const GAS f32x4*)(res_s + off + 4 * q);
                part_sum16<NK>(PART, off, (size_t)MS * D, ps);
#pragma unroll
                for (int q = 0; q < 4; ++q) x[q] += ps[q] * rsc;
#pragma unroll
                for (int q = 0; q < 4; ++q) { *(GAS f32x4*)(X + (size_t)MP * D + off + 4 * q) = x[q];
                    v2u w; w.x = pk2(x[q].x, x[q].y); w.y = pk2(x[q].z, x[q].w); *(GAS v2u*)(XB + (size_t)MP * D + off + 4 * q) = w;
                    s += (x[q].x * x[q].x + x[q].y * x[q].y) + (x[q].z * x[q].z + x[q].w * x[q].w); }
            }
            s = row16_sum(s);
            if (rl < r1 && (F.tid & 15) == 0) { float* sq = SSQ + ((size_t)MP + (size_t)u.pm * 256 + rl) * 32 + u.pn * 4; *(GAS f32x4*)sq = (f32x4){s, 0.f, 0.f, 0.f}; }
        }
    }
}
__device__ __forceinline__ void sample_reduce_rows(Frame& F, int nK) {
    float* X = (float*)(F.ws + WS_X); bf16* XB = (bf16*)(F.ws + WS_HB); float* SSQ = (float*)(F.ws + WS_SSQ); const float* PART = (const float*)(F.ws + WS_PART);
    const int gw = F.vcu * NWAVES + F.wave, NGW = F.G * NWAVES, lane = F.lane;
    for (int r = gw; r < MS; r += NGW) {
        f32x4 v[8]; float ss = 0.f;
#pragma unroll
        for (int j = 0; j < 8; ++j) v[j] = ((const GAS f32x4*)(X + (size_t)(MP + r) * D) + lane)[64 * j];
        for (int k = 0; k < nK; ++k) {
#pragma unroll
            for (int j = 0; j < 8; ++j) v[j] += ((const GAS f32x4*)(PART + (size_t)k * MS * D + (size_t)r * D) + lane)[64 * j]; }
#pragma unroll
        for (int j = 0; j < 8; ++j) { ((GAS f32x4*)(X + (size_t)(MP + r) * D) + lane)[64 * j] = v[j];
            v2u w; w.x = pk2(v[j].x, v[j].y); w.y = pk2(v[j].z, v[j].w); ((GAS v2u*)(XB + (size_t)(MP + r) * D) + lane)[64 * j] = w;
            ss += (v[j].x * v[j].x + v[j].y * v[j].y) + (v[j].z * v[j].z + v[j].w * v[j].w); }
        ss = wave_sum(ss);
        if (lane < 32) SSQ[(size_t)(MP + r) * 32 + lane] = lane == 0 ? ss : 0.f;
    }
}
template <int NK> __device__ __forceinline__ void sample_reduce_proj(Frame& F, const pg8::SplitOrder& S, unsigned* cnt, int Ncols, const float* bias) {
    constexpr int nK = NK;
    float* PROJ = (float*)(F.ws + WS_PROJ); const float* SSQ = (const float*)(F.ws + WS_SSQ); const float* PART = (const float*)(F.ws + WS_SCR);
    pg8::Unit u;
    if (!S.next(0, u)) return;
    asm volatile("s_waitcnt vmcnt(0)" ::: "memory"); __syncthreads();
    if (F.tid == 0) {
        __builtin_amdgcn_fence(__ATOMIC_RELEASE, "agent"); asm volatile("s_waitcnt vmcnt(0)" ::: "memory");
        for (int i = 0; S.next(i, u); ++i) (void)__hip_atomic_fetch_add(cnt + (u.pm * S.nN + u.pn) * 64, 1u, __ATOMIC_RELAXED, __HIP_MEMORY_SCOPE_AGENT);
    }
    const int RS = (256 + nK - 1) / nK;
    for (int i = 0; S.next(i, u); ++i) {
        if (F.tid == 0) {
            unsigned* c = cnt + (u.pm * S.nN + u.pn) * 64; unsigned sp = 0;
            while (__hip_atomic_load(c, __ATOMIC_RELAXED, __HIP_MEMORY_SCOPE_AGENT) < (unsigned)nK) { __builtin_amdgcn_s_sleep(1); if (++sp > (1u << 22)) break; }
            __builtin_amdgcn_fence(__ATOMIC_ACQUIRE, "agent"); asm volatile("s_waitcnt vmcnt(0)" ::: "memory");
        }
        __syncthreads();
        const int r0 = u.ks * RS, r1 = (r0 + RS) < 256 ? (r0 + RS) : 256;
        for (int rb = r0; rb < r1; rb += 32) {
            const int rl = rb + (F.tid >> 4); const int cc = (F.tid & 15) * 16;
            if (rl < r1) {
                const size_t srow = (size_t)u.pm * 256 + rl; const size_t col = (size_t)u.pn * 256 + cc;
                const float* sq = SSQ + ((size_t)MP + srow) * 32; float t_ = 0.f;
#pragma unroll
                for (int q = 0; q < 8; ++q) { const f32x4 a_ = *(const GAS f32x4*)(sq + 4 * q); t_ += (a_.x + a_.y) + (a_.z + a_.w); }
                const float rsc = 1.0f / sqrtf(t_ * (1.0f / D) + EPS);
                f32x4 ps[4], bq[4];
#pragma unroll
                for (int q = 0; q < 4; ++q) bq[q] = bias ? *(const GAS f32x4*)(bias + col + 4 * q) : (f32x4){0.f, 0.f, 0.f, 0.f};
                part_sum16<NK>(PART, (size_t)srow * Ncols + col, (size_t)MS * Ncols, ps);
#pragma unroll
                for (int q = 0; q < 4; ++q) { const f32x4 o = ps[q] * rsc + bq[q];
                    *(GAS f32x4*)(PROJ + ((size_t)MP + srow) * Ncols + col + 4 * q) = o; }
            }
        }
    }
}
typedef short bf16x8 __attribute__((ext_vector_type(8)));
typedef unsigned long long u64;
__device__ __forceinline__ bf16x8 mk_bf16x8(u64 lo, u64 hi) { typedef u64 u64x2 __attribute__((ext_vector_type(2))); u64x2 t; t.x = lo; t.y = hi; return __builtin_bit_cast(bf16x8, t); }
__device__ __forceinline__ bf16x8 pack8(const f32x4 a, const f32x4 b) { v4u w; w.x = pk2(a.x, a.y); w.y = pk2(a.z, a.w); w.z = pk2(b.x, b.y); w.w = pk2(b.z, b.w); return __builtin_bit_cast(bf16x8, w); }
#define MFMA16(a, b, c) __builtin_amdgcn_mfma_f32_16x16x32_bf16((a), (b), (c), 0, 0, 0)
__device__ __forceinline__ void hgrn_scan_mfma(Frame& F, int j, const float* lbp, const float* onorm, int item) {
    const float* proj = (const float*)(F.ws + WS_PROJ); bf16* OB = (bf16*)(F.ws + WS_OB); float* OSSQ = (float*)(F.ws + WS_OSSQ);
    LAS unsigned char* L = F.lds;
    const int tid = F.tid, lane = F.lane, w = F.wave;
    constexpr int CH = 32, NCH = SEQ / CH, QT = 0, KT = 8704, KH = 17408, VT = 27648, GG = 37888, PBUF = 38400, TOT = 76800;
    const int b = item >> 4, h = item & 15;
    const size_t row0 = (size_t)b * SEQ;
    const unsigned upk = (unsigned)(((w & 1) << 6) | lane);
    const int tq = w >> 1, pk = ((w & 1) << 6) | lane;
    const int lr = lane & 15, g = lane >> 4;
    const float lb = hgrn_lb(j, lbp, h * 128 + pk), omlb = 1.f - lb;
    const float on_ = onorm[h * 128 + 16 * w + lr];
    float gpre[8];
    constexpr int OSSL = 80896;
    float kv[8], qv[8], lc[8], vv[8], rf[8], rq[8], rv[8];
    f32x4 S[8];
#pragma unroll
    for (int i = 0; i < 8; ++i) S[i] = (f32x4){0.f, 0.f, 0.f, 0.f};
#define HG2_LOAD(c) do { _Pragma("unroll") for (int i = 0; i < 8; ++i) { const float* p_ = proj + (row0 + (c) * CH + 8 * tq + i) * 8192 + h * 128; rq[i] = p_[upk]; rf[i] = p_[2048u + upk]; rv[i] = p_[4096u + upk]; } } while (0)
#define HG2_P1(c) do { float run_ = 0.f; _Pragma("unroll") for (int i = 0; i < 8; ++i) { const float e_ = __expf(fminf(-rf[i], 80.f)), r_ = __builtin_amdgcn_rcpf(1.0f + e_); \
            kv[i] = omlb * e_ * r_; run_ += __builtin_amdgcn_logf(lb + omlb * r_); lc[i] = run_;     qv[i] = rq[i] * __builtin_amdgcn_rcpf(1.0f + __expf(fminf(-rq[i], 80.f))); vv[i] = rv[i]; } \
            *(LAS float*)(L + TOT + (((c) & 1) * 512 + tq * 128 + pk) * 4) = run_; } while (0)
#define HG2_P2(c) do { LAS unsigned char* P_ = L + ((c) & 1) * PBUF; const LAS float* T_ = (const LAS float*)(L + TOT + ((c) & 1) * 2048); \
            const float t0_ = T_[pk], t1_ = T_[128 + pk], t2_ = T_[256 + pk], t3_ = T_[384 + pk]; \
            const float off_ = tq == 0 ? 0.f : tq == 1 ? t0_ : tq == 2 ? t0_ + t1_ : t0_ + t1_ + t2_, bL_ = (t0_ + t1_) + (t2_ + t3_), gL_ = __builtin_amdgcn_exp2f(bL_); \
            float kh_[8]; _Pragma("unroll") for (int i = 0; i < 8; ++i) { const float b_ = off_ + lc[i]; \
                { const float x_ = qv[i] * __builtin_amdgcn_exp2f(b_); *(LAS unsigned short*)(P_ + QT + (8 * tq + i) * 272 + pk * 2) = (unsigned short)pk2(x_, x_); } \
                { const float x_ = kv[i] * __builtin_amdgcn_exp2f(fminf(-b_, 115.4f)); *(LAS unsigned short*)(P_ + KT + (8 * tq + i) * 272 + pk * 2) = (unsigned short)pk2(x_, x_); kh_[i] = x_ * gL_; } } \
            { v4u o_; o_.x = pk2(kh_[0], kh_[1]); o_.y = pk2(kh_[2], kh_[3]); o_.z = pk2(kh_[4], kh_[5]); o_.w = pk2(kh_[6], kh_[7]); *(LAS v4u*)(P_ + KH + pk * 80 + tq * 16) = o_; } \
            { v4u o_; o_.x = pk2(vv[0], vv[1]); o_.y = pk2(vv[2], vv[3]); o_.z = pk2(vv[4], vv[5]); o_.w = pk2(vv[6], vv[7]); *(LAS v4u*)(P_ + VT + pk * 80 + tq * 16) = o_; } \
            if (tq == 0) *(LAS float*)(P_ + GG + pk * 4) = gL_; } while (0)
#define HG2_M(n) do         { \
            const LAS unsigned char* P = L + (n & 1) * PBUF; \
            f32x4 at00 = (f32x4){0.f, 0.f, 0.f, 0.f}, at01 = at00, at11 = at00, o0 = at00, o1 = at00; \
_Pragma("unroll") \
            for (int kk = 0; kk < 4; ++kk) { \
                const bf16x8 a0 = *(const LAS bf16x8*)(P + KT + lr * 272 + kk * 64 + g * 16), a1 = *(const LAS bf16x8*)(P + KT + (16 + lr) * 272 + kk * 64 + g * 16); \
                const bf16x8 b0 = *(const LAS bf16x8*)(P + QT + lr * 272 + kk * 64 + g * 16), b1 = *(const LAS bf16x8*)(P + QT + (16 + lr) * 272 + kk * 64 + g * 16); \
                at00 = MFMA16(a0, b0, at00); at01 = MFMA16(a0, b1, at01); at11 = MFMA16(a1, b1, at11); \
                const bf16x8 sb = pack8(S[2 * kk], S[2 * kk + 1]); \
                const bf16x8 qa0 = mk_bf16x8(*(const LAS u64*)(P + QT + lr * 272 + kk * 64 + g * 8), *(const LAS u64*)(P + QT + lr * 272 + kk * 64 + 32 + g * 8)); \
                const bf16x8 qa1 = mk_bf16x8(*(const LAS u64*)(P + QT + (16 + lr) * 272 + kk * 64 + g * 8), *(const LAS u64*)(P + QT + (16 + lr) * 272 + kk * 64 + 32 + g * 8)); \
                o0 = MFMA16(qa0, sb, o0); o1 = MFMA16(qa1, sb, o1); \
            } \
_Pragma("unroll") \
            for (int r = 0; r < 4; ++r) { const bool keep = (4 * g + r) <= lr; at00[r] = keep ? at00[r] : 0.f; at11[r] = keep ? at11[r] : 0.f; } \
            const f32x4 zero4 = (f32x4){0.f, 0.f, 0.f, 0.f}; \
            const bf16x8 pa0 = pack8(at00, zero4), pa1 = pack8(at01, at11); \
            const int vcol = 16 * w + lr; \
            const bf16x8 vb = mk_bf16x8(*(const LAS u64*)(P + VT + vcol * 80 + g * 8), *(const LAS u64*)(P + VT + vcol * 80 + 32 + g * 8)); \
            o0 = MFMA16(pa0, vb, o0); o1 = MFMA16(pa1, vb, o1); \
            { const float* gp = proj + (row0 + n * CH + 4 * g) * 8192 + 6144 + h * 128 + vcol; bf16* ob = OB + (row0 + n * CH + 4 * g) * D + h * 128 + vcol; \
              LAS float* osl = (LAS float*)(L + OSSL) + (n & 1) * 256; \
_Pragma("unroll") \
              for (int r = 0; r < 4; ++r) { const float g0 = gpre[r], g1 = gpre[4 + r]; \
                const float y0 = o0[r] * on_ * __builtin_amdgcn_rcpf(1.0f + __expf(-g0)), y1 = o1[r] * on_ * __builtin_amdgcn_rcpf(1.0f + __expf(-g1)); \
                ob[(size_t)r * D] = (bf16)pk2(y0, y0); ob[(size_t)(16 + r) * D] = (bf16)pk2(y1, y1); \
                const float q0 = row16_sum(o0[r] * o0[r]), q1 = row16_sum(o1[r] * o1[r]); \
                if (lr == 0) { osl[(4 * g + r) * 8 + w] = q0; osl[(16 + 4 * g + r) * 8 + w] = q1; } } \
              if (n + 1 < NCH) { _Pragma("unroll") for (int r = 0; r < 4; ++r) { gpre[r] = gp[(size_t)(CH + r) * 8192]; gpre[4 + r] = gp[(size_t)(CH + 16 + r) * 8192]; } } } \
            const bf16x8 vn = *(const LAS bf16x8*)(P + VT + vcol * 80 + g * 16); \
_Pragma("unroll") \
            for (int kt = 0; kt < 8; ++kt) { \
                const f32x4 gk = *(const LAS f32x4*)(P + GG + (16 * kt + 4 * g) * 4); \
                const bf16x8 ka = *(const LAS bf16x8*)(P + KH + (16 * kt + lr) * 80 + g * 16); \
                S[kt] = MFMA16(ka, vn, S[kt] * gk); \
            } \
        } while (0)
    { const float* gp0 = proj + (row0 + 4 * g) * 8192 + 6144 + h * 128 + 16 * w + lr;
#pragma unroll
      for (int r = 0; r < 4; ++r) { gpre[r] = gp0[(size_t)r * 8192]; gpre[4 + r] = gp0[(size_t)(16 + r) * 8192]; } }
    __syncthreads();
    HG2_LOAD(0); HG2_P1(0); __syncthreads();
    HG2_P2(0); HG2_LOAD(1); HG2_P1(1); HG2_LOAD(2); __syncthreads();
    for (int n = 0; n < NCH; ++n) {
        if (SCAN_FIRST(w)) { __builtin_amdgcn_s_setprio(SCAN_PRIO); HG2_M(n); __builtin_amdgcn_s_setprio(0); }
        if (n >= 1 && tid < 32) { const LAS float* osl = (const LAS float*)(L + OSSL) + ((n - 1) & 1) * 256 + tid * 8; const f32x4 a_ = *(const LAS f32x4*)osl, b_ = *(const LAS f32x4*)(osl + 4);
            OSSQ[(row0 + (n - 1) * CH + tid) * 16 + h] = ((a_.x + a_.y) + (a_.z + a_.w)) + ((b_.x + b_.y) + (b_.z + b_.w)); }
        if (n + 1 < NCH) HG2_P2(n + 1);
        if (n + 2 < NCH) HG2_P1(n + 2);
        if (n + 3 < NCH) HG2_LOAD(n + 3);
        if (!SCAN_FIRST(w)) { __builtin_amdgcn_s_setprio(SCAN_PRIO); HG2_M(n); __builtin_amdgcn_s_setprio(0); }
        __syncthreads();
    }
#undef HG2_M
    if (tid < 32) { const LAS float* osl = (const LAS float*)(L + OSSL) + ((NCH - 1) & 1) * 256 + tid * 8; const f32x4 a_ = *(const LAS f32x4*)osl, b_ = *(const LAS f32x4*)(osl + 4);
        OSSQ[(row0 + (NCH - 1) * CH + tid) * 16 + h] = ((a_.x + a_.y) + (a_.z + a_.w)) + ((b_.x + b_.y) + (b_.z + b_.w)); }
    float* So = F.out + O_SP + ((size_t)(j * NB + b) * 16 + h) * 16384 + 16 * w + lr;
#pragma unroll
    for (int kt = 0; kt < 8; ++kt)
#pragma unroll
        for (int r = 0; r < 4; ++r) So[(size_t)(16 * kt + 4 * g + r) * 128] = S[kt][r];
#undef HG2_LOAD
#undef HG2_P1
#undef HG2_P2
}
__device__ __forceinline__ void hgrn_sample(Frame& F, int j, const float* lbp, const float* onorm, const float* S_in, int it0, int itstep) {
    const float* proj = (const float*)(F.ws + WS_PROJ); bf16* OB = (bf16*)(F.ws + WS_OB); float* OSSQ = (float*)(F.ws + WS_OSSQ);
    LAS float* L = (LAS float*)F.lds;
    const int tid = F.tid;
    {
        constexpr int SF = 0, SK = 512, SQ = 1024, SV = 1536, RED = 2048;
        const int v4 = tid & 31, kb = tid >> 5;
        for (int it = it0; it < DB * 16; it += itstep) {
            const int b = it >> 4, h = it & 15;
            __syncthreads();
            const float* S0 = S_in + ((size_t)(j * DB + b) * 16 + h) * 16384;
            f32x4 S[8];
#pragma unroll
            for (int i = 0; i < 8; ++i) S[i] = *(const GAS f32x4*)(S0 + (kb + 16 * i) * 128 + v4 * 4);
            { const int tok = tid >> 7, c = tid & 127; const size_t row = MP + b * DSQ + tok;
              const float fp = proj[row * 8192 + 2048 + h * 128 + c], qr = proj[row * 8192 + h * 128 + c], vr = proj[row * 8192 + 4096 + h * 128 + c];
              const float lb = hgrn_lb(j, lbp, h * 128 + c);
              L[SF + tid] = lb + (1.f - lb) * sigm(fp); L[SK + tid] = (1.f - lb) * sigm(-fp); L[SQ + tid] = qr * sigm(qr); L[SV + tid] = vr; }
            __syncthreads();
#pragma unroll
            for (int tok = 0; tok < DSQ; ++tok) {
                const f32x4 vv = *(const LAS f32x4*)(L + SV + tok * 128 + v4 * 4);
                f32x4 o = (f32x4){0.f, 0.f, 0.f, 0.f};
#pragma unroll
                for (int i = 0; i < 8; ++i) { const int k = kb + 16 * i; const float fk = L[SF + tok * 128 + k], kk = L[SK + tok * 128 + k], qq = L[SQ + tok * 128 + k];
                    S[i] = S[i] * fk + vv * kk; o += S[i] * qq; }
                *(LAS f32x4*)(L + RED + ((tok * 16 + kb) * 32 + v4) * 4) = o;
            }
            __syncthreads();
            { const int tok = tid >> 7, v = tid & 127; float s = 0.f;
#pragma unroll
              for (int k2 = 0; k2 < 16; ++k2) s += L[RED + (tok * 16 + k2) * 128 + v];
              const size_t row = MP + b * DSQ + tok; const float gg = proj[row * 8192 + 6144 + h * 128 + v];
              const float y = s * onorm[h * 128 + v] * __builtin_amdgcn_rcpf(1.0f + __expf(-gg)); OB[row * D + h * 128 + v] = (bf16)pk2(y, y);
              const float q = wave_sum(s * s); if (F.lane == 0) L[SF + F.wave] = q; }
            __syncthreads();
            if (tid < DSQ) OSSQ[(size_t)(MP + b * DSQ + tid) * 16 + h] = L[SF + 2 * tid] + L[SF + 2 * tid + 1];
            float* So = F.out + O_SS + ((size_t)(j * DB + b) * 16 + h) * 16384;
#pragma unroll
            for (int i = 0; i < 8; ++i) *(GAS f32x4*)(So + (kb + 16 * i) * 128 + v4 * 4) = S[i];
        }
    }
}
__device__ __forceinline__ void hgrn_scan(Frame& F, int j, const float* lbp, const float* onorm, const float* S_in, int part = 3) {
    const int bx = blockIdx.x, G = F.G;
    if (G > 64) { if (bx < 64) { if (part & 1) hgrn_scan_mfma(F, j, lbp, onorm, bx); } else if (part & 2) hgrn_sample(F, j, lbp, onorm, S_in, bx - 64, G - 64); }
    else { for (int it = bx; it < 64; it += G) hgrn_scan_mfma(F, j, lbp, onorm, it); hgrn_sample(F, j, lbp, onorm, S_in, bx, G); }
}
__device__ __forceinline__ void hgrn_post(Frame& F, const float* onorm) {
    const float* proj = (const float*)(F.ws + WS_PROJ); const float* scr = (const float*)(F.ws + WS_SCR); bf16* OB = (bf16*)(F.ws + WS_OB);
    const int gw = F.vcu * NWAVES + F.wave, NGW = F.G * NWAVES, lane = F.lane;
    for (int m = gw; m < M; m += NGW) {
        const GAS f32x4* xr = (const GAS f32x4*)(scr + (size_t)m * D) + lane; const GAS f32x4* gr = (const GAS f32x4*)(proj + (size_t)m * 8192 + 6144) + lane; const GAS f32x4* nr = (const GAS f32x4*)onorm + lane;
        f32x4 v[8]; float ss = 0.f;
#pragma unroll
        for (int j = 0; j < 8; ++j) { v[j] = xr[64 * j]; ss += (v[j].x * v[j].x + v[j].y * v[j].y) + (v[j].z * v[j].z + v[j].w * v[j].w); }
        const float rstd = 1.0f / sqrtf(wave_sum(ss) * (1.0f / D) + EPS);
        GAS v2u* ho = (GAS v2u*)(OB + (size_t)m * D) + lane;
#pragma unroll
        for (int j = 0; j < 8; ++j) { const f32x4 g = gr[64 * j], nn = nr[64 * j]; f32x4 o;
#pragma unroll
            for (int e = 0; e < 4; ++e) o[e] = v[j][e] * rstd * nn[e] * sigm(g[e]);
            v2u w; w.x = pk2(o.x, o.y); w.y = pk2(o.z, o.w); ho[64 * j] = w; }
    }
}
__device__ __forceinline__ void mlstm_scan_mfma(Frame& F, int item) {
    const float* proj = (const float*)(F.ws + WS_PROJ); float* scr = (float*)(F.ws + WS_SCR); const float* GATES = (const float*)(F.ws + WS_GATES); float* DENM = (float*)(F.ws + WS_DENM);
    LAS unsigned char* L = F.lds;
    const int tid = F.tid, lane = F.lane, w = F.wave;
    constexpr int CH = 32, NCH = SEQ / CH, PW = 6144, QT = 0, KT = 8704, KH = 17408, VT = 27648, PBUF = 37888, SCAL = 75776, SCSZ = 640;
    const int b = item >> 4, h = (item >> 1) & 7, vh = item & 1;
    const size_t row0 = (size_t)b * SEQ;
    const unsigned upk = (unsigned)(((w & 1) << 6) | lane);
    const int tq = w >> 1, pk = ((w & 1) << 6) | lane;
    const int lr = lane & 15, g = lane >> 4;
    const bool nwave = (vh == 0 && w == 7);
    float rk[8], rq[8], rv[8], rig = 0.f, rlf = 0.f, m_prev = 0.f;
    f32x4 C[8], N[8];
#pragma unroll
    for (int i = 0; i < 8; ++i) { C[i] = (f32x4){0.f, 0.f, 0.f, 0.f}; N[i] = (f32x4){0.f, 0.f, 0.f, 0.f}; }
    const bf16x8 ones = (lr == 0) ? (bf16x8){0x3F80, 0x3F80, 0x3F80, 0x3F80, 0x3F80, 0x3F80, 0x3F80, 0x3F80} : (bf16x8){0, 0, 0, 0, 0, 0, 0, 0};
#define ML2_LOAD(c) do { _Pragma("unroll") for (int i = 0; i < 8; ++i) { const float* p_ = proj + (row0 + (c) * CH + 8 * tq + i) * PW + h * 128; rq[i] = p_[upk]; rk[i] = p_[1024u + upk]; rv[i] = p_[(unsigned)(2048 + h * 128 + vh * 128) + upk]; } \
            } while (0)
#define ML2_GLOAD(c) do { if (w == 0 && lane < 32) { const size_t rg_ = row0 + (c) * CH + lane; rig = GATES[rg_ * 16 + h]; rlf = GATES[rg_ * 16 + 8 + h]; } } while (0)
#define ML2_P1(c) do { if (w == 0) { float bt_ = rlf; _Pragma("unroll") for (int d_ = 1; d_ < 32; d_ <<= 1) { const float t_ = __shfl_up(bt_, d_); if (lane >= d_) bt_ += t_; } \
                const float u_ = rig - bt_; float pm_ = u_; _Pragma("unroll") for (int d_ = 1; d_ < 32; d_ <<= 1) { const float t_ = __shfl_up(pm_, d_); if (lane >= d_) pm_ = fmaxf(pm_, t_); } \
                const float mt_ = fmaxf(bt_ + m_prev, bt_ + pm_); const float bL_ = __shfl(bt_, 31), mL_ = __shfl(mt_, 31); \
                LAS float* S_ = (LAS float*)(L + SCAL + ((c) & 3) * SCSZ); \
                if (lane < 32) { S_[lane] = u_; S_[32 + lane] = bt_ - mt_; S_[64 + lane] = __expf(bt_ + m_prev - mt_); S_[96 + lane] = __expf(u_ + bL_ - mL_); \
                    if (vh == 0) DENM[(row0 + (c) * CH + lane) * 16 + 8 + h] = mt_; } \
                if (lane == 0) S_[128] = __expf(bL_ + m_prev - mL_); \
                m_prev = mL_; } } while (0)
#define ML2_P2(c) do { LAS unsigned char* P_ = L + ((c) & 1) * PBUF; const LAS float* S_ = (const LAS float*)(L + SCAL + ((c) & 3) * SCSZ); \
            float kh_[8]; _Pragma("unroll") for (int i = 0; i < 8; ++i) { \
                *(LAS unsigned short*)(P_ + QT + (8 * tq + i) * 272 + pk * 2) = (unsigned short)pk2(rq[i], rq[i]); \
                *(LAS unsigned short*)(P_ + KT + (8 * tq + i) * 272 + pk * 2) = (unsigned short)pk2(rk[i], rk[i]); \
                kh_[i] = rk[i] * S_[96 + 8 * tq + i]; } \
            { v4u o_; o_.x = pk2(kh_[0], kh_[1]); o_.y = pk2(kh_[2], kh_[3]); o_.z = pk2(kh_[4], kh_[5]); o_.w = pk2(kh_[6], kh_[7]); *(LAS v4u*)(P_ + KH + pk * 80 + tq * 16) = o_; } \
            { v4u o_; o_.x = pk2(rv[0], rv[1]); o_.y = pk2(rv[2], rv[3]); o_.z = pk2(rv[4], rv[5]); o_.w = pk2(rv[6], rv[7]); *(LAS v4u*)(P_ + VT + pk * 80 + tq * 16) = o_; } } while (0)
#define ML2_TILE(St, vb_, vn_, o0_, o1_) do { \
            _Pragma("unroll") for (int kk = 0; kk < 4; ++kk) { const bf16x8 sb_ = pack8(St[2 * kk], St[2 * kk + 1]); \
                const bf16x8 qa0_ = mk_bf16x8(*(const LAS u64*)(P + QT + lr * 272 + kk * 64 + g * 8), *(const LAS u64*)(P + QT + lr * 272 + kk * 64 + 32 + g * 8)); \
                const bf16x8 qa1_ = mk_bf16x8(*(const LAS u64*)(P + QT + (16 + lr) * 272 + kk * 64 + g * 8), *(const LAS u64*)(P + QT + (16 + lr) * 272 + kk * 64 + 32 + g * 8)); \
                o0_ = MFMA16(qa0_, sb_, o0_); o1_ = MFMA16(qa1_, sb_, o1_); } \
            o0_ = o0_ * sc0; o1_ = o1_ * sc1; \
            o0_ = MFMA16(pa0, vb_, o0_); o1_ = MFMA16(pa1, vb_, o1_); __builtin_amdgcn_sched_barrier(0); \
            _Pragma("unroll") for (int kt = 0; kt < 8; ++kt) { const bf16x8 ka_ = *(const LAS bf16x8*)(P + KH + (16 * kt + lr) * 80 + g * 16); St[kt] = MFMA16(ka_, vn_, St[kt] * scst); } } while (0)
#define ML2_M(n) do { const LAS unsigned char* P = L + ((n) & 1) * PBUF; const LAS float* SC_ = (const LAS float*)(L + SCAL + ((n) & 3) * SCSZ); \
            f32x4 at00 = (f32x4){0.f, 0.f, 0.f, 0.f}, at01 = at00, at11 = at00; \
            _Pragma("unroll") for (int kk = 0; kk < 4; ++kk) { \
                const bf16x8 a0 = *(const LAS bf16x8*)(P + KT + lr * 272 + kk * 64 + g * 16), a1 = *(const LAS bf16x8*)(P + KT + (16 + lr) * 272 + kk * 64 + g * 16); \
                const bf16x8 b0 = *(const LAS bf16x8*)(P + QT + lr * 272 + kk * 64 + g * 16), b1 = *(const LAS bf16x8*)(P + QT + (16 + lr) * 272 + kk * 64 + g * 16); \
                at00 = MFMA16(a0, b0, at00); at01 = MFMA16(a0, b1, at01); at11 = MFMA16(a1, b1, at11); } \
            { const f32x4 u0 = *(const LAS f32x4*)(SC_ + 4 * g), u1 = *(const LAS f32x4*)(SC_ + 16 + 4 * g); const float w0 = SC_[32 + lr], w1 = SC_[48 + lr]; \
              _Pragma("unroll") for (int r = 0; r < 4; ++r) { const bool keep = (4 * g + r) <= lr; \
                at00[r] = keep ? at00[r] * __expf(u0[r] + w0) : 0.f; at01[r] = at01[r] * __expf(u0[r] + w1); at11[r] = keep ? at11[r] * __expf(u1[r] + w1) : 0.f; } } \
            const f32x4 zero4 = (f32x4){0.f, 0.f, 0.f, 0.f}; \
            const bf16x8 pa0 = pack8(at00, zero4), pa1 = pack8(at01, at11); __builtin_amdgcn_sched_barrier(0); \
            const f32x4 sc0 = *(const LAS f32x4*)(SC_ + 64 + 4 * g), sc1 = *(const LAS f32x4*)(SC_ + 80 + 4 * g); const float scst = SC_[128]; \
            const int vcol = 16 * w + lr; \
            { const bf16x8 vb = mk_bf16x8(*(const LAS u64*)(P + VT + vcol * 80 + g * 8), *(const LAS u64*)(P + VT + vcol * 80 + 32 + g * 8)); \
              const bf16x8 vn = *(const LAS bf16x8*)(P + VT + vcol * 80 + g * 16); \
              f32x4 o0 = zero4, o1 = zero4; \
              ML2_TILE(C, vb, vn, o0, o1); \
              float* op = scr + (row0 + (n) * CH + 4 * g) * D + h * 256 + vh * 128 + vcol; \
              _Pragma("unroll") for (int r = 0; r < 4; ++r) { op[(size_t)r * D] = o0[r]; op[(size_t)(16 + r) * D] = o1[r]; } } \
            __builtin_amdgcn_sched_barrier(0); \
            if (nwave) { f32x4 o0 = zero4, o1 = zero4; \
              ML2_TILE(N, ones, ones, o0, o1); \
              if (lr == 0) { float* dp = DENM + (row0 + (n) * CH + 4 * g) * 16 + h; \
                _Pragma("unroll") for (int r = 0; r < 4; ++r) { dp[(size_t)r * 16] = o0[r]; dp[(size_t)(16 + r) * 16] = o1[r]; } } } } while (0)
    __syncthreads();
    ML2_GLOAD(0); ML2_P1(0); ML2_GLOAD(1); ML2_LOAD(0); __syncthreads();
    ML2_P2(0); ML2_LOAD(1); ML2_P1(1); ML2_GLOAD(2); __syncthreads();
    for (int n = 0; n < NCH; ++n) {
        if (SCAN_FIRST(w)) { __builtin_amdgcn_s_setprio(SCAN_PRIO); ML2_M(n); __builtin_amdgcn_s_setprio(0); }
        if (n + 1 < NCH) { ML2_P2(n + 1); }
        if (n + 2 < NCH) { ML2_LOAD(n + 2); ML2_P1(n + 2); }
        if (n + 3 < NCH) { ML2_GLOAD(n + 3); }
        if (!SCAN_FIRST(w)) { __builtin_amdgcn_s_setprio(SCAN_PRIO); ML2_M(n); __builtin_amdgcn_s_setprio(0); }
        __syncthreads();
    }
#undef ML2_GLOAD
    float* Co = F.out + O_CP + ((size_t)(b * 8 + h) * 128) * 256 + vh * 128 + 16 * w + lr;
#pragma unroll
    for (int kt = 0; kt < 8; ++kt)
#pragma unroll
        for (int r = 0; r < 4; ++r) Co[(size_t)(16 * kt + 4 * g + r) * 256] = C[kt][r];
    if (nwave && lr == 0) {
#pragma unroll
        for (int kt = 0; kt < 8; ++kt)
#pragma unroll
            for (int r = 0; r < 4; ++r) F.out[O_NP + (size_t)(b * 8 + h) * 128 + 16 * kt + 4 * g + r] = N[kt][r]; }
    if (vh == 0 && w == 0 && lane == 0) F.out[O_MP + b * 8 + h] = m_prev;
#undef ML2_LOAD
#undef ML2_P1
#undef ML2_P2
#undef ML2_TILE
#undef ML2_M
}
__device__ __forceinline__ void mlstm_sample(Frame& F, const float* C_in, const float* n_in, const float* m_in, int it0, int itstep) {
    const float* proj = (const float*)(F.ws + WS_PROJ); float* scr = (float*)(F.ws + WS_SCR); const float* GATES = (const float*)(F.ws + WS_GATES); float* DENM = (float*)(F.ws + WS_DENM);
    LAS float* L = (LAS float*)F.lds;
    const int tid = F.tid, lane = F.lane, wave = F.wave;
    constexpr int PW = 6144;
    {
        constexpr int SK = 0, SQ = 512, SV = 1024, SG = 2048, DD = 2064, EM = 2072, RED = 2080;
        const int v4 = tid & 63, kb = tid >> 6;
        for (int it = it0; it < DB * 8; it += itstep) {
            const int b = it >> 3, h = it & 7;
            __syncthreads();
            const float* C0 = C_in + ((size_t)(b * 8 + h) * 128) * 256;
            f32x4 C[16];
#pragma unroll
            for (int i = 0; i < 16; ++i) C[i] = *(const GAS f32x4*)(C0 + (kb + 8 * i) * 256 + v4 * 4);
            float nn = (tid < 128) ? n_in[(size_t)(b * 8 + h) * 128 + tid] : 0.f;
            float m = m_in[b * 8 + h];
            { const int tok = tid >> 7, c = tid & 127; const size_t row = MP + b * DSQ + tok;
              L[SK + tid] = proj[row * PW + 1024 + h * 128 + c]; L[SQ + tid] = proj[row * PW + h * 128 + c];
#pragma unroll
              for (int r = 0; r < 2; ++r) { const int idx = tid + 512 * r, tk = idx >> 8, cc = idx & 255; L[SV + idx] = proj[(size_t)(MP + b * DSQ + tk) * PW + 2048 + h * 256 + cc]; }
              if (tid < 4) { L[SG + tid] = GATES[(size_t)(MP + b * DSQ + tid) * 16 + h]; L[SG + 4 + tid] = GATES[(size_t)(MP + b * DSQ + tid) * 16 + 8 + h]; } }
            __syncthreads();
#pragma unroll
            for (int tok = 0; tok < DSQ; ++tok) {
                const float ig = L[SG + tok], lf = L[SG + 4 + tok];
                const float mn = fmaxf(lf + m, ig), a = __expf(lf + m - mn), bb = __expf(ig - mn); m = mn;
                const f32x4 vv = *(const LAS f32x4*)(L + SV + tok * 256 + v4 * 4);
                f32x4 o = (f32x4){0.f, 0.f, 0.f, 0.f};
#pragma unroll
                for (int i = 0; i < 16; ++i) { const int k = kb + 8 * i; const float kk = bb * L[SK + tok * 128 + k], qq = L[SQ + tok * 128 + k];
                    C[i] = C[i] * a + vv * kk; o += C[i] * qq; }
                *(LAS f32x4*)(L + RED + ((tok * 8 + kb) * 64 + v4) * 4) = o;
                if (tid < 128) { nn = a * nn + bb * L[SK + tok * 128 + tid]; const float p = wave_sum(nn * L[SQ + tok * 128 + tid]); if (lane == 0) L[DD + tok * 2 + wave] = p; }
                if (tid == 0) L[EM + tok] = __expf(-m);
            }
            __syncthreads();
#pragma unroll
            for (int r = 0; r < 2; ++r) { const int idx = tid + 512 * r, tok = idx >> 8, v = idx & 255; float s = 0.f;
#pragma unroll
                for (int k2 = 0; k2 < 8; ++k2) s += L[RED + (tok * 8 + k2) * 256 + v];
                const float den = L[DD + tok * 2] + L[DD + tok * 2 + 1];
                scr[(size_t)(MP + b * DSQ + tok) * D + h * 256 + v] = s / fmaxf(fabsf(den), L[EM + tok]); }
            float* Co = F.out + O_CS + ((size_t)(b * 8 + h) * 128) * 256;
#pragma unroll
            for (int i = 0; i < 16; ++i) *(GAS f32x4*)(Co + (kb + 8 * i) * 256 + v4 * 4) = C[i];
            if (tid < 128) F.out[O_NS + (size_t)(b * 8 + h) * 128 + tid] = nn;
            if (tid == 0) F.out[O_MS + b * 8 + h] = m;
            if (tid < DSQ) { DENM[(size_t)(MP + b * DSQ + tid) * 16 + h] = 1.0f; DENM[(size_t)(MP + b * DSQ + tid) * 16 + 8 + h] = 0.0f; }
        }
    }
}
__device__ __forceinline__ void mlstm_scan(Frame& F, const float* C_in, const float* n_in, const float* m_in) {
    const int bx = blockIdx.x, G = F.G;
    if (G > 64) { if (bx < 64) mlstm_scan_mfma(F, bx); else mlstm_sample(F, C_in, n_in, m_in, bx - 64, G - 64); }
    else { for (int it = bx; it < 64; it += G) mlstm_scan_mfma(F, it); mlstm_sample(F, C_in, n_in, m_in, bx, G); }
}
__device__ __forceinline__ void mlstm_post(Frame& F, const float* hnorm) {
    const float* proj = (const float*)(F.ws + WS_PROJ); const float* scr = (const float*)(F.ws + WS_SCR); bf16* OB = (bf16*)(F.ws + WS_OB); const float* DENM = (const float*)(F.ws + WS_DENM);
    const int gw = F.vcu * NWAVES + F.wave, NGW = F.G * NWAVES, lane = F.lane;
    for (int m = gw; m < M; m += NGW) {
        const GAS f32x4* xr = (const GAS f32x4*)(scr + (size_t)m * D) + lane; const GAS f32x4* gr = (const GAS f32x4*)(proj + (size_t)m * 6144 + 4096) + lane; const GAS f32x4* nr = (const GAS f32x4*)hnorm + lane;
        GAS v2u* ho = (GAS v2u*)(OB + (size_t)m * D) + lane;
        const float dm = DENM[(size_t)m * 16 + (lane & 15)];
        f32x4 xv[8], gv[8], nv[8];
#pragma unroll
        for (int j = 0; j < 8; ++j) { xv[j] = xr[64 * j]; gv[j] = gr[64 * j]; nv[j] = nr[64 * j]; }
        float ss[8];
#pragma unroll
        for (int j = 0; j < 8; ++j) {
            const float den_ = __builtin_bit_cast(float, __builtin_amdgcn_readlane(__builtin_bit_cast(int, dm), j)), mt_ = __builtin_bit_cast(float, __builtin_amdgcn_readlane(__builtin_bit_cast(int, dm), 8 + j));
            const float dn = 1.0f / fmaxf(fabsf(den_), __expf(-mt_));
            xv[j] = xv[j] * dn; ss[j] = (xv[j].x * xv[j].x + xv[j].y * xv[j].y) + (xv[j].z * xv[j].z + xv[j].w * xv[j].w); }
#pragma unroll
        for (int o = 1; o < 64; o <<= 1) {
#pragma unroll
            for (int j = 0; j < 8; ++j) ss[j] += __shfl_xor(ss[j], o); }
#pragma unroll
        for (int j = 0; j < 8; ++j) {
            const float rstd = 1.0f / sqrtf(ss[j] * (1.0f / 256.0f) + EPS);
            const f32x4 v = xv[j], g = gv[j], nn = nv[j]; f32x4 o;
#pragma unroll
            for (int e = 0; e < 4; ++e) o[e] = v[e] * rstd * nn[e] * sigm(g[e]);
            v2u w; w.x = pk2(o.x, o.y); w.y = pk2(o.z, o.w); ho[64 * j] = w; }
    }
}

__device__ __forceinline__ float gelu_erf(float v) {
    const float av = fabsf(v), t = __builtin_amdgcn_rcpf(av * 0.2316418882f + 1.0f);
    float q = t * 0.5307027145f + (-0.7265760135f); q = q * t + 0.7107068705f; q = q * t + (-0.142248368f); q = q * t + 0.127414796f; q = q * t;
    const float m = v * (q * __builtin_amdgcn_exp2f((v * v) * (-0.72134752044f)));
    return v < 0.f ? m : v - m;
}
__device__ __forceinline__ void gmlp_a(Frame& F, const float* vg, const float* vb) {
    float* proj = (float*)(F.ws + WS_PROJ); float* scr = (float*)(F.ws + WS_SCR);
    const int gw = F.vcu * NWAVES + F.wave, NGW = F.G * NWAVES, lane = F.lane;
    for (int m = gw; m < M; m += NGW) {
        const GAS f32x4* zr = (const GAS f32x4*)(proj + (size_t)m * 4096 + 2048) + lane;
        f32x4 v[8]; float s = 0.f;
#pragma unroll
        for (int j = 0; j < 8; ++j) v[j] = zr[64 * j];
        __builtin_amdgcn_sched_barrier(0);
#pragma unroll
        for (int j = 0; j < 8; ++j) { const f32x4 z = v[j];
#pragma unroll
            for (int e = 0; e < 4; ++e) v[j][e] = gelu_erf(z[e]);
            s += (v[j].x + v[j].y) + (v[j].z + v[j].w); }
        const float mean = wave_sum(s) * (1.0f / D); float s2 = 0.f;
#pragma unroll
        for (int j = 0; j < 8; ++j) { v[j] = v[j] - mean; s2 += (v[j].x * v[j].x + v[j].y * v[j].y) + (v[j].z * v[j].z + v[j].w * v[j].w); }
        const float rstd = 1.0f / sqrtf(wave_sum(s2) * (1.0f / D) + EPS);
        GAS v2u* so = (GAS v2u*)((bf16*)scr + (size_t)m * D) + lane; const GAS f32x4* g4 = (const GAS f32x4*)vg + lane; const GAS f32x4* b4 = (const GAS f32x4*)vb + lane;
        f32x4 gq[8], bq[8];
#pragma unroll
        for (int j = 0; j < 8; ++j) { gq[j] = g4[64 * j]; bq[j] = b4[64 * j]; }
#pragma unroll
        for (int j = 0; j < 8; ++j) { const f32x4 o = v[j] * rstd * gq[j] + bq[j];
            if (m < MP) { v2u w_; w_.x = pk2(o.x, o.y); w_.y = pk2(o.z, o.w); so[64 * j] = w_; }
            else ((GAS f32x4*)(F.out + O_VS + (size_t)(m - MP) * D) + lane)[64 * j] = o; }
    }
}
__device__ __forceinline__ void gmlp_b(Frame& F, const float* w_s, const float* b_s) {
    const float* proj = (const float*)(F.ws + WS_PROJ); const float* scr = (const float*)(F.ws + WS_SCR); bf16* OB = (bf16*)(F.ws + WS_OB);
    LAS unsigned char* L = F.lds;
    const int tid = F.tid, lane = F.lane, w = F.wave, lr = lane & 15, g4 = lane >> 4;
    constexpr int WB_ = 0, VT_ = 34816, RS = 272;
    for (int it = F.vcu; it < NB * 16 * 16; it += F.G) {
        const int g = it & 15, n = (it >> 4) & 15, b = it >> 8;
        const size_t row0 = (size_t)b * SEQ + n * 128;
        __syncthreads();
        f32x4 wvv[8];
#pragma unroll
        for (int i = 0; i < 8; ++i) { const int idx = tid + 512 * i, tr = idx >> 5, s4 = idx & 31; wvv[i] = *(const GAS f32x4*)(w_s + (size_t)g * 16384 + tr * 128 + s4 * 4); }
#pragma unroll
        for (int i = 0; i < 8; ++i) { const int idx = tid + 512 * i, tr = idx >> 5, s4 = idx & 31;
            const f32x4 wv = wvv[i]; f32x4 m;
#pragma unroll
            for (int e = 0; e < 4; ++e) m[e] = (s4 * 4 + e <= tr) ? wv[e] : 0.f;
            v2u o; o.x = pk2(m.x, m.y); o.y = pk2(m.z, m.w); *(LAS v2u*)(L + WB_ + tr * RS + s4 * 8) = o; }
        { const int d = tid & 127, sq = tid >> 7;
#pragma unroll
          for (int k8 = 0; k8 < 4; ++k8) { unsigned x[8];
#pragma unroll
            for (int e = 0; e < 8; ++e) x[e] = ((const bf16*)scr)[(row0 + 32 * sq + 8 * k8 + e) * D + g * 128 + d];
            v4u o; o.x = x[0] | (x[1] << 16); o.y = x[2] | (x[3] << 16); o.z = x[4] | (x[5] << 16); o.w = x[6] | (x[7] << 16);
            *(LAS v4u*)(L + VT_ + d * RS + (32 * sq + 8 * k8) * 2) = o; } }
        __syncthreads();
        f32x4 acc[8];
#pragma unroll
        for (int di = 0; di < 8; ++di) acc[di] = (f32x4){0.f, 0.f, 0.f, 0.f};
        const int nks = (16 * w + 15) / 32 + 1;
        for (int ks = 0; ks < nks; ++ks) {
            const bf16x8 a = *(const LAS bf16x8*)(L + WB_ + (16 * w + lr) * RS + ks * 64 + g4 * 16);
#pragma unroll
            for (int di = 0; di < 8; ++di) { const bf16x8 bb = *(const LAS bf16x8*)(L + VT_ + (16 * di + lr) * RS + ks * 64 + g4 * 16); acc[di] = MFMA16(a, bb, acc[di]); }
        }
        float uu[4][8], bsr[4];
#pragma unroll
        for (int r = 0; r < 4; ++r) { const int tt = 16 * w + 4 * g4 + r; bsr[r] = b_s[g * 128 + tt];
#pragma unroll
            for (int di = 0; di < 8; ++di) uu[r][di] = proj[(row0 + tt) * 4096 + g * 128 + 16 * di + lr]; }
#pragma unroll
        for (int r = 0; r < 4; ++r) { const int tt = 16 * w + 4 * g4 + r; const size_t row = row0 + tt;
#pragma unroll
            for (int di = 0; di < 8; ++di) { const int d = 16 * di + lr; const float o = (acc[di][r] + bsr[r]) * gelu_erf(uu[r][di]);
                OB[row * D + g * 128 + d] = (bf16)pk2(o, o); } }
    }
    for (int it = F.vcu * NTHR + tid; it < MS * (D / 4); it += F.G * NTHR) {
        const int r = it >> 9, c4 = it & 511, b = r >> 2, t = r & 3, c = c4 * 4, g = c >> 7;
        f32x4 mix; { const float bs = b_s[g * 128 + t]; mix = (f32x4){bs, bs, bs, bs}; }
        { f32x4 vr[DSQ]; float ws_[DSQ];
#pragma unroll
          for (int s = 0; s < DSQ; ++s) { vr[s] = *(const GAS f32x4*)(F.out + O_VS + (size_t)(b * DSQ + s) * D + c); ws_[s] = w_s[(size_t)g * 16384 + t * 128 + s]; }
#pragma unroll
          for (int s = 0; s < DSQ; ++s) if (s <= t) mix += vr[s] * ws_[s]; }
        const f32x4 uz = *(const GAS f32x4*)(proj + (size_t)(MP + r) * 4096 + c); const f32x4 u = (f32x4){gelu_erf(uz.x), gelu_erf(uz.y), gelu_erf(uz.z), gelu_erf(uz.w)}; const f32x4 o = mix * u;
        v2u w; w.x = pk2(o.x, o.y); w.y = pk2(o.z, o.w); *(GAS v2u*)(OB + (size_t)(MP + r) * D + c) = w;
    }
}

__device__ __forceinline__ void bf8_to_f(const v4u w, float (&x)[8]) {
    x[0] = __builtin_bit_cast(float, w.x << 16); x[1] = __builtin_bit_cast(float, w.x & 0xffff0000u); x[2] = __builtin_bit_cast(float, w.y << 16); x[3] = __builtin_bit_cast(float, w.y & 0xffff0000u);
    x[4] = __builtin_bit_cast(float, w.z << 16); x[5] = __builtin_bit_cast(float, w.z & 0xffff0000u); x[6] = __builtin_bit_cast(float, w.w << 16); x[7] = __builtin_bit_cast(float, w.w & 0xffff0000u);
}
__device__ __forceinline__ void ld8f(const float* p, float (&x)[8]) { const f32x4 a = *(const GAS f32x4*)p, b = *(const GAS f32x4*)(p + 4); x[0] = a.x; x[1] = a.y; x[2] = a.z; x[3] = a.w; x[4] = b.x; x[5] = b.y; x[6] = b.z; x[7] = b.w; }
__device__ __forceinline__ void st8f(float* p, const float (&x)[8]) { *(GAS f32x4*)p = (f32x4){x[0], x[1], x[2], x[3]}; *(GAS f32x4*)(p + 4) = (f32x4){x[4], x[5], x[6], x[7]}; }
__device__ __forceinline__ void conv_fix(Frame& F, int layer, const float* cw, const float* cb, const float* st_in) {
    const float* SIDE = (const float*)(F.ws + WS_PROJ); const float* UPS = (const float*)(F.ws + WS_PROJ + 32 * MiB); bf16* ACT = (bf16*)(F.ws + WS_ACT);
    constexpr int NCH = FF / 8;
    for (int it = F.vcu * NTHR + F.tid; it < (MP / 64) * NCH; it += F.G * NTHR) {
        const int ch = it % NCH, blk = it / NCH, c = ch * 8;
        float wa[3][8], wg[3][8], ba[8], bg[8];
#pragma unroll
        for (int j = 0; j < 3; ++j) { ld8f(cw + (size_t)j * F2 + c, wa[j]); ld8f(cw + (size_t)j * F2 + FF + c, wg[j]); }
        ld8f(cb + c, ba); ld8f(cb + FF + c, bg);
        float a2[8], a1[8], g2[8], g1[8], x0a[8], x0g[8], x1a[8], x1g[8];
        if ((blk & 31) != 0) { const float* sp = SIDE + ((size_t)(blk - 1) * 4) * F2; ld8f(sp + c, a2); ld8f(sp + FF + c, g2); ld8f(sp + F2 + c, a1); ld8f(sp + F2 + FF + c, g1); }
        else {
#pragma unroll
            for (int e = 0; e < 8; ++e) { a2[e] = 0.f; a1[e] = 0.f; g2[e] = 0.f; g1[e] = 0.f; } }
        { const float* sp = SIDE + ((size_t)blk * 4 + 2) * F2; ld8f(sp + c, x0a); ld8f(sp + FF + c, x0g); ld8f(sp + F2 + c, x1a); ld8f(sp + F2 + FF + c, x1g); }
        float o0[8], o1[8];
#pragma unroll
        for (int e = 0; e < 8; ++e) {
            const float ya0 = ba[e] + wa[0][e] * a2[e] + wa[1][e] * a1[e] + wa[2][e] * x0a[e], yg0 = bg[e] + wg[0][e] * g2[e] + wg[1][e] * g1[e] + wg[2][e] * x0g[e];
            const float ya1 = ba[e] + wa[0][e] * a1[e] + wa[1][e] * x0a[e] + wa[2][e] * x1a[e], yg1 = bg[e] + wg[0][e] * g1[e] + wg[1][e] * x0g[e] + wg[2][e] * x1g[e];
            o0[e] = ya0 * (yg0 * sigm(yg0)); o1[e] = ya1 * (yg1 * sigm(yg1)); }
        v4u w; w.x = pk2(o0[0], o0[1]); w.y = pk2(o0[2], o0[3]); w.z = pk2(o0[4], o0[5]); w.w = pk2(o0[6], o0[7]);
        *(GAS v4u*)(ACT + (size_t)(blk * 64) * FF + c) = w;
        w.x = pk2(o1[0], o1[1]); w.y = pk2(o1[2], o1[3]); w.z = pk2(o1[4], o1[5]); w.w = pk2(o1[6], o1[7]);
        *(GAS v4u*)(ACT + (size_t)(blk * 64 + 1) * FF + c) = w;
    }
    for (int it = F.vcu * NTHR + F.tid; it < DB * NCH; it += F.G * NTHR) {
        const int ch = it % NCH, b = it / NCH, c = ch * 8;
        float wa[3][8], wg[3][8], ba[8], bg[8];
#pragma unroll
        for (int j = 0; j < 3; ++j) { ld8f(cw + (size_t)j * F2 + c, wa[j]); ld8f(cw + (size_t)j * F2 + FF + c, wg[j]); }
        ld8f(cb + c, ba); ld8f(cb + FF + c, bg);
        float a2[8], a1[8], g2[8], g1[8];
        const float* sp = st_in + ((size_t)(layer * DB + b) * 2) * F2;
        ld8f(sp + c, a2); ld8f(sp + FF + c, g2); ld8f(sp + F2 + c, a1); ld8f(sp + F2 + FF + c, g1);
        float xaa[DSQ][8], xgg[DSQ][8];
#pragma unroll
        for (int t = 0; t < DSQ; ++t) { const size_t rl = (size_t)b * DSQ + t; ld8f(UPS + rl * F2 + c, xaa[t]); ld8f(UPS + rl * F2 + FF + c, xgg[t]); }
        __builtin_amdgcn_sched_barrier(0);
#pragma unroll
        for (int t = 0; t < DSQ; ++t) {
            const size_t rl = (size_t)b * DSQ + t; float xa[8], xg[8];
#pragma unroll
            for (int e = 0; e < 8; ++e) { xa[e] = xaa[t][e]; xg[e] = xgg[t][e]; }
            float o[8];
#pragma unroll
            for (int e = 0; e < 8; ++e) { const float ya = ba[e] + wa[0][e] * a2[e] + wa[1][e] * a1[e] + wa[2][e] * xa[e], yg = bg[e] + wg[0][e] * g2[e] + wg[1][e] * g1[e] + wg[2][e] * xg[e];
                o[e] = ya * (yg * sigm(yg)); a2[e] = a1[e]; a1[e] = xa[e]; g2[e] = g1[e]; g1[e] = xg[e]; }
            v4u w; w.x = pk2(o[0], o[1]); w.y = pk2(o[2], o[3]); w.z = pk2(o[4], o[5]); w.w = pk2(o[6], o[7]);
            *(GAS v4u*)(ACT + (MP + rl) * FF + c) = w;
            if (t >= 2) { float* po = F.out + O_CVS + ((size_t)(layer * DB + b) * 2 + (t - 2)) * F2; st8f(po + c, xa); st8f(po + FF + c, xg); }
        }
    }
}
__device__ __forceinline__ void conv_ffn(Frame& F, int layer, const float* cw, const float* cb, const float* st_in) {
    const bf16* UP = (const bf16*)(F.ws + WS_PROJ); bf16* ACT = (bf16*)(F.ws + WS_ACT);
    constexpr int RB = 16, NCH = FF / 8;
    for (int it = F.vcu * NTHR + F.tid; it < (MP / RB) * NCH; it += F.G * NTHR) {
        const int ch = it % NCH, rb = it / NCH, c = ch * 8; const int r0 = rb * RB;
        float wa[3][8], wg[3][8], ba[8], bg[8];
#pragma unroll
        for (int j = 0; j < 3; ++j) { ld8f(cw + (size_t)j * F2 + c, wa[j]); ld8f(cw + (size_t)j * F2 + FF + c, wg[j]); }
        ld8f(cb + c, ba); ld8f(cb + FF + c, bg);
        float a2[8], a1[8], g2[8], g1[8];
        if ((r0 & (SEQ - 1)) != 0) { bf8_to_f(*(const GAS v4u*)(UP + (size_t)(r0 - 2) * F2 + c), a2); bf8_to_f(*(const GAS v4u*)(UP + (size_t)(r0 - 1) * F2 + c), a1);
                                     bf8_to_f(*(const GAS v4u*)(UP + (size_t)(r0 - 2) * F2 + FF + c), g2); bf8_to_f(*(const GAS v4u*)(UP + (size_t)(r0 - 1) * F2 + FF + c), g1); }
        else {
#pragma unroll
            for (int e = 0; e < 8; ++e) { a2[e] = 0.f; a1[e] = 0.f; g2[e] = 0.f; g1[e] = 0.f; } }
#pragma unroll 4
        for (int rr = 0; rr < RB; ++rr) {
            const int r = r0 + rr; float xa[8], xg[8];
            bf8_to_f(*(const GAS v4u*)(UP + (size_t)r * F2 + c), xa); bf8_to_f(*(const GAS v4u*)(UP + (size_t)r * F2 + FF + c), xg);
            float o[8];
#pragma unroll
            for (int e = 0; e < 8; ++e) { const float ya = ba[e] + wa[0][e] * a2[e] + wa[1][e] * a1[e] + wa[2][e] * xa[e], yg = bg[e] + wg[0][e] * g2[e] + wg[1][e] * g1[e] + wg[2][e] * xg[e];
                o[e] = ya * (yg * sigm(yg)); a2[e] = a1[e]; a1[e] = xa[e]; g2[e] = g1[e]; g1[e] = xg[e]; }
            v4u w; w.x = pk2(o[0], o[1]); w.y = pk2(o[2], o[3]); w.z = pk2(o[4], o[5]); w.w = pk2(o[6], o[7]);
            *(GAS v4u*)(ACT + (size_t)r * FF + c) = w;
            const int tin = r & (SEQ - 1);
            if (tin >= SEQ - 2) { float* po = F.out + O_CVP + ((size_t)(layer * NB + (r >> 11)) * 2 + (tin - (SEQ - 2))) * F2; st8f(po + c, xa); st8f(po + FF + c, xg); }
        }
    }
    for (int it = F.vcu * NTHR + F.tid; it < DB * NCH; it += F.G * NTHR) {
        const int ch = it % NCH, b = it / NCH, c = ch * 8;
        float wa[3][8], wg[3][8], ba[8], bg[8];
#pragma unroll
        for (int j = 0; j < 3; ++j) { ld8f(cw + (size_t)j * F2 + c, wa[j]); ld8f(cw + (size_t)j * F2 + FF + c, wg[j]); }
        ld8f(cb + c, ba); ld8f(cb + FF + c, bg);
        float a2[8], a1[8], g2[8], g1[8];
        const float* sp = st_in + ((size_t)(layer * DB + b) * 2) * F2;
        ld8f(sp + c, a2); ld8f(sp + FF + c, g2); ld8f(sp + F2 + c, a1); ld8f(sp + F2 + FF + c, g1);
#pragma unroll
        for (int t = 0; t < DSQ; ++t) {
            const size_t r = MP + b * DSQ + t; float xa[8], xg[8];
            bf8_to_f(*(const GAS v4u*)(UP + r * F2 + c), xa); bf8_to_f(*(const GAS v4u*)(UP + r * F2 + FF + c), xg);
            float o[8];
#pragma unroll
            for (int e = 0; e < 8; ++e) { const float ya = ba[e] + wa[0][e] * a2[e] + wa[1][e] * a1[e] + wa[2][e] * xa[e], yg = bg[e] + wg[0][e] * g2[e] + wg[1][e] * g1[e] + wg[2][e] * xg[e];
                o[e] = ya * (yg * sigm(yg)); a2[e] = a1[e]; a1[e] = xa[e]; g2[e] = g1[e]; g1[e] = xg[e]; }
            v4u w; w.x = pk2(o[0], o[1]); w.y = pk2(o[2], o[3]); w.z = pk2(o[4], o[5]); w.w = pk2(o[6], o[7]);
            *(GAS v4u*)(ACT + r * FF + c) = w;
            if (t >= 2) { float* po = F.out + O_CVS + ((size_t)(layer * DB + b) * 2 + (t - 2)) * F2; st8f(po + c, xa); st8f(po + FF + c, xg); }
        }
    }
}

#ifndef EN_P0
#define EN_P0 1
#endif
#ifndef EN_GIN
#define EN_GIN 1
#endif
#ifndef EN_MIXA
#define EN_MIXA 1
#endif
#ifndef EN_MIXB
#define EN_MIXB 1
#endif
#ifndef EN_GOUT
#define EN_GOUT 1
#endif
#ifndef EN_NORM
#define EN_NORM 1
#endif
#ifndef EN_GUP
#define EN_GUP 1
#endif
#ifndef EN_CONV
#define EN_CONV 1
#endif
#ifndef EN_GDOWN
#define EN_GDOWN 1
#endif
#ifndef REP_P0
#define REP_P0 1
#endif
#ifndef REP_GIN
#define REP_GIN 1
#endif
#ifndef REP_MIXA
#define REP_MIXA 1
#endif
#ifndef REP_MIXB
#define REP_MIXB 1
#endif
#ifndef REP_NORM
#define REP_NORM 1
#endif
#ifndef REP_GUP
#define REP_GUP 1
#endif
#ifndef REP_CONV
#define REP_CONV 1
#endif
#ifndef REP_GOUT
#define REP_GOUT 1
#endif
#ifndef REP_GDOWN
#define REP_GDOWN 1
#endif
constexpr int NPHASE = 37;
#ifndef MK_N_LAUNCHES
#define MK_N_LAUNCHES 1
#endif
#define FFN_DESC(li_) do { SET_DESCP(di, INP(32) + (size_t)(li_) * D * F2, INP(8) + (li_) * D, WB + WE_UP + (size_t)(li_) * WE_UP_STRIDE, D, F2, 0, 1.0f, 1); ++di; \
        SET_DESC(di, INP(35) + (size_t)(li_) * FF * D, (const float*)nullptr, WB + WE_DOWN + (size_t)(li_) * WE_DOWN_STRIDE, FF, D, 0, 1.0f); ++di; } while (0)
#define HGRN_DESC(jj_) do { const int li__ = (jj_) * 3; const float* gn = INP(7) + li__ * D; bf16* wi = WB + ((jj_) ? WE_IN3 : WE_IN0); bf16* wo = WB + ((jj_) ? WE_OUT3 : WE_OUT0); const size_t so = (size_t)(jj_) * D * D; \
        SET_DESC(di, INP(10) + so, gn, wi, D, D, 0, 1.0f); ++di; SET_DESC(di, INP(11) + so, gn, wi, D, D, 2048, 1.0f); ++di; \
        SET_DESC(di, INP(12) + so, gn, wi, D, D, 4096, 1.0f); ++di; SET_DESC(di, INP(13) + so, gn, wi, D, D, 6144, 1.0f); ++di; \
        SET_DESC(di, INP(16) + so, (const float*)nullptr, wo, D, D, 0, 1.0f); ++di; } while (0)
#define BUILD_DESC() do { if (F.tid == 0) { int tot_ = 0; int di = 0; \
        HGRN_DESC(0); FFN_DESC(0); \
        { const float* gn = INP(7) + 1 * D; bf16* wi = (bf16*)(args.ws + WS_WIN1); \
          SET_DESC(di, INP(17), gn, wi, D, 1024, 0, 1.0f); ++di; SET_DESC(di, INP(18), gn, wi, D, 1024, 1024, 0.08838834764831845f); ++di; \
          SET_DESC(di, INP(19), gn, wi, D, 2048, 2048, 1.0f); ++di; SET_DESC(di, INP(20), gn, wi, D, 2048, 4096, 1.0f); ++di; \
          SET_DESC(di, INP(24), (const float*)nullptr, WB + WE_OUT1, D, D, 0, 1.0f); ++di; } FFN_DESC(1); \
        { const float* gn = INP(7) + 2 * D; \
          SET_DESC(di, INP(25), gn, WB + WE_IN2, D, 4096, 0, 1.0f); ++di; SET_DESC(di, INP(31), (const float*)nullptr, WB + WE_OUT2, D, D, 0, 1.0f); ++di; } FFN_DESC(2); \
        HGRN_DESC(1); FFN_DESC(3); } } while (0)
#define CONVERT_FR(d_lo, d_hi, n0_, n1_, den_, widx, nw) do { LAS float* scr_ = (LAS float*)(F.lds + F.wave * 16640); \
        const int itA_ = (d_lo) ? desc[(d_lo) - 1].item_end : 0, itB_ = desc[(d_hi) - 1].item_end; \
        const int it0_ = itA_ + (int)((long)(itB_ - itA_) * (n0_) / (den_)), it1_ = itA_ + (int)((long)(itB_ - itA_) * (n1_) / (den_)); \
        for (int it = it0_ + (widx); it < it1_; it += (nw)) { int d = (d_lo); while (d < (d_hi) - 1 && desc[d].item_end <= it) ++d; \
            const int first = d ? desc[d - 1].item_end : 0; \
            p0_transpose_item(desc[d].W, desc[d].gain, desc[d].scale, desc[d].K, desc[d].N, desc[d].WT, desc[d].row_off, desc[d].perm, scr_, it - first, F.lane); } } while (0)
#define CONVERT(d_lo, d_hi, widx, nw) CONVERT_FR(d_lo, d_hi, 0, 1, 1, widx, nw)
constexpr int INTAB_OFF = 142592;
__device__ __forceinline__ const float* lds_ptr(LAS unsigned char* p) { const unsigned long long v = *(LAS unsigned long long*)p;
    const unsigned lo_ = __builtin_amdgcn_readfirstlane((unsigned)v), hi_ = __builtin_amdgcn_readfirstlane((unsigned)(v >> 32)); return (const float*)(((unsigned long long)hi_ << 32) | lo_); }
struct Args { const float* in[36]; float* out; unsigned char* ws; int ph_lo, ph_hi, li, pad; };
__global__ void __launch_bounds__(NTHR, 2) mk_fwd(Args args) {
    extern __shared__ __attribute__((aligned(16))) unsigned char lds[];
    Frame F;
    F.lds = (LAS unsigned char*)lds;
    F.MISC = (volatile LAS unsigned*)(F.lds + MISC_OFF);
    F.tid = threadIdx.x; F.lane = F.tid & 63; F.wave = __builtin_amdgcn_readfirstlane(F.tid >> 6);
    F.G = gridDim.x; { const int bx = blockIdx.x; F.vcu = (F.G % 8 == 0) ? (bx % 8) * (F.G / 8) + bx / 8 : bx; }
    F.out = args.out; F.ws = args.ws;
    for (int u = F.tid; u < (LDS_BYTES - LDSCTL_OFF) / 4; u += NTHR) ((LAS unsigned*)(F.lds + LDSCTL_OFF))[u] = 0u;
    __syncthreads();
    if (F.tid < 36) ((LAS unsigned long long*)(F.lds + INTAB_OFF))[F.tid] = (unsigned long long)args.in[F.tid];
    __syncthreads();
#define INP(k) lds_ptr(F.lds + INTAB_OFF + 8 * (k))
    const int lo = args.ph_lo, hi = args.ph_hi;
    bf16* WB = (bf16*)(args.ws + WS_W);
    LAS MatDesc* desc = (LAS MatDesc*)(F.lds + DESC_OFF);
    BUILD_DESC();
    unsigned* barw = (unsigned*)(args.ws + WS_CTL) + CW_BAR + args.li * XCD_BAR_WORDS;
    XcdBarrier bar; bar.bar = barw; bar.x = 0; bar.st = nullptr;
    if (hi - lo > 1) bar = xcd_barrier_post(barw, F.MISC + 8);
#define IN(k) (lo <= (k) && (k) < hi)
#define FRESH() do { int t_ = threadIdx.x; asm volatile("" : "+v"(t_)); F.tid = t_; F.lane = t_ & 63; F.wave = __builtin_amdgcn_readfirstlane(t_ >> 6); } while (0)
#if defined(DBG_CONV_RAW)
#define CONV_FN conv_ffn
#else
#define CONV_FN conv_fix
#endif
#ifndef PROBE_NOSTORE
#define PROBE_NOSTORE 0
#endif
#ifndef PROBE_NOML
#define PROBE_NOML 0
#endif
#ifndef PROBE_PART
#define PROBE_PART 3
#endif
#ifndef REP_BAR
#define REP_BAR 1
#endif
#if defined(PROBE_K2)
#define K2_RERUN(gg, Mm, Nn) do { xcd_barrier(bar); _Pragma("unroll 1") for (int rr_ = 0; rr_ < PROBE_K2; ++rr_) { FRESH(); pg8::StaticOrder Sx; Sx.init((Mm), (Nn), F.G, (int)blockIdx.x); int one_ = 1; asm volatile("" : "+s"(one_)); pg8::EpiBf16<0> Ex{(pg8::bf16_t*)(args.ws + WS_SCR), 256, one_}; \
        pg8::gemm_phase<pg8::EpiBf16<0>, pg8::StaticOrder, PG8_ALIGN, PG8_SP2>(F.lds, (gg), Sx, Ex); } xcd_barrier(bar); } while (0)
#else
#define K2_RERUN(gg, Mm, Nn) do { } while (0)
#endif
#define SEAM(k) do { if (IN(k) && IN((k) + 1)) { _Pragma("unroll 1") for (int rb_ = 0; rb_ < REP_BAR; ++rb_) xcd_barrier(bar); } } while (0)
    float* X = (float*)(args.ws + WS_X); bf16* HB = (bf16*)(args.ws + WS_HB); float* PROJ = (float*)(args.ws + WS_PROJ); bf16* UP = (bf16*)(args.ws + WS_PROJ);
    bf16* OB = (bf16*)(args.ws + WS_OB); bf16* ACT = (bf16*)(args.ws + WS_ACT); float* PART = (float*)(args.ws + WS_PART); float* SSQ = (float*)(args.ws + WS_SSQ);
    unsigned* CNT = (unsigned*)(args.ws + WS_CTL) + CW_CNT;

    if (EN_P0 && IN(0)) {
        FRESH();
        __syncthreads();
        {
            const int dhi = F.G > 64 ? 7 : N_MAT;
            CONVERT(0, dhi, F.vcu * NWAVES + F.wave, F.G * NWAVES);
        }
        { bf16* wi = (bf16*)(args.ws + WS_WIN1); const float* gn = INP(7) + 1 * D; const float* wif = INP(21);
          for (int idx = F.vcu * NTHR + F.tid; idx < 256 * (D / 2); idx += F.G * NTHR) { const int r = idx / (D / 2), k2 = (idx % (D / 2)) * 2;
              unsigned w = 0u; if (r < 16) w = pk2(wif[(size_t)k2 * 16 + r] * gn[k2], wif[(size_t)(k2 + 1) * 16 + r] * gn[k2 + 1]);
              *(GAS unsigned*)(wi + (size_t)(6144 + r) * D + k2) = w; } }
        norm_rows(F, 1 | 16 | 32, 0, INP(0), INP(1), nullptr, nullptr, nullptr);
        SEAM(0);
    }
    for (int i = 0; i < 4; ++i) {
        const int kind = i % 3, base = 1 + 9 * i, j = i / 3;
        const size_t we_in = i == 0 ? WE_IN0 : i == 1 ? WE_IN1 : i == 2 ? WE_IN2 : WE_IN3, we_out = i == 0 ? WE_OUT0 : i == 1 ? WE_OUT1 : i == 2 ? WE_OUT2 : WE_OUT3;
        const int Nin = kind == 0 ? 8192 : kind == 1 ? 6144 : 4096;
        if (EN_GIN && IN(base + 0)) {
            FRESH();
            const int Ng = kind == 1 ? 6400 : Nin;
            const bool split = (kind != 1) && (F.G >= 256);
            const bf16* Wt = kind == 1 ? (const bf16*)(args.ws + WS_WIN1) : WB + we_in;
            pg8::Gemm g{HB, Wt, split ? MP : M, Ng, D, D}; pg8::StaticOrder S; S.init(split ? MP : M, Ng, F.G, (int)blockIdx.x);
            fill_rstd_table(F, S);
            { pg8::EpiF32 E{PROJ, Nin, kind == 2 ? INP(26) : (const float*)nullptr, 0, (const LAS float*)(F.lds + RTAB_OFF),
                    kind == 1 ? 24 : -1, (float*)(args.ws + WS_GATES), INP(22)};
            pg8::gemm_phase<pg8::EpiF32, pg8::StaticOrder, PG8_ALIGN, PG8_SP2>(F.lds, g, S, E); }
            if (split) { pg8::Gemm g2{HB + (size_t)MP * D, Wt, MS, Ng, 512, D}; pg8::SplitOrder S2; S2.init(MS, Ng, 4, 512, F.G, (int)blockIdx.x);
                pg8::EpiPart E2{(float*)(args.ws + WS_SCR), Ng, (size_t)MS * Ng};
                pg8::gemm_phase<pg8::EpiPart, pg8::SplitOrder, PG8_ALIGN, PG8_SP2>(F.lds, g2, S2, E2);
                sample_reduce_proj<4>(F, S2, CNT + 8192 + (size_t)i * 64 * 64, Ng, kind == 2 ? INP(26) : (const float*)nullptr); }
            if (i == 1 && F.G > 64) {
                const int rem = (M / 256) * (Ng / 256) % F.G, bx = (int)blockIdx.x;
                if (rem != 0 && bx >= rem) { __syncthreads(); CONVERT_FR(18, N_MAT, 0, 9, 20, (bx - rem) * NWAVES + F.wave, (F.G - rem) * NWAVES); }
                else if (rem == 0) { __syncthreads(); CONVERT_FR(18, N_MAT, 0, 9, 20, F.vcu * NWAVES + F.wave, F.G * NWAVES); }
            }
            SEAM(base + 0);
        }
        if (EN_MIXA && IN(base + 1)) {
            FRESH();
            if (kind == 0) { { FRESH(); hgrn_scan(F, j, INP(14), INP(15) + j * D, INP(2), 3); }
                if (i == 0 && F.G > 64 && blockIdx.x >= 64) { __syncthreads();
                    CONVERT(7, 14, ((int)blockIdx.x - 64) * NWAVES + F.wave, (F.G - 64) * NWAVES); } }
            else if (kind == 1) { { FRESH(); mlstm_scan(F, INP(3), INP(4), INP(5)); }
                if (F.G > 64 && blockIdx.x >= 64) { __syncthreads();
                    CONVERT(14, 18, ((int)blockIdx.x - 64) * NWAVES + F.wave, (F.G - 64) * NWAVES); CONVERT_FR(18, N_MAT, 9, 20, 20, ((int)blockIdx.x - 64) * NWAVES + F.wave, (F.G - 64) * NWAVES); } }
            else gmlp_a(F, INP(27), INP(28));
            SEAM(base + 1);
        }
        if (EN_MIXB && kind != 0 && IN(base + 2)) {
            FRESH();
            {
            if (kind == 1) mlstm_post(F, INP(23));
            else gmlp_b(F, INP(29), INP(30)); }
            SEAM(base + 2);
        }
        if (EN_GOUT && IN(base + 3)) {
            FRESH();
            { pg8::Gemm g{OB, WB + we_out, MP, D, D, D}; pg8::StaticOrder S; S.init(MP, D, F.G, (int)blockIdx.x);
              if (kind == 0) fill_rstd_table16(F, S);
              { pg8::EpiResid E{i == 0 ? INP(0) : (const float*)X, X, D, HB, SSQ, kind == 0 ? (const LAS float*)(F.lds + RTAB_OFF) : (const LAS float*)nullptr};
              pg8::gemm_phase<pg8::EpiResid, pg8::StaticOrder, PG8_ALIGN, PG8_SP2>(F.lds, g, S, E); } K2_RERUN(g, MP, D); }
            { pg8::Gemm g{OB + (size_t)MP * D, WB + we_out, MS, D, 256, D}; pg8::SplitOrder S; S.init(MS, D, 8, 256, F.G, (int)blockIdx.x);
              pg8::EpiPart E{PART, D, (size_t)MS * D};
              pg8::gemm_phase<pg8::EpiPart, pg8::SplitOrder, PG8_ALIGN, PG8_SP2>(F.lds, g, S, E);
#if !defined(DBG_REDUCE_PHASE)
              sample_reduce<8>(F, S, CNT + (size_t)(2 * i) * 16 * 64, i == 0 ? INP(1) : (const float*)(X + (size_t)MP * D), kind == 0 ? (const float*)(args.ws + WS_OSSQ) : (const float*)nullptr);
#endif
            }
            SEAM(base + 3);
#if defined(DBG_REDUCE_PHASE)
            FRESH(); sample_reduce_rows(F, 4); xcd_barrier(bar);
#endif
        }
        if (EN_GUP && IN(base + 5)) {
            FRESH();
            pg8::Gemm g{HB, WB + WE_UP + (size_t)i * WE_UP_STRIDE, M, F2, D, D}; pg8::StaticOrder S; S.init(M, F2, F.G, (int)blockIdx.x);
            fill_rstd_table(F, S);
            { pg8::EpiConv E{ACT, PROJ, PROJ + 8 * MiB, args.out + O_CVP + (size_t)i * NB * 2 * F2, INP(33) + (size_t)i * 3 * F2, INP(34) + (size_t)i * F2, FF, MP / 256, (const LAS float*)(F.lds + RTAB_OFF), (LAS float*)(F.lds + RING_BYTES)};
              pg8::gemm_phase<pg8::EpiConv, pg8::StaticOrder, PG8_ALIGN, PG8_SP2>(F.lds, g, S, E); }
            SEAM(base + 5);
        }
        if (EN_CONV && IN(base + 6)) { FRESH(); CONV_FN(F, i, INP(33) + (size_t)i * 3 * F2, INP(34) + (size_t)i * F2, INP(6)); SEAM(base + 6); }
        if (EN_GDOWN && IN(base + 7)) {
            FRESH();
            { pg8::Gemm g{ACT, WB + WE_DOWN + (size_t)i * WE_DOWN_STRIDE, MP, D, FF, FF}; pg8::StaticOrder S; S.init(MP, D, F.G, (int)blockIdx.x);
              { pg8::EpiResid E{X, X, D, i == 3 ? (bf16*)nullptr : HB, SSQ, (const LAS float*)nullptr};
              pg8::gemm_phase<pg8::EpiResid, pg8::StaticOrder, PG8_ALIGN, PG8_SP2>(F.lds, g, S, E); } }
            { pg8::Gemm g{ACT + (size_t)MP * FF, WB + WE_DOWN + (size_t)i * WE_DOWN_STRIDE, MS, D, 512, FF}; pg8::SplitOrder S; S.init(MS, D, 11, 512, F.G, (int)blockIdx.x);
              pg8::EpiPart E{PART, D, (size_t)MS * D};
              pg8::gemm_phase<pg8::EpiPart, pg8::SplitOrder, PG8_ALIGN, PG8_SP2>(F.lds, g, S, E);
#if !defined(DBG_REDUCE_PHASE)
              sample_reduce<11>(F, S, CNT + (size_t)(2 * i + 1) * 16 * 64, (const float*)(X + (size_t)MP * D), (const float*)nullptr);
#endif
            }
            SEAM(base + 7);
#if defined(DBG_REDUCE_PHASE)
            FRESH(); sample_reduce_rows(F, 11); xcd_barrier(bar);
#endif
        }
        if (EN_NORM && i == 3 && IN(base + 8)) { FRESH(); norm_rows(F, 2, 0, nullptr, nullptr, INP(9), nullptr, nullptr); }
    }
#undef IN
#undef SEAM
}

extern "C" void kernel_launch(void* const* d_in, const int* in_sizes, int n_in, void* d_out, int out_size, void* d_ws, size_t ws_size, hipStream_t stream) {
    static int grid = 0;
    if (grid == 0) {
        if (n_in != 36 || (size_t)out_size != O_END || ws_size < WS_END) { fprintf(stderr, "kernel_launch: unexpected shapes: n_in %d out %d ws %zu (need %zu)\n", n_in, out_size, ws_size, (size_t)WS_END); grid = -1; return; }
        int dev = 0, cus = 0;
        if (hipGetDevice(&dev) != hipSuccess || hipDeviceGetAttribute(&cus, hipDeviceAttributeMultiprocessorCount, dev) != hipSuccess) { grid = -1; return; }
        if (hipFuncSetAttribute((const void*)mk_fwd, hipFuncAttributeMaxDynamicSharedMemorySize, LDS_BYTES) != hipSuccess) { fprintf(stderr, "kernel_launch: hipFuncSetAttribute failed\n"); grid = -1; return; }
        int per_cu = 0;
        if (hipOccupancyMaxActiveBlocksPerMultiprocessor(&per_cu, (const void*)mk_fwd, NTHR, LDS_BYTES) != hipSuccess || per_cu < 1) { fprintf(stderr, "kernel_launch: occupancy query says %d blocks per CU\n", per_cu); }
        (void)hipGetLastError();
        grid = cus;
    }
    if (grid < 0) return;
    (void)hipMemsetAsync((char*)d_ws + WS_CTL, 0, CTL_ZERO_BYTES, stream);
    Args a{};
    for (int i = 0; i < 36; ++i) a.in[i] = (const float*)d_in[i];
    a.out = (float*)d_out; a.ws = (unsigned char*)d_ws; a.pad = 0;
#if MK_N_LAUNCHES == 1
    a.ph_lo = 0; a.ph_hi = NPHASE; a.li = 0;
    hipLaunchKernelGGL(mk_fwd, dim3(grid), dim3(NTHR), LDS_BYTES, stream, a);
#else
    for (int p = 0; p < NPHASE; ++p) { a.ph_lo = p; a.ph_hi = p + 1; a.li = p;
        hipLaunchKernelGGL(mk_fwd, dim3(grid), dim3(NTHR), LDS_BYTES, stream, a); }
#endif
}
```
